# Optimizing an MI355X kernel written in HIP

```python
import math
import jax
import jax.numpy as jnp
from jax import lax
import numpy as np

D_MODEL = 1024
BATCH = 8
SEQ = 2048
DEPTH = 4

GRID_W = 64
CTX_LEN = 256
EPS = 1e-6

GROUP_W = D_MODEL // 4
D_MIX = 4 * GROUP_W
HEAD_DIM = 64
N_HEADS = GROUP_W // HEAD_DIM

HGRN_DK = 64
HGRN_DV = 64
HGRN_CHUNK = 64

HYENA_ORDER = 2
HYENA_SHORT = 3
HYENA_BANDS = 16
HYENA_EMB = 1 + 2 * HYENA_BANDS
HYENA_FFN = 64
HYENA_DECAY_MIN = 3.07
HYENA_DECAY_MAX = 15.35

NA_ROWS = 8
NA_COLS = 16

MLA_Q_RANK = 256
MLA_KV_RANK = 128
MLA_NOPE = 64
MLA_ROPE = 32
MLA_V = 64
MLA_QBLOCK = 128
ROPE_BASE = 10000.0

N_GROUPS = 4
EXPERTS_PER_GROUP = 8
N_EXPERTS = N_GROUPS * EXPERTS_PER_GROUP
TOP_K = 2
D_EXPERT = 512
MOE_BLOCK = 128

IN_SPLITS = (GROUP_W, GROUP_W, GROUP_W, GROUP_W, GROUP_W, 3 * GROUP_W, 3 * GROUP_W, MLA_Q_RANK, MLA_KV_RANK, MLA_ROPE)
D_IN = sum(IN_SPLITS)

kernel_name = "hybrid_parallel_heads_diffusion_trunk"


def rmsnorm(x, g):
    xf = x.astype(jnp.float32)
    y = xf * lax.rsqrt(jnp.mean(xf * xf, axis=-1, keepdims=True) + EPS)
    return (y * g.astype(jnp.float32)).astype(x.dtype)


def _heads(a, d):
    return a.reshape(a.shape[0], a.shape[1], -1, d)


def dense_attention(q, k, v):
    s = jnp.einsum('bqhd,bkhd->bhqk', q.astype(jnp.float32), k.astype(jnp.float32)) * (q.shape[-1] ** -0.5)
    p = jax.nn.softmax(s, axis=-1)
    return jnp.einsum('bhqk,bkhd->bqhd', p, v.astype(jnp.float32)).astype(v.dtype)


def blocked_attention(q, k, v):
    B, L, H, dq = q.shape
    nb = L // MLA_QBLOCK
    qb = q.reshape(B, nb, MLA_QBLOCK, H, dq).swapaxes(0, 1)
    o = lax.map(lambda qi: dense_attention(qi, k, v), qb)
    return o.swapaxes(0, 1).reshape(B, L, H, v.shape[-1])


def rope_2d(x):
    L = x.shape[1]
    t = jnp.arange(L)
    row = (t // GRID_W).astype(jnp.float32)
    col = (t % GRID_W).astype(jnp.float32)
    half = MLA_ROPE // 2
    inv = ROPE_BASE ** (-jnp.arange(0, half, 2, dtype=jnp.float32) / half)

    def rot(part, pos):
        ang = pos[:, None] * inv[None, :]
        cos = jnp.cos(ang)[None, :, None, :]
        sin = jnp.sin(ang)[None, :, None, :]
        a, b = part[..., :half // 2], part[..., half // 2:]
        return jnp.concatenate([a * cos - b * sin, a * sin + b * cos], axis=-1)

    xf = x.astype(jnp.float32)
    return jnp.concatenate([rot(xf[..., :half], row), rot(xf[..., half:], col)], axis=-1).astype(x.dtype)


def hgrn_gates(z, lb):
    zf = z.astype(jnp.float32)
    lbf = lb.astype(jnp.float32)
    logf = jnp.logaddexp(jnp.log(lbf), jnp.log1p(-lbf) + jax.nn.log_sigmoid(zf))
    k = -jnp.expm1(logf)
    return _heads(logf, HGRN_DK), _heads(k, HGRN_DK)


def hgrn_chunk_scan(q, k, logf, v, s0):
    B, L, H, dk = q.shape
    dv = v.shape[-1]
    C = HGRN_CHUNK
    n = L // C

    def chunks(a):
        return a.reshape(B, n, C, H, a.shape[-1]).transpose(1, 0, 3, 2, 4)

    causal = jnp.tril(jnp.ones((C, C), dtype=bool))

    def step(S, inp):
        qc, kc, fc, vc = inp
        b = jnp.cumsum(fc, axis=2)
        o_inter = jnp.einsum('bhtk,bhkv->bhtv', qc * jnp.exp(b), S)
        diff = b[:, :, :, None, :] - b[:, :, None, :, :]
        decay = jnp.exp(jnp.where(causal[None, None, :, :, None], diff, -jnp.inf))
        attn = jnp.einsum('bhtk,bhsk,bhtsk->bhts', qc, kc, decay)
        o_intra = jnp.einsum('bhts,bhsv->bhtv', attn, vc)
        b_last = b[:, :, -1:, :]
        S_new = jnp.exp(b_last[:, :, 0, :])[..., None] * S + jnp.einsum('bhsk,bhsv->bhkv', kc * jnp.exp(b_last - b), vc)
        return S_new, o_inter + o_intra

    S_fin, o = lax.scan(step, s0, (chunks(q), chunks(k), chunks(logf), chunks(v)))
    return o.transpose(1, 0, 3, 2, 4).reshape(B, L, H, dv), S_fin


def hgrn_readout(o, g, norm_g):
    B, L = g.shape[0], g.shape[1]
    o = rmsnorm(o, norm_g).reshape(B, L, -1)
    return (o * jax.nn.silu(g.astype(jnp.float32))).astype(g.dtype)


def hgrn_mixer(q, zf, zb, i, g, qc, zfc, zbc, ic, gc, lb, norm_g, need_ctx):
    f32 = jnp.float32
    B = q.shape[0]
    qh, ih = _heads(q.astype(f32), HGRN_DK), _heads(i.astype(f32), HGRN_DV)
    qch, ich = _heads(qc.astype(f32), HGRN_DK), _heads(ic.astype(f32), HGRN_DV)
    lf_f, k_f = hgrn_gates(zf, lb[0])
    lf_b, k_b = hgrn_gates(zb, lb[1])
    lfc_f, kc_f = hgrn_gates(zfc, lb[0])
    lfc_b, kc_b = hgrn_gates(zbc, lb[1])
    s0 = jnp.zeros((B, N_HEADS, HGRN_DK, HGRN_DV), f32)
    rev = lambda a: jnp.flip(a, axis=1)
    oc_f, s_cf = hgrn_chunk_scan(qch, kc_f, lfc_f, ich, s0)
    o_f, _ = hgrn_chunk_scan(qh, k_f, lf_f, ih, s_cf)
    oc_b, s_cb = hgrn_chunk_scan(rev(qch), rev(kc_b), rev(lfc_b), rev(ich), s0)
    o_b, _ = hgrn_chunk_scan(rev(qh), rev(k_b), rev(lf_b), rev(ih), s_cb)
    out = hgrn_readout(o_f + rev(o_b), g, norm_g)
    outc = hgrn_readout(oc_f + rev(oc_b), gc, norm_g) if need_ctx else None
    return out, outc


def hyena_filters(L, w1, b1, freq, w2, b2, w3, b3, decay):
    f32 = jnp.float32
    t = jnp.arange(L, dtype=f32)
    t_unit = jnp.linspace(0.0, 1.0, L, dtype=f32)
    bands = jnp.linspace(1e-4, HYENA_BANDS - 1, HYENA_BANDS, dtype=f32)
    ang = (2.0 * math.pi / L) * t[:, None] * bands[None, :]
    feats = jnp.concatenate([t_unit[:, None], jnp.cos(ang), -jnp.sin(ang)], axis=-1)
    fr = freq.astype(f32)
    hdn = jnp.sin(fr * (feats @ w1.astype(f32) + b1.astype(f32)))
    hdn = jnp.sin(fr * (hdn @ w2.astype(f32) + b2.astype(f32)))
    filt = (hdn @ w3.astype(f32) + b3.astype(f32)).reshape(L, HYENA_ORDER, 2, GROUP_W)
    filt = filt * jnp.exp(-t_unit[:, None, None, None] * decay.astype(f32)[None])
    fwd, bwd = filt[:, :, 0], filt[:, :, 1]
    kern = jnp.concatenate([fwd, jnp.zeros((1, HYENA_ORDER, GROUP_W), f32), bwd[:0:-1]], axis=0)
    return kern * lax.rsqrt(jnp.sum(kern * kern, axis=0, keepdims=True) + EPS)


def hyena_mixer(u, short_w, short_b, w1, b1, freq, w2, b2, w3, b3, decay, dbias):
    B, L, Cin = u.shape
    uc = lax.conv_general_dilated(u, short_w[:, None, :].astype(u.dtype), (1,), 'SAME',
                                  dimension_numbers=('NWC', 'WIO', 'NWC'),
                                  feature_group_count=Cin) + short_b.astype(u.dtype)
    v, x1, x2 = jnp.split(uc.astype(jnp.float32), 3, axis=-1)
    kern = hyena_filters(L, w1, b1, freq, w2, b2, w3, b3, decay)
    kf = jnp.fft.rfft(kern, axis=0)
    db = dbias.astype(jnp.float32)
    z = v
    for o, gate in enumerate((x1, x2)):
        zf = jnp.fft.rfft(z, n=2 * L, axis=1)
        y = jnp.fft.irfft(zf * kf[None, :, o], n=2 * L, axis=1)[:, :L]
        z = gate * (y + db[o] * z)
    return z.astype(u.dtype)


def neighborhood_attention(q, k, v, k_ctx, v_ctx, rpb):
    B, L, H, d = q.shape
    rows = L // GRID_W
    wr = min(NA_ROWS, rows)
    f32 = jnp.float32
    qg = q.astype(f32).reshape(B, rows, GRID_W, H, d)
    kg = k.astype(f32).reshape(B, rows, GRID_W, H, d)
    vg = v.astype(f32).reshape(B, rows, GRID_W, H, d)
    r = jnp.arange(rows)
    rs = jnp.clip(r - wr // 2, 0, rows - wr)
    row_idx = rs[:, None] + jnp.arange(wr)[None, :]
    kb = kg[:, row_idx]
    vb = vg[:, row_idx]
    cq = jnp.arange(GRID_W)
    cs = jnp.clip(cq - NA_COLS // 2, 0, GRID_W - NA_COLS)
    col_ok = (cq[None, :] >= cs[:, None]) & (cq[None, :] < cs[:, None] + NA_COLS)
    dr = row_idx - r[:, None] + (NA_ROWS - 1)
    dc = jnp.clip(cq[None, :] - cq[:, None] + (NA_COLS - 1), 0, 2 * NA_COLS - 2)
    bias = rpb.astype(f32)[:, dr[:, None, :, None], dc[None, :, None, :]]
    scale = d ** -0.5
    s_loc = jnp.einsum('brqhd,brjkhd->bhrqjk', qg, kb) * scale + bias[None]
    s_loc = jnp.where(col_ok[None, None, None, :, None, :], s_loc, -jnp.inf)
    s_ctx = jnp.einsum('brqhd,bchd->bhrqc', qg, k_ctx.astype(f32)) * scale
    s = jnp.concatenate([s_loc.reshape(B, H, rows, GRID_W, wr * GRID_W), s_ctx], axis=-1)
    p = jax.nn.softmax(s, axis=-1)
    p_loc = p[..., :wr * GRID_W].reshape(B, H, rows, GRID_W, wr, GRID_W)
    p_ctx = p[..., wr * GRID_W:]
    out = jnp.einsum('bhrqjk,brjkhd->brqhd', p_loc, vb) + jnp.einsum('bhrqc,bchd->brqhd', p_ctx, v_ctx.astype(f32))
    return out.reshape(B, L, H, d).astype(v.dtype)


def na_mixer(qkv, qkvc, rpb, q_g, k_g, need_ctx):
    q, k, v = [_heads(a, HEAD_DIM) for a in jnp.split(qkv, 3, axis=-1)]
    qc, kc, vc = [_heads(a, HEAD_DIM) for a in jnp.split(qkvc, 3, axis=-1)]
    q, k = rmsnorm(q, q_g), rmsnorm(k, k_g)
    qc, kc = rmsnorm(qc, q_g), rmsnorm(kc, k_g)
    B, L = qkv.shape[0], qkv.shape[1]
    out = neighborhood_attention(q, k, v, kc, vc, rpb).reshape(B, L, GROUP_W)
    outc = dense_attention(qc, kc, vc).reshape(B, qkvc.shape[1], GROUP_W) if need_ctx else None
    return out, outc


def mla_project(cq, ckv, kr, q_a_g, kv_a_g, w_uq, w_ukv, q_g, k_g, use_rope):
    B, L = cq.shape[0], cq.shape[1]
    q = (rmsnorm(cq, q_a_g) @ w_uq).reshape(B, L, N_HEADS, MLA_NOPE + MLA_ROPE)
    kv = (rmsnorm(ckv, kv_a_g) @ w_ukv).reshape(B, L, N_HEADS, MLA_NOPE + MLA_V)
    k_nope, v = kv[..., :MLA_NOPE], kv[..., MLA_NOPE:]
    k = jnp.concatenate([k_nope, jnp.broadcast_to(kr[:, :, None, :], (B, L, N_HEADS, MLA_ROPE))], axis=-1)
    q, k = rmsnorm(q, q_g), rmsnorm(k, k_g)
    if use_rope:
        q = jnp.concatenate([q[..., :MLA_NOPE], rope_2d(q[..., MLA_NOPE:])], axis=-1)
        k = jnp.concatenate([k[..., :MLA_NOPE], rope_2d(k[..., MLA_NOPE:])], axis=-1)
    return q, k, v


def mla_mixer(cq, ckv, kr, cqc, ckvc, krc, q_a_g, kv_a_g, w_uq, w_ukv, q_g, k_g, need_ctx):
    q, k, v = mla_project(cq, ckv, kr, q_a_g, kv_a_g, w_uq, w_ukv, q_g, k_g, True)
    qc, kc, vc = mla_project(cqc, ckvc, krc, q_a_g, kv_a_g, w_uq, w_ukv, q_g, k_g, False)
    B, L = cq.shape[0], cq.shape[1]
    k_all = jnp.concatenate([k, kc], axis=1)
    v_all = jnp.concatenate([v, vc], axis=1)
    out = blocked_attention(q, k_all, v_all).reshape(B, L, N_HEADS * MLA_V)
    outc = dense_attention(qc, kc, vc).reshape(B, cqc.shape[1], N_HEADS * MLA_V) if need_ctx else None
    return out, outc


def moe_ffn(h, wg, bg, we, be, w_gate, w_up, w_down):
    T, D = h.shape
    f32 = jnp.float32
    hf = h.astype(f32)
    lg = hf @ wg.astype(f32) + bg.astype(f32)
    pg = jax.nn.softmax(lg, axis=-1)
    g_sel = jnp.argmax(lg, axis=-1).astype(jnp.int32)
    p_sel = jnp.take_along_axis(pg, g_sel[:, None], axis=-1)[:, 0]
    le = (hf @ we.astype(f32) + be.astype(f32)).reshape(T, N_GROUPS, EXPERTS_PER_GROUP)
    le_sel = le[jnp.arange(T), g_sel]
    top_v, top_i = lax.top_k(le_sel, TOP_K)
    wts = jax.nn.softmax(top_v, axis=-1) * p_sel[:, None]
    eid = g_sel[:, None] * EXPERTS_PER_GROUP + top_i.astype(jnp.int32)
    N = T * TOP_K
    flat_e = eid.reshape(N)
    flat_t = jnp.repeat(jnp.arange(T, dtype=jnp.int32), TOP_K)
    flat_w = wts.reshape(N).astype(h.dtype)
    order = jnp.argsort(flat_e)
    se = flat_e[order]
    counts = jnp.bincount(flat_e, length=N_EXPERTS)
    starts = jnp.cumsum(counts) - counts
    pcounts = ((counts + MOE_BLOCK - 1) // MOE_BLOCK) * MOE_BLOCK
    pends = jnp.cumsum(pcounts)
    pstarts = pends - pcounts
    dest = pstarts[se] + (jnp.arange(N) - starts[se])
    NB = -(-N // MOE_BLOCK) + N_EXPERTS
    P = NB * MOE_BLOCK
    buf_t = jnp.full((P,), T, dtype=jnp.int32).at[dest].set(flat_t[order])
    buf_w = jnp.zeros((P,), h.dtype).at[dest].set(flat_w[order])
    block_e = jnp.minimum(jnp.searchsorted(pends, jnp.arange(NB) * MOE_BLOCK, side='right'), N_EXPERTS - 1)
    xpad = jnp.concatenate([h, jnp.zeros((1, D), h.dtype)], axis=0)
    xb = xpad[buf_t].reshape(NB, MOE_BLOCK, D)

    def run(args):
        xblk, e = args
        return (jax.nn.silu(xblk @ w_gate[e]) * (xblk @ w_up[e])) @ w_down[e]

    yb = lax.map(run, (xb, block_e)).reshape(P, D)
    return jax.ops.segment_sum(yb * buf_w[:, None], buf_t, num_segments=T + 1)[:T]


def setup_inputs(seed: int = 0) -> dict:
    key = jax.random.key(seed)
    ks = iter(jax.random.split(key, 48))
    f32 = jnp.float32
    nrm = lambda shape, scale: jax.random.normal(next(ks), shape, f32) * scale
    gain = lambda shape: 1.0 + 0.02 * jax.random.normal(next(ks), shape, f32)
    D = D_MODEL
    C = GROUP_W
    return {
        "x": nrm((BATCH, SEQ, D), 1.0),
        "c": nrm((BATCH, D), 1.0),
        "ctx": nrm((BATCH, CTX_LEN, D), 1.0),
        "c_ctx": nrm((D,), 1.0),
        "w_ada": nrm((DEPTH, D, 6 * D), 0.3 * D ** -0.5),
        "b_ada": nrm((DEPTH, 6 * D), 0.02),
        "norm1_g": gain((DEPTH, D)),
        "norm2_g": gain((DEPTH, D)),
        "w_in": nrm((DEPTH, D, D_IN), D ** -0.5),
        "w_out": nrm((DEPTH, D_MIX, D), D_MIX ** -0.5),
        "hgrn_lb_logits": nrm((DEPTH, 2, N_HEADS * HGRN_DK), 1.0),
        "hgrn_norm_g": gain((DEPTH, HGRN_DV)),
        "hy_short_w": nrm((DEPTH, HYENA_SHORT, 3 * C), HYENA_SHORT ** -0.5),
        "hy_short_b": nrm((DEPTH, 3 * C), 0.02),
        "hy_w1": nrm((DEPTH, HYENA_EMB, HYENA_FFN), HYENA_EMB ** -0.5),
        "hy_b1": nrm((DEPTH, HYENA_FFN), 0.02),
        "hy_freq": gain((DEPTH, HYENA_FFN)),
        "hy_w2": nrm((DEPTH, HYENA_FFN, HYENA_FFN), HYENA_FFN ** -0.5),
        "hy_b2": nrm((DEPTH, HYENA_FFN), 0.02),
        "hy_w3": nrm((DEPTH, HYENA_FFN, HYENA_ORDER * 2 * C), HYENA_FFN ** -0.5),
        "hy_b3": nrm((DEPTH, HYENA_ORDER * 2 * C), 0.02),
        "hy_decay": jnp.exp(jax.random.uniform(next(ks), (DEPTH, HYENA_ORDER, 2, C), f32,
                                               math.log(HYENA_DECAY_MIN), math.log(HYENA_DECAY_MAX))),
        "hy_bias": nrm((DEPTH, HYENA_ORDER, C), 0.1),
        "na_rpb": nrm((DEPTH, N_HEADS, 2 * NA_ROWS - 1, 2 * NA_COLS - 1), 0.02),
        "na_q_g": gain((DEPTH, HEAD_DIM)),
        "na_k_g": gain((DEPTH, HEAD_DIM)),
        "mla_q_a_g": gain((DEPTH, MLA_Q_RANK)),
        "mla_kv_a_g": gain((DEPTH, MLA_KV_RANK)),
        "mla_w_uq": nrm((DEPTH, MLA_Q_RANK, N_HEADS * (MLA_NOPE + MLA_ROPE)), MLA_Q_RANK ** -0.5),
        "mla_w_ukv": nrm((DEPTH, MLA_KV_RANK, N_HEADS * (MLA_NOPE + MLA_V)), MLA_KV_RANK ** -0.5),
        "mla_q_g": gain((DEPTH, MLA_NOPE + MLA_ROPE)),
        "mla_k_g": gain((DEPTH, MLA_NOPE + MLA_ROPE)),
        "moe_wg": nrm((DEPTH, D, N_GROUPS), D ** -0.5),
        "moe_bg": nrm((DEPTH, N_GROUPS), 0.01),
        "moe_we": nrm((DEPTH, D, N_EXPERTS), D ** -0.5),
        "moe_be": nrm((DEPTH, N_EXPERTS), 0.01),
        "moe_w_gate": nrm((DEPTH, N_EXPERTS, D, D_EXPERT), D ** -0.5),
        "moe_w_up": nrm((DEPTH, N_EXPERTS, D, D_EXPERT), D ** -0.5),
        "moe_w_down": nrm((DEPTH, N_EXPERTS, D_EXPERT, D), D_EXPERT ** -0.5),
    }


def reference(x, c, ctx, c_ctx, w_ada, b_ada, norm1_g, norm2_g, w_in, w_out,
              hgrn_lb_logits, hgrn_norm_g,
              hy_short_w, hy_short_b, hy_w1, hy_b1, hy_freq, hy_w2, hy_b2, hy_w3, hy_b3, hy_decay, hy_bias,
              na_rpb, na_q_g, na_k_g,
              mla_q_a_g, mla_kv_a_g, mla_w_uq, mla_w_ukv, mla_q_g, mla_k_g,
              moe_wg, moe_bg, moe_we, moe_be, moe_w_gate, moe_w_up, moe_w_down):
    B, L, D = x.shape
    lb_cum = jnp.cumsum(jax.nn.softmax(hgrn_lb_logits.astype(jnp.float32), axis=0), axis=0)
    lower_bounds = lb_cum - lb_cum[0:1]
    sc = jax.nn.silu(c)
    scc = jax.nn.silu(c_ctx)
    split_at = [int(s) for s in np.cumsum(IN_SPLITS)[:-1]]
    xc = ctx
    for l in range(DEPTH):
        need_ctx = l < DEPTH - 1
        mod = sc @ w_ada[l] + b_ada[l]
        modc = scc @ w_ada[l] + b_ada[l]
        sh1, s1, g1, sh2, s2, g2 = jnp.split(mod[:, None, :], 6, axis=-1)
        sh1c, s1c, g1c, sh2c, s2c, g2c = jnp.split(modc, 6, axis=-1)
        h = rmsnorm(x, norm1_g[l]) * (1 + s1) + sh1
        hc = rmsnorm(xc, norm1_g[l]) * (1 + s1c) + sh1c
        p = jnp.split(h @ w_in[l], split_at, axis=-1)
        pc = jnp.split(hc @ w_in[l], split_at, axis=-1)
        o_a, oc_a = hgrn_mixer(p[0], p[1], p[2], p[3], p[4], pc[0], pc[1], pc[2], pc[3], pc[4],
                               lower_bounds[l], hgrn_norm_g[l], need_ctx)
        hy_args = (hy_short_w[l], hy_short_b[l], hy_w1[l], hy_b1[l], hy_freq[l], hy_w2[l], hy_b2[l],
                   hy_w3[l], hy_b3[l], hy_decay[l], hy_bias[l])
        o_b = hyena_mixer(p[5], *hy_args)
        o_c, oc_c = na_mixer(p[6], pc[6], na_rpb[l], na_q_g[l], na_k_g[l], need_ctx)
        o_d, oc_d = mla_mixer(p[7], p[8], p[9], pc[7], pc[8], pc[9], mla_q_a_g[l], mla_kv_a_g[l],
                              mla_w_uq[l], mla_w_ukv[l], mla_q_g[l], mla_k_g[l], need_ctx)
        x = x + g1 * (jnp.concatenate([o_a, o_b, o_c, o_d], axis=-1) @ w_out[l])
        h2 = rmsnorm(x, norm2_g[l]) * (1 + s2) + sh2
        moe_args = (moe_wg[l], moe_bg[l], moe_we[l], moe_be[l], moe_w_gate[l], moe_w_up[l], moe_w_down[l])
        if need_ctx:
            oc_b = hyena_mixer(pc[5], *hy_args)
            xc = xc + g1c * (jnp.concatenate([oc_a, oc_b, oc_c, oc_d], axis=-1) @ w_out[l])
            h2c = rmsnorm(xc, norm2_g[l]) * (1 + s2c) + sh2c
            y = moe_ffn(jnp.concatenate([h2.reshape(-1, D), h2c.reshape(-1, D)], axis=0), *moe_args)
            x = x + g2 * y[:B * L].reshape(B, L, D)
            xc = xc + g2c * y[B * L:].reshape(xc.shape)
        else:
            x = x + g2 * moe_ffn(h2.reshape(-1, D), *moe_args).reshape(B, L, D)
    return x
```

```cpp
#include <hip/hip_runtime.h>
#include <stdint.h>
#include <stdio.h>

#ifndef MEGA
#define MEGA 0
#endif

#define DM 1024
#define NB 8
#define SEQ 2048
#define CTXL 256
#define NLAT (NB * SEQ)
#define NCTX (NB * CTXL)
#define TT (NLAT + NCTX)
#define DIN 3232
#define DEPTH 4
#define EPSF 1e-6f
#define C_HQ 0
#define C_ZF 256
#define C_ZB 512
#define C_HI 768
#define C_HG 1024
#define C_HY 1280
#define C_NA 2048
#define C_CQ 2816
#define C_CKV 3072
#define C_KR 3200

#define SMF 16384

struct Params {
    const float *x, *c, *ctx, *c_ctx, *w_ada, *b_ada, *norm1_g, *norm2_g, *w_in, *w_out, *lb_logits, *hgrn_norm_g;
    const float *hy_short_w, *hy_short_b, *hy_w1, *hy_b1, *hy_freq, *hy_w2, *hy_b2, *hy_w3, *hy_b3, *hy_decay, *hy_bias;
    const float *na_rpb, *na_q_g, *na_k_g, *mla_q_a_g, *mla_kv_a_g, *mla_w_uq, *mla_w_ukv, *mla_q_g, *mla_k_g;
    const float *moe_wg, *moe_bg, *moe_we, *moe_be, *moe_w_gate, *moe_w_up, *moe_w_down;
    float* out;
    unsigned* bar;
    int* cnt;
    float *X, *MOD, *LB, *HDN, *HYKL, *HYKC, *H, *P, *OF, *OB, *NQ, *NK, *MQ, *MK, *MV, *CAT, *EW, *GU, *YEXP;
    int* LIST;
};

#define XB_TMO      128
#define XB_XCNT(j)  (256  + 64 * (j))
#define XB_XSUB(j)  (1280 + 64 * (j))
#define XB_XGEN(j)  (2304 + 64 * (j))
#define XB_TOP      3328
#define XB_TOPGEN   3392
#define XCD_BAR_WORDS 3456
#define XB_SPIN_CAP (1u << 22)
#define LAS __attribute__((address_space(3)))

__device__ __forceinline__ unsigned xb_ld(unsigned* p)              { return __hip_atomic_load(p, __ATOMIC_RELAXED, __HIP_MEMORY_SCOPE_AGENT); }
__device__ __forceinline__ unsigned xb_add(unsigned* p, unsigned v) { return __hip_atomic_fetch_add(p, v, __ATOMIC_RELAXED, __HIP_MEMORY_SCOPE_AGENT); }
__device__ __forceinline__ unsigned xb_xcc_id() { return (unsigned)__builtin_amdgcn_s_getreg((3 << 11) | 20) & 0xFu; }
#define XB_SPIN(cond, bar) do { unsigned _sp = 0; while (cond) { __builtin_amdgcn_s_sleep(1); \
    if ((++_sp & 255u) == 0u) { if (xb_ld(&(bar)[XB_TMO])) break; if (_sp > XB_SPIN_CAP) { atomicAdd(&(bar)[XB_TMO], 1u); break; } } } } while (0)

struct XcdBarrier { unsigned* bar; unsigned x; volatile LAS unsigned* st; };

__device__ __forceinline__ XcdBarrier xcd_barrier_post(unsigned* bar, volatile LAS unsigned* st) {
    XcdBarrier b; b.bar = bar; b.x = xb_xcc_id(); b.st = st;
    if (threadIdx.x == 0) (void)xb_add(&bar[XB_XCNT(b.x)], 1u);
    return b;
}
__device__ __forceinline__ void xcd_barrier_complete(unsigned* bar, unsigned x, unsigned& nloc, unsigned& nx) {
    const unsigned G = gridDim.x * gridDim.y * gridDim.z;
    unsigned sum, cnt, mine, sp = 0u;
    for (;;) {
        sum = 0u; cnt = 0u; mine = 0u;
#pragma unroll
        for (unsigned j = 0; j < 16; ++j) { const unsigned c = xb_ld(&bar[XB_XCNT(j)]); sum += c; cnt += (c > 0u) ? 1u : 0u; mine = (j == x) ? c : mine; }
        if (sum == G) break;
        __builtin_amdgcn_s_sleep(1);
        if ((++sp & 255u) == 0u) { if (xb_ld(&bar[XB_TMO])) break; if (sp > XB_SPIN_CAP) { atomicAdd(&bar[XB_TMO], 1u); break; } }
    }
    nloc = mine > 0u ? mine : 1u; nx = cnt > 0u ? cnt : 1u;
}
__device__ __forceinline__ void xcd_barrier(const XcdBarrier& b) {
    asm volatile("s_waitcnt vmcnt(0)" ::: "memory");
    __syncthreads();
    if (threadIdx.x == 0) {
        unsigned* bar = b.bar;
        __builtin_amdgcn_s_waitcnt(0);
        unsigned nloc = b.st[0], nx = b.st[1];
        if (nloc == 0u) { xcd_barrier_complete(bar, b.x, nloc, nx); b.st[0] = nloc; b.st[1] = nx; }
        const unsigned old = xb_add(&bar[XB_XSUB(b.x)], 1u);
        const unsigned gen = old / nloc;
        if (old + 1u == (gen + 1u) * nloc) {
            __builtin_amdgcn_fence(__ATOMIC_RELEASE, "agent");
            asm volatile("s_waitcnt vmcnt(0)" ::: "memory");
            const unsigned og = xb_add(&bar[XB_TOP], 1u);
            const unsigned tg = og / nx;
            if (og + 1u == (tg + 1u) * nx) xb_add(&bar[XB_TOPGEN], 1u);
            else XB_SPIN(xb_ld(&bar[XB_TOPGEN]) == tg, bar);
            __builtin_amdgcn_fence(__ATOMIC_ACQUIRE, "agent");
            xb_add(&bar[XB_XGEN(b.x)], 1u);
            asm volatile("s_waitcnt vmcnt(0)" ::: "memory");
        } else {
            XB_SPIN(xb_ld(&bar[XB_XGEN(b.x)]) == gen, bar);
            __builtin_amdgcn_fence(__ATOMIC_ACQUIRE, "agent");
            asm volatile("s_waitcnt vmcnt(0)" ::: "memory");
        }
    }
    __syncthreads();
}

__device__ __forceinline__ float wave_sum(float v) {
#pragma unroll
    for (int o = 32; o > 0; o >>= 1) v += __shfl_xor(v, o);
    return v;
}
__device__ __forceinline__ float sigmoidf_(float z) { return 1.f / (1.f + __expf(-z)); }
__device__ __forceinline__ float siluf_(float z) { return z / (1.f + __expf(-z)); }
__device__ __forceinline__ int bidx_of(int row) { return row < NLAT ? (row >> 11) : 8; }

__device__ __forceinline__ float block_sum(float v, float* red) {
    v = wave_sum(v);
    __syncthreads();
    if ((threadIdx.x & 63) == 0) red[threadIdx.x >> 6] = v;
    __syncthreads();
    float r = red[0] + red[1] + red[2] + red[3];
    __syncthreads();
    return r;
}

template <class FA, class FB, class FE>
__device__ __forceinline__ void gemm_tile_f32(int K, float* sm, FA fa, FB fb, FE fe) {
    float* As = sm;
    float* Bs = sm + 16 * 68;
    const int tid = threadIdx.x, tx = tid & 15, ty = tid >> 4;
    float acc[4][4];
#pragma unroll
    for (int a = 0; a < 4; a++)
#pragma unroll
        for (int b = 0; b < 4; b++) acc[a][b] = 0.f;
    for (int k0 = 0; k0 < K; k0 += 16) {
#pragma unroll
        for (int q = 0; q < 4; q++) { int e = tid + 256 * q; int i = e >> 4, kk = e & 15; As[kk * 68 + i] = fa(i, k0 + kk); }
#pragma unroll
        for (int q = 0; q < 4; q++) { int e = tid + 256 * q; int kk = e >> 6, j = e & 63; Bs[kk * 68 + j] = fb(k0 + kk, j); }
        __syncthreads();
#pragma unroll
        for (int kk = 0; kk < 16; kk++) {
            float4 a4 = *(const float4*)&As[kk * 68 + ty * 4];
            float4 b4 = *(const float4*)&Bs[kk * 68 + tx * 4];
            float av[4] = {a4.x, a4.y, a4.z, a4.w}, bv[4] = {b4.x, b4.y, b4.z, b4.w};
#pragma unroll
            for (int a = 0; a < 4; a++)
#pragma unroll
                for (int b = 0; b < 4; b++) acc[a][b] += av[a] * bv[b];
        }
        __syncthreads();
    }
#pragma unroll
    for (int a = 0; a < 4; a++)
#pragma unroll
        for (int b = 0; b < 4; b++) fe(ty * 4 + a, tx * 4 + b, acc[a][b]);
}

__device__ void phase_pro1(const Params& p, float* sm) {
    const int tid = threadIdx.x, nth = blockDim.x * gridDim.x, gtid = blockIdx.x * blockDim.x + tid;
    {
        const float4* xs = (const float4*)p.x; const float4* cs = (const float4*)p.ctx; float4* X4 = (float4*)p.X;
        const int n1 = NLAT * 256, n2 = NCTX * 256;
        for (int i = gtid; i < n1 + n2; i += nth) X4[i] = i < n1 ? xs[i] : cs[i - n1];
    }
    for (int i = gtid; i < DEPTH * 32; i += nth) p.cnt[i] = 0;
    for (int i = gtid; i < 512; i += nth) {
        float z0 = p.lb_logits[i], z1 = p.lb_logits[512 + i], z2 = p.lb_logits[1024 + i], z3 = p.lb_logits[1536 + i];
        float m = fmaxf(fmaxf(z0, z1), fmaxf(z2, z3));
        float e0 = expf(z0 - m), e1 = expf(z1 - m), e2 = expf(z2 - m), e3 = expf(z3 - m);
        float inv = 1.f / (e0 + e1 + e2 + e3);
        p.LB[i] = 0.f; p.LB[512 + i] = e1 * inv; p.LB[1024 + i] = (e1 + e2) * inv; p.LB[1536 + i] = (e1 + e2 + e3) * inv;
    }
    for (int u = blockIdx.x; u < DEPTH * 96; u += gridDim.x) {
        const int l = u / 96, cg = u % 96;
        for (int i = tid; i < 9 * 1024; i += 256) { float v = i < 8192 ? p.c[i] : p.c_ctx[i - 8192]; sm[i] = siluf_(v); }
        __syncthreads();
        const int col = cg * 64 + (tid & 63), kq = tid >> 6;
        float acc[9];
#pragma unroll
        for (int r = 0; r < 9; r++) acc[r] = 0.f;
        const float* w = p.w_ada + (size_t)l * 1024 * 6144 + col;
        for (int k = kq * 256; k < kq * 256 + 256; k++) {
            float wv = w[(size_t)k * 6144];
#pragma unroll
            for (int r = 0; r < 9; r++) acc[r] += sm[r * 1024 + k] * wv;
        }
        float* red = sm + 9 * 1024;
#pragma unroll
        for (int r = 0; r < 9; r++) red[(kq * 9 + r) * 64 + (tid & 63)] = acc[r];
        __syncthreads();
        if (tid < 64) {
#pragma unroll
            for (int r = 0; r < 9; r++)
                p.MOD[(size_t)(l * 9 + r) * 6144 + col] = red[(0 * 9 + r) * 64 + tid] + red[(1 * 9 + r) * 64 + tid] + red[(2 * 9 + r) * 64 + tid] +
                                                          red[(3 * 9 + r) * 64 + tid] + p.b_ada[l * 6144 + col];
        }
        __syncthreads();
    }
    {
        const int wave = tid >> 6, lane = tid & 63;
        for (int wu = blockIdx.x * 4 + wave; wu < DEPTH * 2304; wu += gridDim.x * 4) {
            const int l = wu / 2304, rem = wu % 2304;
            const int which = rem >= 2048 ? 1 : 0;
            const int t = which ? rem - 2048 : rem;
            const int L = which ? 256 : 2048;
            const float tu = (float)t / (float)(L - 1);
            float feat = 0.f;
            if (lane == 0) feat = tu;
            else if (lane <= 32) {
                const int bi = (lane - 1) & 15;
                const float band = 1e-4f + (float)bi * ((15.f - 1e-4f) / 15.f);
                float uu = (float)t * band / (float)L;
                uu -= floorf(uu);
                float s_, c_;
                sincospif(2.f * uu, &s_, &c_);
                feat = lane <= 16 ? c_ : -s_;
            }
            const float fr = p.hy_freq[l * 64 + lane];
            float a = p.hy_b1[l * 64 + lane];
            for (int e = 0; e < 33; e++) a += __shfl(feat, e) * p.hy_w1[(l * 33 + e) * 64 + lane];
            const float h1 = sinf(fr * a);
            float a2 = p.hy_b2[l * 64 + lane];
            for (int i = 0; i < 64; i++) a2 += __shfl(h1, i) * p.hy_w2[(l * 64 + i) * 64 + lane];
            const float h2 = sinf(fr * a2);
            p.HDN[((size_t)(l * 2 + which) * 2048 + t) * 64 + lane] = h2;
        }
    }
}

template <int LL>
__device__ __forceinline__ void hyk_unit(const Params& p, int l, int o, int c, float* sm) {
    constexpr int NT = LL / 256;
    constexpr int which = (LL == 256) ? 1 : 0;
    const int tid = threadIdx.x;
    const int colf = o * 512 + c, colb = o * 512 + 256 + c;
    __syncthreads();
    if (tid < 64) { sm[tid] = p.hy_w3[(size_t)(l * 64 + tid) * 1024 + colf]; sm[64 + tid] = p.hy_w3[(size_t)(l * 64 + tid) * 1024 + colb]; }
    __syncthreads();
    const float bf = p.hy_b3[l * 1024 + colf], bb = p.hy_b3[l * 1024 + colb];
    const float df = p.hy_decay[((l * 2 + o) * 2 + 0) * 256 + c], dbw = p.hy_decay[((l * 2 + o) * 2 + 1) * 256 + c];
    float vf[NT], vb[NT];
    float ss = 0.f;
#pragma unroll
    for (int i = 0; i < NT; i++) {
        const int t = tid + 256 * i;
        const float* h = p.HDN + ((size_t)(l * 2 + which) * 2048 + t) * 64;
        float af = bf, ab = bb;
        for (int k = 0; k < 64; k++) { float hv = h[k]; af += hv * sm[k]; ab += hv * sm[64 + k]; }
        const float tu = (float)t / (float)(LL - 1);
        af *= expf(-tu * df); ab *= expf(-tu * dbw);
        vf[i] = af; vb[i] = ab;
        ss += af * af + (t > 0 ? ab * ab : 0.f);
    }
    const float tot = block_sum(ss, sm + 128);
    const float scale = rsqrtf(tot + EPSF);
    float* outp = (which ? p.HYKC : p.HYKL) + (size_t)((l * 2 + o) * 256 + c) * 2 * LL;
#pragma unroll
    for (int i = 0; i < NT; i++) { const int t = tid + 256 * i; outp[t] = vf[i] * scale; outp[LL + t] = vb[i] * scale; }
}
__device__ void phase_pro2(const Params& p, float* sm) {
    for (int u = blockIdx.x; u < 2 * DEPTH * 2 * 256; u += gridDim.x) {
        const int which = u / (DEPTH * 512), r = u % (DEPTH * 512);
        const int l = r / 512, o = (r / 256) & 1, c = r & 255;
        if (which == 0) hyk_unit<2048>(p, l, o, c, sm); else hyk_unit<256>(p, l, o, c, sm);
    }
}

__device__ void phase_norm1(const Params& p, int l, float* sm) {
    const int wave = threadIdx.x >> 6, lane = threadIdx.x & 63;
    for (int row = blockIdx.x * 4 + wave; row < TT; row += gridDim.x * 4) {
        const int bi = bidx_of(row);
        float4 xv[4];
        float ss = 0.f;
#pragma unroll
        for (int i = 0; i < 4; i++) {
            const int k = i * 256 + lane * 4;
            float4 v = *(const float4*)&p.X[(size_t)row * 1024 + k];
            if (l > 0) {
                const float4 g2 = *(const float4*)&p.MOD[(size_t)((l - 1) * 9 + bi) * 6144 + 5120 + k];
                const float4 y0 = *(const float4*)&p.YEXP[((size_t)row * 2 + 0) * 1024 + k];
                const float4 y1 = *(const float4*)&p.YEXP[((size_t)row * 2 + 1) * 1024 + k];
                v.x += g2.x * (y0.x + y1.x); v.y += g2.y * (y0.y + y1.y); v.z += g2.z * (y0.z + y1.z); v.w += g2.w * (y0.w + y1.w);
                *(float4*)&p.X[(size_t)row * 1024 + k] = v;
            }
            xv[i] = v;
            ss += v.x * v.x + v.y * v.y + v.z * v.z + v.w * v.w;
        }
        ss = wave_sum(ss);
        const float rstd = rsqrtf(ss * (1.f / 1024.f) + EPSF);
        const float* md = p.MOD + (size_t)(l * 9 + bi) * 6144;
#pragma unroll
        for (int i = 0; i < 4; i++) {
            const int k = i * 256 + lane * 4;
            const float4 g = *(const float4*)&p.norm1_g[l * 1024 + k];
            const float4 sh = *(const float4*)&md[k];
            const float4 sc = *(const float4*)&md[1024 + k];
            float4 o;
            o.x = xv[i].x * rstd * g.x * (1.f + sc.x) + sh.x;
            o.y = xv[i].y * rstd * g.y * (1.f + sc.y) + sh.y;
            o.z = xv[i].z * rstd * g.z * (1.f + sc.z) + sh.z;
            o.w = xv[i].w * rstd * g.w * (1.f + sc.w) + sh.w;
            *(float4*)&p.H[(size_t)row * 1024 + k] = o;
        }
    }
}

__device__ void phase_final(const Params& p, float* sm) {
    const int nth = blockDim.x * gridDim.x, gtid = blockIdx.x * blockDim.x + threadIdx.x;
    for (int i = gtid; i < NLAT * 256; i += nth) {
        const int row = i >> 8, k = (i & 255) * 4;
        const int bi = row >> 11;
        float4 v = *(const float4*)&p.X[(size_t)row * 1024 + k];
        const float4 g2 = *(const float4*)&p.MOD[(size_t)(3 * 9 + bi) * 6144 + 5120 + k];
        const float4 y0 = *(const float4*)&p.YEXP[((size_t)row * 2 + 0) * 1024 + k];
        const float4 y1 = *(const float4*)&p.YEXP[((size_t)row * 2 + 1) * 1024 + k];
        v.x += g2.x * (y0.x + y1.x); v.y += g2.y * (y0.y + y1.y); v.z += g2.z * (y0.z + y1.z); v.w += g2.w * (y0.w + y1.w);
        *(float4*)&p.out[(size_t)row * 1024 + k] = v;
    }
}

__device__ void phase_gemm1(const Params& p, int l, float* sm) {
    const int NTN = (DIN + 63) / 64;
    const float* W = p.w_in + (size_t)l * 1024 * DIN;
    for (int u = blockIdx.x; u < (TT / 64) * NTN; u += gridDim.x) {
        const int rb = u / NTN, cb = u % NTN;
        const int r0 = rb * 64, n0 = cb * 64;
        gemm_tile_f32(1024, sm,
            [&](int i, int k) { return p.H[(size_t)(r0 + i) * 1024 + k]; },
            [&](int k, int j) { return (n0 + j < DIN) ? W[(size_t)k * DIN + n0 + j] : 0.f; },
            [&](int i, int j, float v) { if (n0 + j < DIN) p.P[(size_t)(r0 + i) * DIN + n0 + j] = v; });
    }
}

__device__ void phase_prep(const Params& p, int l, float* sm) {
    const int tid = threadIdx.x, wave = tid >> 6, lane = tid & 63;
    float* a_cq = sm;
    float* a_ckv = sm + 2048;
    float* q_raw = sm + 3072;
    float* kv_raw = sm + 6144;
    float* krb = sm + 10240;
    float* kbuf = sm + 10496;
    for (int u = blockIdx.x; u < TT / 8; u += gridDim.x) {
        const int r0 = u * 8;
        __syncthreads();
        for (int it = wave; it < 64; it += 4) {
            const int tk = it >> 3, h = (it >> 1) & 3, wh = it & 1;
            const int row = r0 + tk;
            const float v = p.P[(size_t)row * DIN + C_NA + wh * 256 + h * 64 + lane];
            const float ss = wave_sum(v * v);
            const float g = wh ? p.na_k_g[l * 64 + lane] : p.na_q_g[l * 64 + lane];
            const float o = v * rsqrtf(ss * (1.f / 64.f) + EPSF) * g;
            (wh ? p.NK : p.NQ)[(size_t)row * 256 + h * 64 + lane] = o;
        }
        for (int tk = wave * 2; tk < wave * 2 + 2; tk++) {
            const int row = r0 + tk;
            const float4 v = *(const float4*)&p.P[(size_t)row * DIN + C_CQ + lane * 4];
            float ss = wave_sum(v.x * v.x + v.y * v.y + v.z * v.z + v.w * v.w);
            float rs = rsqrtf(ss * (1.f / 256.f) + EPSF);
            const float4 g = *(const float4*)&p.mla_q_a_g[l * 256 + lane * 4];
            a_cq[tk * 256 + lane * 4 + 0] = v.x * rs * g.x; a_cq[tk * 256 + lane * 4 + 1] = v.y * rs * g.y;
            a_cq[tk * 256 + lane * 4 + 2] = v.z * rs * g.z; a_cq[tk * 256 + lane * 4 + 3] = v.w * rs * g.w;
            const float2 w = *(const float2*)&p.P[(size_t)row * DIN + C_CKV + lane * 2];
            ss = wave_sum(w.x * w.x + w.y * w.y);
            rs = rsqrtf(ss * (1.f / 128.f) + EPSF);
            const float2 g2 = *(const float2*)&p.mla_kv_a_g[l * 128 + lane * 2];
            a_ckv[tk * 128 + lane * 2 + 0] = w.x * rs * g2.x; a_ckv[tk * 128 + lane * 2 + 1] = w.y * rs * g2.y;
            if (lane < 32) krb[tk * 32 + lane] = p.P[(size_t)row * DIN + C_KR + lane];
        }
        __syncthreads();
        for (int j = tid; j < 896; j += 256) {
            float acc[8];
#pragma unroll
            for (int t = 0; t < 8; t++) acc[t] = 0.f;
            if (j < 384) {
                const float* w = p.mla_w_uq + (size_t)l * 256 * 384 + j;
                for (int k = 0; k < 256; k++) {
                    const float wv = w[k * 384];
#pragma unroll
                    for (int t = 0; t < 8; t++) acc[t] += a_cq[t * 256 + k] * wv;
                }
#pragma unroll
                for (int t = 0; t < 8; t++) q_raw[t * 384 + j] = acc[t];
            } else {
                const int jj = j - 384;
                const float* w = p.mla_w_ukv + (size_t)l * 128 * 512 + jj;
                for (int k = 0; k < 128; k++) {
                    const float wv = w[k * 512];
#pragma unroll
                    for (int t = 0; t < 8; t++) acc[t] += a_ckv[t * 128 + k] * wv;
                }
#pragma unroll
                for (int t = 0; t < 8; t++) kv_raw[t * 512 + jj] = acc[t];
            }
        }
        __syncthreads();
        if (tid < 64) {
            const int isk = tid >> 5, it = tid & 31, tk = it >> 2, h = it & 3;
            const int row = r0 + tk;
            float* vec = isk ? (kbuf + (tk * 4 + h) * 96) : (q_raw + tk * 384 + h * 96);
            if (isk) {
                for (int e = 0; e < 64; e++) vec[e] = kv_raw[tk * 512 + h * 128 + e];
                for (int e = 0; e < 32; e++) vec[64 + e] = krb[tk * 32 + e];
            }
            float ss = 0.f;
            for (int e = 0; e < 96; e++) ss += vec[e] * vec[e];
            const float rs = rsqrtf(ss * (1.f / 96.f) + EPSF);
            const float* g = (isk ? p.mla_k_g : p.mla_q_g) + l * 96;
            for (int e = 0; e < 96; e++) vec[e] = vec[e] * rs * g[e];
            if (row < NLAT) {
                const int t = row & 2047;
                const float prow = (float)(t >> 6), pcol = (float)(t & 63);
                for (int half = 0; half < 2; half++) {
                    const float pos = half ? pcol : prow;
                    float* part = vec + 64 + half * 16;
                    for (int i = 0; i < 8; i++) {
                        const float inv = expf(-9.210340371976184f * (float)i * 0.125f);
                        float sn, cs;
                        sincosf(pos * inv, &sn, &cs);
                        const float a = part[i], b = part[8 + i];
                        part[i] = a * cs - b * sn;
                        part[8 + i] = a * sn + b * cs;
                    }
                }
            }
        }
        __syncthreads();
        for (int i = tid; i < 8 * 384; i += 256) {
            const int tk = i / 384, e = i % 384;
            p.MQ[(size_t)(r0 + tk) * 384 + e] = q_raw[i];
            p.MK[(size_t)(r0 + tk) * 384 + e] = kbuf[i];
        }
        for (int i = tid; i < 8 * 256; i += 256) {
            const int tk = i >> 8, e = i & 255, h = e >> 6, d = e & 63;
            p.MV[(size_t)(r0 + tk) * 256 + e] = kv_raw[tk * 512 + h * 128 + 64 + d];
        }
    }
}

template <int DQ>
__device__ __forceinline__ void attn_keys(const float (&q)[DQ], float& m, float& ls, float (&o)[64], const float* kb, int kstride,
                                          const float* vb, int vstride, int nkeys, float scale) {
    for (int j = 0; j < nkeys; j++) {
        const float* kp = kb + (size_t)j * kstride;
        const float* vp = vb + (size_t)j * vstride;
        float s = 0.f;
#pragma unroll
        for (int d = 0; d < DQ; d++) s += q[d] * kp[d];
        s *= scale;
        const float mn = fmaxf(m, s);
        const float corr = __expf(m - mn), pe = __expf(s - mn);
        ls = ls * corr + pe;
#pragma unroll
        for (int d = 0; d < 64; d++) o[d] = o[d] * corr + pe * vp[d];
        m = mn;
    }
}

__device__ __forceinline__ void hgrn_unit(const Params& p, int l, int u, float* sm) {
    const int tid = threadIdx.x, j = tid & 63, kq = tid >> 6;
    const int b = u >> 3, h = (u >> 1) & 3, dir = u & 1;
    float* st = sm;
    float* red = sm + 16 * 192;
    float lb[16], s[16];
#pragma unroll
    for (int i = 0; i < 16; i++) { lb[i] = p.LB[(l * 2 + dir) * 256 + h * 64 + kq * 16 + i]; s[i] = 0.f; }
    const int zoff = dir ? C_ZB : C_ZF;
    float* outp = dir ? p.OB : p.OF;
    __syncthreads();
    for (int n0 = 0; n0 < 2304; n0 += 16) {
        for (int e = tid; e < 16 * 192; e += 256) {
            const int stp = e / 192, w = e % 192;
            const int n = n0 + stp;
            int row;
            if (n < 256) row = NLAT + b * 256 + (dir ? 255 - n : n);
            else { const int mm = n - 256; row = b * 2048 + (dir ? 2047 - mm : mm); }
            const int part = w >> 6, ch = w & 63;
            const int col = part == 0 ? (C_HQ + h * 64 + ch) : (part == 1 ? (zoff + h * 64 + ch) : (C_HI + h * 64 + ch));
            st[e] = p.P[(size_t)row * DIN + col];
        }
        __syncthreads();
        for (int stp = 0; stp < 16; stp++) {
            const int n = n0 + stp;
            int row;
            if (n < 256) row = NLAT + b * 256 + (dir ? 255 - n : n);
            else { const int mm = n - 256; row = b * 2048 + (dir ? 2047 - mm : mm); }
            const float vj = st[stp * 192 + 128 + j];
            float part = 0.f;
#pragma unroll
            for (int i = 0; i < 16; i++) {
                const int k = kq * 16 + i;
                const float qv = st[stp * 192 + k];
                float z = st[stp * 192 + 64 + k];
                z = fminf(fmaxf(z, -30.f), 30.f);
                const float e_ = __expf(-z);
                const float sg = 1.f / (1.f + e_);
                const float f = lb[i] + (1.f - lb[i]) * sg;
                const float kk = (1.f - lb[i]) * (e_ * sg);
                s[i] = f * s[i] + kk * vj;
                part += s[i] * qv;
            }
            red[((n & 1) * 4 + kq) * 64 + j] = part;
            __syncthreads();
            if (kq == 0) {
                const float o = red[((n & 1) * 4 + 0) * 64 + j] + red[((n & 1) * 4 + 1) * 64 + j] + red[((n & 1) * 4 + 2) * 64 + j] +
                                red[((n & 1) * 4 + 3) * 64 + j];
                outp[(size_t)row * 256 + h * 64 + j] = o;
            }
        }
    }
}

template <int LL>
__device__ __forceinline__ void hyena_unit(const Params& p, int l, int b, int c, float* sm) {
    constexpr int NT = LL / 256;
    constexpr bool isctx = (LL == 256);
    const int tid = threadIdx.x;
    float* zs = sm;
    float* kc = sm + LL;
    const int rowbase = isctx ? NLAT + b * 256 : b * 2048;
    float z[NT], x1[NT], x2[NT];
#pragma unroll
    for (int i = 0; i < NT; i++) {
        const int t = tid + 256 * i;
        float val[3];
#pragma unroll
        for (int q = 0; q < 3; q++) {
            const int chn = q * 256 + c;
            const int col = C_HY + chn;
            const float um = t > 0 ? p.P[(size_t)(rowbase + t - 1) * DIN + col] : 0.f;
            const float u0 = p.P[(size_t)(rowbase + t) * DIN + col];
            const float up = t < LL - 1 ? p.P[(size_t)(rowbase + t + 1) * DIN + col] : 0.f;
            val[q] = p.hy_short_w[(l * 3 + 0) * 768 + chn] * um + p.hy_short_w[(l * 3 + 1) * 768 + chn] * u0 + p.hy_short_w[(l * 3 + 2) * 768 + chn] * up +
                     p.hy_short_b[l * 768 + chn];
        }
        z[i] = val[0]; x1[i] = val[1]; x2[i] = val[2];
    }
#pragma unroll
    for (int o = 0; o < 2; o++) {
        const float* kbase = (isctx ? p.HYKC : p.HYKL) + (size_t)((l * 2 + o) * 256 + c) * 2 * LL;
        __syncthreads();
        for (int i = tid; i < 2 * LL - 1; i += 256) { const int d = i - (LL - 1); kc[i] = d >= 0 ? kbase[d] : kbase[LL - d]; }
#pragma unroll
        for (int i = 0; i < NT; i++) zs[tid + 256 * i] = z[i];
        __syncthreads();
        float acc[NT];
#pragma unroll
        for (int i = 0; i < NT; i++) acc[i] = 0.f;
        for (int s = 0; s < LL; s++) {
            const float zv = zs[s];
#pragma unroll
            for (int i = 0; i < NT; i++) acc[i] += kc[(tid + 256 * i) - s + (LL - 1)] * zv;
        }
        const float dbv = p.hy_bias[(l * 2 + o) * 256 + c];
#pragma unroll
        for (int i = 0; i < NT; i++) z[i] = (o == 0 ? x1[i] : x2[i]) * (acc[i] + dbv * z[i]);
    }
#pragma unroll
    for (int i = 0; i < NT; i++) p.CAT[(size_t)(rowbase + tid + 256 * i) * 1024 + 256 + c] = z[i];
}

__device__ __forceinline__ void na_lat_wave(const Params& p, int l, int wu) {
    const int lane = threadIdx.x & 63;
    const int b = wu >> 7, h = (wu >> 5) & 3, r = wu & 31;
    const int row = b * 2048 + r * 64 + lane;
    float q[64], o[64];
#pragma unroll
    for (int d = 0; d < 64; d++) { q[d] = p.NQ[(size_t)row * 256 + h * 64 + d]; o[d] = 0.f; }
    float m = -1e30f, ls = 0.f;
    const int rs = min(max(r - 4, 0), 24);
    const int cs = min(max(lane - 8, 0), 48);
    const float* rpb = p.na_rpb + (size_t)(l * 4 + h) * 15 * 31;
    for (int jr = 0; jr < 8; jr++) {
        const int kr = rs + jr;
        const int dr = kr - r + 7;
        for (int kcol = 0; kcol < 64; kcol++) {
            const int krow = b * 2048 + kr * 64 + kcol;
            const float* kp = p.NK + (size_t)krow * 256 + h * 64;
            const float* vp = p.P + (size_t)krow * DIN + C_NA + 512 + h * 64;
            float s = 0.f;
#pragma unroll
            for (int d = 0; d < 64; d++) s += q[d] * kp[d];
            const int dc = min(max(kcol - lane + 15, 0), 30);
            s = s * 0.125f + rpb[dr * 31 + dc];
            const bool ok = (kcol >= cs) && (kcol < cs + 16);
            const float se = ok ? s : -1e30f;
            const float mn = fmaxf(m, se);
            const float corr = __expf(m - mn);
            const float pe = ok ? __expf(s - mn) : 0.f;
            ls = ls * corr + pe;
#pragma unroll
            for (int d = 0; d < 64; d++) o[d] = o[d] * corr + pe * vp[d];
            m = mn;
        }
    }
    attn_keys<64>(q, m, ls, o, p.NK + (size_t)(NLAT + b * 256) * 256 + h * 64, 256, p.P + (size_t)(NLAT + b * 256) * DIN + C_NA + 512 + h * 64, DIN, 256, 0.125f);
    const float inv = 1.f / ls;
#pragma unroll
    for (int d = 0; d < 64; d++) p.CAT[(size_t)row * 1024 + 512 + h * 64 + d] = o[d] * inv;
}
__device__ __forceinline__ void na_ctx_wave(const Params& p, int l, int wu) {
    const int lane = threadIdx.x & 63;
    const int b = wu >> 4, h = (wu >> 2) & 3, qb = wu & 3;
    const int row = NLAT + b * 256 + qb * 64 + lane;
    float q[64], o[64];
#pragma unroll
    for (int d = 0; d < 64; d++) { q[d] = p.NQ[(size_t)row * 256 + h * 64 + d]; o[d] = 0.f; }
    float m = -1e30f, ls = 0.f;
    attn_keys<64>(q, m, ls, o, p.NK + (size_t)(NLAT + b * 256) * 256 + h * 64, 256, p.P + (size_t)(NLAT + b * 256) * DIN + C_NA + 512 + h * 64, DIN, 256, 0.125f);
    const float inv = 1.f / ls;
#pragma unroll
    for (int d = 0; d < 64; d++) p.CAT[(size_t)row * 1024 + 512 + h * 64 + d] = o[d] * inv;
}
__device__ __forceinline__ void mla_wave(const Params& p, int l, int wu, bool isctx) {
    const int lane = threadIdx.x & 63;
    int b, h, qb;
    if (!isctx) { b = wu >> 7; h = (wu >> 5) & 3; qb = wu & 31; } else { b = wu >> 4; h = (wu >> 2) & 3; qb = wu & 3; }
    const int row = (isctx ? NLAT + b * 256 : b * 2048) + qb * 64 + lane;
    float q[96], o[64];
#pragma unroll
    for (int d = 0; d < 96; d++) q[d] = p.MQ[(size_t)row * 384 + h * 96 + d];
#pragma unroll
    for (int d = 0; d < 64; d++) o[d] = 0.f;
    float m = -1e30f, ls = 0.f;
    const float scale = 0.10206207261596577f;
    if (!isctx) attn_keys<96>(q, m, ls, o, p.MK + (size_t)(b * 2048) * 384 + h * 96, 384, p.MV + (size_t)(b * 2048) * 256 + h * 64, 256, 2048, scale);
    attn_keys<96>(q, m, ls, o, p.MK + (size_t)(NLAT + b * 256) * 384 + h * 96, 384, p.MV + (size_t)(NLAT + b * 256) * 256 + h * 64, 256, 256, scale);
    const float inv = 1.f / ls;
#pragma unroll
    for (int d = 0; d < 64; d++) p.CAT[(size_t)row * 1024 + 768 + h * 64 + d] = o[d] * inv;
}

__device__ void phase_mix(const Params& p, int l, float* sm) {
    const bool need_ctx = l < DEPTH - 1;
    const int wave = __builtin_amdgcn_readfirstlane(threadIdx.x >> 6);
    const int U_HG = 64;
    const int U_MLA = U_HG + 256;
    const int U_HYL = U_MLA + 2048;
    const int U_NA = U_HYL + 256;
    const int U_MLAC = U_NA + (need_ctx ? 32 : 0);
    const int U_NAC = U_MLAC + (need_ctx ? 32 : 0);
    const int U_HYC = U_NAC + (need_ctx ? 2048 : 0);
    for (int u = blockIdx.x; u < U_HYC; u += gridDim.x) {
        if (u < U_HG) hgrn_unit(p, l, u, sm);
        else if (u < U_MLA) mla_wave(p, l, (u - U_HG) * 4 + wave, false);
        else if (u < U_HYL) { const int v = u - U_MLA; hyena_unit<2048>(p, l, v >> 8, v & 255, sm); }
        else if (u < U_NA) na_lat_wave(p, l, (u - U_HYL) * 4 + wave);
        else if (u < U_MLAC) mla_wave(p, l, (u - U_NA) * 4 + wave, true);
        else if (u < U_NAC) na_ctx_wave(p, l, (u - U_MLAC) * 4 + wave);
        else { const int v = u - U_NAC; hyena_unit<256>(p, l, v >> 8, v & 255, sm); }
    }
}

__device__ void phase_hgout(const Params& p, int l, float* sm) {
    const int wave = threadIdx.x >> 6, lane = threadIdx.x & 63;
    const int nrows = (l < DEPTH - 1) ? TT : NLAT;
    for (int row = blockIdx.x * 4 + wave; row < nrows; row += gridDim.x * 4) {
        const float4 a = *(const float4*)&p.OF[(size_t)row * 256 + lane * 4];
        const float4 b = *(const float4*)&p.OB[(size_t)row * 256 + lane * 4];
        float4 o; o.x = a.x + b.x; o.y = a.y + b.y; o.z = a.z + b.z; o.w = a.w + b.w;
        float ss = o.x * o.x + o.y * o.y + o.z * o.z + o.w * o.w;
        ss += __shfl_xor(ss, 1); ss += __shfl_xor(ss, 2); ss += __shfl_xor(ss, 4); ss += __shfl_xor(ss, 8);
        const float rs = rsqrtf(ss * (1.f / 64.f) + EPSF);
        const float4 g = *(const float4*)&p.hgrn_norm_g[l * 64 + (lane & 15) * 4];
        const float4 gt = *(const float4*)&p.P[(size_t)row * DIN + C_HG + lane * 4];
        float4 r;
        r.x = o.x * rs * g.x * siluf_(gt.x); r.y = o.y * rs * g.y * siluf_(gt.y);
        r.z = o.z * rs * g.z * siluf_(gt.z); r.w = o.w * rs * g.w * siluf_(gt.w);
        *(float4*)&p.CAT[(size_t)row * 1024 + lane * 4] = r;
    }
}

__device__ void phase_gemm2(const Params& p, int l, float* sm) {
    const int nrows = (l < DEPTH - 1) ? TT : NLAT;
    const float* W = p.w_out + (size_t)l * 1024 * 1024;
    for (int u = blockIdx.x; u < (nrows / 64) * 16; u += gridDim.x) {
        const int rb = u >> 4, cb = u & 15;
        const int r0 = rb * 64, n0 = cb * 64;
        const float* g1 = p.MOD + (size_t)(l * 9 + bidx_of(r0)) * 6144 + 2048;
        gemm_tile_f32(1024, sm,
            [&](int i, int k) { return p.CAT[(size_t)(r0 + i) * 1024 + k]; },
            [&](int k, int j) { return W[(size_t)k * 1024 + n0 + j]; },
            [&](int i, int j, float v) { p.X[(size_t)(r0 + i) * 1024 + n0 + j] += g1[n0 + j] * v; });
    }
}

__device__ void phase_norm2(const Params& p, int l, float* sm) {
    const int wave = threadIdx.x >> 6, lane = threadIdx.x & 63;
    const int nrows = (l < DEPTH - 1) ? TT : NLAT;
    for (int row = blockIdx.x * 4 + wave; row < nrows; row += gridDim.x * 4) {
        const int bi = bidx_of(row);
        float4 xv[4];
        float ss = 0.f;
#pragma unroll
        for (int i = 0; i < 4; i++) {
            const int k = i * 256 + lane * 4;
            xv[i] = *(const float4*)&p.X[(size_t)row * 1024 + k];
            ss += xv[i].x * xv[i].x + xv[i].y * xv[i].y + xv[i].z * xv[i].z + xv[i].w * xv[i].w;
        }
        ss = wave_sum(ss);
        const float rstd = rsqrtf(ss * (1.f / 1024.f) + EPSF);
        const float* md = p.MOD + (size_t)(l * 9 + bi) * 6144;
        float acc[36];
#pragma unroll
        for (int c = 0; c < 36; c++) acc[c] = 0.f;
#pragma unroll
        for (int i = 0; i < 4; i++) {
            const int k = i * 256 + lane * 4;
            const float4 g = *(const float4*)&p.norm2_g[l * 1024 + k];
            const float4 sh = *(const float4*)&md[3072 + k];
            const float4 sc = *(const float4*)&md[4096 + k];
            float4 o;
            o.x = xv[i].x * rstd * g.x * (1.f + sc.x) + sh.x;
            o.y = xv[i].y * rstd * g.y * (1.f + sc.y) + sh.y;
            o.z = xv[i].z * rstd * g.z * (1.f + sc.z) + sh.z;
            o.w = xv[i].w * rstd * g.w * (1.f + sc.w) + sh.w;
            *(float4*)&p.H[(size_t)row * 1024 + k] = o;
            const float hv[4] = {o.x, o.y, o.z, o.w};
#pragma unroll
            for (int e = 0; e < 4; e++) {
                const float4 wg = *(const float4*)&p.moe_wg[(size_t)(l * 1024 + k + e) * 4];
                acc[0] += hv[e] * wg.x; acc[1] += hv[e] * wg.y; acc[2] += hv[e] * wg.z; acc[3] += hv[e] * wg.w;
                const float4* we = (const float4*)&p.moe_we[(size_t)(l * 1024 + k + e) * 32];
#pragma unroll
                for (int q = 0; q < 8; q++) {
                    const float4 w = we[q];
                    acc[4 + q * 4 + 0] += hv[e] * w.x; acc[4 + q * 4 + 1] += hv[e] * w.y; acc[4 + q * 4 + 2] += hv[e] * w.z; acc[4 + q * 4 + 3] += hv[e] * w.w;
                }
            }
        }
#pragma unroll
        for (int c = 0; c < 36; c++) acc[c] = wave_sum(acc[c]);
        if (lane == 0) {
            float lg[4];
#pragma unroll
            for (int c = 0; c < 4; c++) lg[c] = acc[c] + p.moe_bg[l * 4 + c];
            int gs = 0; float best = lg[0];
#pragma unroll
            for (int c = 1; c < 4; c++) if (lg[c] > best) { best = lg[c]; gs = c; }
            float den = 0.f;
#pragma unroll
            for (int c = 0; c < 4; c++) den += expf(lg[c] - best);
            const float psel = 1.f / den;
            float le[8];
#pragma unroll
            for (int i = 0; i < 8; i++) {
                const float a = gs == 0 ? acc[4 + i] : (gs == 1 ? acc[12 + i] : (gs == 2 ? acc[20 + i] : acc[28 + i]));
                le[i] = a + p.moe_be[l * 32 + gs * 8 + i];
            }
            int i1 = 0; float v1 = le[0];
#pragma unroll
            for (int i = 1; i < 8; i++) if (le[i] > v1) { v1 = le[i]; i1 = i; }
            int i2 = -1; float v2 = -3.0e38f;
#pragma unroll
            for (int i = 0; i < 8; i++) if (i != i1 && le[i] > v2) { v2 = le[i]; i2 = i; }
            const float e2 = expf(v2 - v1);
            const float w1 = psel / (1.f + e2), w2 = psel * e2 / (1.f + e2);
            const int ea = gs * 8 + i1, eb = gs * 8 + i2;
            const int n0 = row * 2, n1 = row * 2 + 1;
            p.EW[n0] = w1; p.EW[n1] = w2;
            const int pa = atomicAdd(&p.cnt[l * 32 + ea], 1);
            p.LIST[(size_t)ea * TT + pa] = n0;
            const int pb = atomicAdd(&p.cnt[l * 32 + eb], 1);
            p.LIST[(size_t)eb * TT + pb] = n1;
        }
    }
}

__device__ void phase_moe1(const Params& p, int l, float* sm) {
    int* offs = (int*)(sm + 4200);
    int* ns = (int*)(sm + 4096);
    __syncthreads();
    if (threadIdx.x == 0) { int a = 0; for (int e = 0; e < 32; e++) { offs[e] = a; a += (p.cnt[l * 32 + e] + 63) >> 6; } offs[32] = a; }
    __syncthreads();
    const int total = offs[32] * 16;
    for (int u = blockIdx.x; u < total; u += gridDim.x) {
        const int rbg = u >> 4, cb = u & 15;
        int e = 0;
        while (offs[e + 1] <= rbg) e++;
        const int rbi = rbg - offs[e];
        const int ce = p.cnt[l * 32 + e];
        __syncthreads();
        if (threadIdx.x < 64) { const int idx = rbi * 64 + threadIdx.x; ns[threadIdx.x] = idx < ce ? p.LIST[(size_t)e * TT + idx] : -1; }
        __syncthreads();
        const int col0 = cb * 64;
        const float* W = (col0 < 512 ? p.moe_w_gate : p.moe_w_up) + (size_t)(l * 32 + e) * 1024 * 512 + (col0 & 511);
        gemm_tile_f32(1024, sm,
            [&](int i, int k) { const int n = ns[i]; return n >= 0 ? p.H[(size_t)(n >> 1) * 1024 + k] : 0.f; },
            [&](int k, int j) { return W[(size_t)k * 512 + j]; },
            [&](int i, int j, float v) { const int n = ns[i]; if (n >= 0) p.GU[(size_t)n * 1024 + col0 + j] = v; });
    }
}
__device__ void phase_moe2(const Params& p, int l, float* sm) {
    int* offs = (int*)(sm + 4200);
    int* ns = (int*)(sm + 4096);
    __syncthreads();
    if (threadIdx.x == 0) { int a = 0; for (int e = 0; e < 32; e++) { offs[e] = a; a += (p.cnt[l * 32 + e] + 63) >> 6; } offs[32] = a; }
    __syncthreads();
    const int total = offs[32] * 16;
    for (int u = blockIdx.x; u < total; u += gridDim.x) {
        const int rbg = u >> 4, cb = u & 15;
        int e = 0;
        while (offs[e + 1] <= rbg) e++;
        const int rbi = rbg - offs[e];
        const int ce = p.cnt[l * 32 + e];
        __syncthreads();
        if (threadIdx.x < 64) { const int idx = rbi * 64 + threadIdx.x; ns[threadIdx.x] = idx < ce ? p.LIST[(size_t)e * TT + idx] : -1; }
        __syncthreads();
        const int col0 = cb * 64;
        const float* W = p.moe_w_down + (size_t)(l * 32 + e) * 512 * 1024 + col0;
        gemm_tile_f32(512, sm,
            [&](int i, int k) { const int n = ns[i]; if (n < 0) return 0.f; const float g = p.GU[(size_t)n * 1024 + k]; const float uu = p.GU[(size_t)n * 1024 + 512 + k]; return siluf_(g) * uu; },
            [&](int k, int j) { return W[(size_t)k * 1024 + j]; },
            [&](int i, int j, float v) { const int n = ns[i]; if (n >= 0) p.YEXP[(size_t)n * 1024 + col0 + j] = v * p.EW[n]; });
    }
}

enum { PH_PRO1 = 0, PH_PRO2, PH_NORM1, PH_GEMM1, PH_PREP, PH_MIX, PH_HGOUT, PH_GEMM2, PH_NORM2, PH_MOE1, PH_MOE2, PH_FINAL };

template <int PH>
__device__ __forceinline__ void run_phase(const Params& p, int l, float* sm) {
    if (PH == PH_PRO1) phase_pro1(p, sm);
    else if (PH == PH_PRO2) phase_pro2(p, sm);
    else if (PH == PH_NORM1) phase_norm1(p, l, sm);
    else if (PH == PH_GEMM1) phase_gemm1(p, l, sm);
    else if (PH == PH_PREP) phase_prep(p, l, sm);
    else if (PH == PH_MIX) phase_mix(p, l, sm);
    else if (PH == PH_HGOUT) phase_hgout(p, l, sm);
    else if (PH == PH_GEMM2) phase_gemm2(p, l, sm);
    else if (PH == PH_NORM2) phase_norm2(p, l, sm);
    else if (PH == PH_MOE1) phase_moe1(p, l, sm);
    else if (PH == PH_MOE2) phase_moe2(p, l, sm);
    else if (PH == PH_FINAL) phase_final(p, sm);
}

#if !MEGA
template <int PH>
__global__ void __launch_bounds__(256, 2) k_phase(Params p, int l) {
    __shared__ float sm[SMF];
    run_phase<PH>(p, l, sm);
}
#else
__global__ void __launch_bounds__(256, 2) k_mega(Params p) {
    __shared__ float sm[SMF];
    __shared__ uint4 xb_words;
    if (threadIdx.x == 0) xb_words = make_uint4(0u, 0u, 0u, 0u);
    __syncthreads();
    XcdBarrier bar = xcd_barrier_post(p.bar, (volatile LAS unsigned*)&xb_words);
    run_phase<PH_PRO1>(p, 0, sm); xcd_barrier(bar);
    run_phase<PH_PRO2>(p, 0, sm); xcd_barrier(bar);
    for (int l = 0; l < DEPTH; l++) {
        run_phase<PH_NORM1>(p, l, sm); xcd_barrier(bar);
        run_phase<PH_GEMM1>(p, l, sm); xcd_barrier(bar);
        run_phase<PH_PREP>(p, l, sm); xcd_barrier(bar);
        run_phase<PH_MIX>(p, l, sm); xcd_barrier(bar);
        run_phase<PH_HGOUT>(p, l, sm); xcd_barrier(bar);
        run_phase<PH_GEMM2>(p, l, sm); xcd_barrier(bar);
        run_phase<PH_NORM2>(p, l, sm); xcd_barrier(bar);
        run_phase<PH_MOE1>(p, l, sm); xcd_barrier(bar);
        run_phase<PH_MOE2>(p, l, sm); xcd_barrier(bar);
    }
    run_phase<PH_FINAL>(p, 0, sm);
}
#endif

static inline size_t align_up(size_t v, size_t a) { return (v + a - 1) / a * a; }

extern "C" void kernel_launch(void* const* d_in, const int* in_sizes, int n_in, void* d_out, int out_size, void* d_ws, size_t ws_size,
                              hipStream_t stream) {
    Params p{};
    const float* const* in = (const float* const*)d_in;
    p.x = in[0]; p.c = in[1]; p.ctx = in[2]; p.c_ctx = in[3]; p.w_ada = in[4]; p.b_ada = in[5]; p.norm1_g = in[6]; p.norm2_g = in[7];
    p.w_in = in[8]; p.w_out = in[9]; p.lb_logits = in[10]; p.hgrn_norm_g = in[11];
    p.hy_short_w = in[12]; p.hy_short_b = in[13]; p.hy_w1 = in[14]; p.hy_b1 = in[15]; p.hy_freq = in[16]; p.hy_w2 = in[17]; p.hy_b2 = in[18];
    p.hy_w3 = in[19]; p.hy_b3 = in[20]; p.hy_decay = in[21]; p.hy_bias = in[22];
    p.na_rpb = in[23]; p.na_q_g = in[24]; p.na_k_g = in[25];
    p.mla_q_a_g = in[26]; p.mla_kv_a_g = in[27]; p.mla_w_uq = in[28]; p.mla_w_ukv = in[29]; p.mla_q_g = in[30]; p.mla_k_g = in[31];
    p.moe_wg = in[32]; p.moe_bg = in[33]; p.moe_we = in[34]; p.moe_be = in[35]; p.moe_w_gate = in[36]; p.moe_w_up = in[37]; p.moe_w_down = in[38];
    p.out = (float*)d_out;

    char* base = (char*)d_ws;
    size_t off = 0;
    auto carve = [&](size_t bytes) { char* r = base + off; off = align_up(off + bytes, 256); return r; };
    p.bar = (unsigned*)carve(XCD_BAR_WORDS * 4);
    p.cnt = (int*)carve(DEPTH * 32 * 4);
    p.X = (float*)carve((size_t)TT * 1024 * 4);
    p.MOD = (float*)carve((size_t)DEPTH * 9 * 6144 * 4);
    p.LB = (float*)carve(DEPTH * 512 * 4);
    p.HDN = (float*)carve((size_t)DEPTH * 2 * 2048 * 64 * 4);
    p.HYKL = (float*)carve((size_t)DEPTH * 2 * 256 * 2 * 2048 * 4);
    p.HYKC = (float*)carve((size_t)DEPTH * 2 * 256 * 2 * 256 * 4);
    p.H = (float*)carve((size_t)TT * 1024 * 4);
    p.P = (float*)carve((size_t)TT * DIN * 4);
    p.OF = (float*)carve((size_t)TT * 256 * 4);
    p.OB = (float*)carve((size_t)TT * 256 * 4);
    p.NQ = (float*)carve((size_t)TT * 256 * 4);
    p.NK = (float*)carve((size_t)TT * 256 * 4);
    p.MQ = (float*)carve((size_t)TT * 384 * 4);
    p.MK = (float*)carve((size_t)TT * 384 * 4);
    p.MV = (float*)carve((size_t)TT * 256 * 4);
    p.CAT = (float*)carve((size_t)TT * 1024 * 4);
    p.EW = (float*)carve((size_t)TT * 2 * 4);
    p.LIST = (int*)carve((size_t)32 * TT * 4);
    p.GU = (float*)carve((size_t)TT * 2 * 1024 * 4);
    p.YEXP = (float*)carve((size_t)TT * 2 * 1024 * 4);
    if (off > ws_size) { fprintf(stderr, "workspace too small: need %zu have %zu\n", off, ws_size); return; }

#if !MEGA
    const int grid = 1024;
    k_phase<PH_PRO1><<<grid, 256, 0, stream>>>(p, 0);
    k_phase<PH_PRO2><<<grid, 256, 0, stream>>>(p, 0);
    for (int l = 0; l < DEPTH; l++) {
        k_phase<PH_NORM1><<<grid, 256, 0, stream>>>(p, l);
        k_phase<PH_GEMM1><<<grid, 256, 0, stream>>>(p, l);
        k_phase<PH_PREP><<<grid, 256, 0, stream>>>(p, l);
        k_phase<PH_MIX><<<grid, 256, 0, stream>>>(p, l);
        k_phase<PH_HGOUT><<<grid, 256, 0, stream>>>(p, l);
        k_phase<PH_GEMM2><<<grid, 256, 0, stream>>>(p, l);
        k_phase<PH_NORM2><<<grid, 256, 0, stream>>>(p, l);
        k_phase<PH_MOE1><<<grid, 256, 0, stream>>>(p, l);
        k_phase<PH_MOE2><<<grid, 256, 0, stream>>>(p, l);
    }
    k_phase<PH_FINAL><<<grid, 256, 0, stream>>>(p, 0);
#else
    static int grid = 0;
    if (!grid) {
        int dev = 0, cus = 0, per_cu = 0;
        hipGetDevice(&dev);
        hipDeviceGetAttribute(&cus, hipDeviceAttributeMultiprocessorCount, dev);
        hipOccupancyMaxActiveBlocksPerMultiprocessor(&per_cu, k_mega, 256, 0);
        if (per_cu > 2) per_cu = 2;
        if (per_cu < 1) per_cu = 1;
        grid = cus * per_cu;
    }
    hipMemsetAsync(p.bar, 0, XCD_BAR_WORDS * sizeof(unsigned), stream);
    k_mega<<<grid, 256, 0, stream>>>(p);
#endif
}
```

```cpp
#include <hip/hip_runtime.h>
#include <stdint.h>
#include <stdio.h>
#include <hip/hip_cooperative_groups.h>
#define USE_CG 0

#ifndef MEGA
#define MEGA 1
#endif

#define DM 1024
#define NB 8
#define SEQ 2048
#define CTXL 256
#define NLAT (NB * SEQ)
#define NCTX (NB * CTXL)
#define TT (NLAT + NCTX)
#define DIN 3232
#define DEPTH 4
#define EPSF 1e-6f
#define C_HQ 0
#define C_ZF 256
#define C_ZB 512
#define C_HI 768
#define C_HG 1024
#define C_HY 1280
#define C_NA 2048
#define C_CQ 2816
#define C_CKV 3072
#define C_KR 3200

#define SMF 17920

typedef unsigned short bf16_t;

struct Params {
    const float *x, *c, *ctx, *c_ctx, *w_ada, *b_ada, *norm1_g, *norm2_g, *w_in, *w_out, *lb_logits, *hgrn_norm_g;
    const float *hy_short_w, *hy_short_b, *hy_w1, *hy_b1, *hy_freq, *hy_w2, *hy_b2, *hy_w3, *hy_b3, *hy_decay, *hy_bias;
    const float *na_rpb, *na_q_g, *na_k_g, *mla_q_a_g, *mla_kv_a_g, *mla_w_uq, *mla_w_ukv, *mla_q_g, *mla_k_g;
    const float *moe_wg, *moe_bg, *moe_we, *moe_be, *moe_w_gate, *moe_w_up, *moe_w_down;
    float* out;
    char* ws;
    int rep[16];
};

#define XB_TMO      128
#define XB_XCNT(j)  (256  + 64 * (j))
#define XB_XSUB(j)  (1280 + 64 * (j))
#define XB_XGEN(j)  (2304 + 64 * (j))
#define XB_TOP      3328
#define XB_TOPGEN   3392
#define XCD_BAR_WORDS 3456
#define XB_SPIN_CAP (1u << 22)
#define LAS __attribute__((address_space(3)))

__device__ __forceinline__ unsigned xb_ld(unsigned* p)              { return __hip_atomic_load(p, __ATOMIC_RELAXED, __HIP_MEMORY_SCOPE_AGENT); }
__device__ __forceinline__ unsigned xb_add(unsigned* p, unsigned v) { return __hip_atomic_fetch_add(p, v, __ATOMIC_RELAXED, __HIP_MEMORY_SCOPE_AGENT); }
__device__ __forceinline__ unsigned xb_xcc_id() { return (unsigned)__builtin_amdgcn_s_getreg((3 << 11) | 20) & 0xFu; }
#define XB_SPIN(cond, bar) do { unsigned _sp = 0; while (cond) { __builtin_amdgcn_s_sleep(1); \
    if ((++_sp & 255u) == 0u) { if (xb_ld(&(bar)[XB_TMO])) break; if (_sp > XB_SPIN_CAP) { atomicAdd(&(bar)[XB_TMO], 1u); break; } } } } while (0)

struct XcdBarrier { unsigned* bar; unsigned x; volatile LAS unsigned* st; };

__device__ __forceinline__ XcdBarrier xcd_barrier_post(unsigned* bar, volatile LAS unsigned* st) {
    XcdBarrier b; b.bar = bar; b.x = xb_xcc_id(); b.st = st;
    if (threadIdx.x == 0) (void)xb_add(&bar[XB_XCNT(b.x)], 1u);
    return b;
}
__device__ __forceinline__ void xcd_barrier_complete(unsigned* bar, unsigned x, unsigned& nloc, unsigned& nx) {
    const unsigned G = gridDim.x * gridDim.y * gridDim.z;
    unsigned sum, cnt, mine, sp = 0u;
    for (;;) {
        sum = 0u; cnt = 0u; mine = 0u;
#pragma unroll
        for (unsigned j = 0; j < 16; ++j) { const unsigned c = xb_ld(&bar[XB_XCNT(j)]); sum += c; cnt += (c > 0u) ? 1u : 0u; mine = (j == x) ? c : mine; }
        if (sum == G) break;
        __builtin_amdgcn_s_sleep(1);
        if ((++sp & 255u) == 0u) { if (xb_ld(&bar[XB_TMO])) break; if (sp > XB_SPIN_CAP) { atomicAdd(&bar[XB_TMO], 1u); break; } }
    }
    nloc = mine > 0u ? mine : 1u; nx = cnt > 0u ? cnt : 1u;
}
__device__ __forceinline__ void xcd_barrier(const XcdBarrier& b) {
    asm volatile("s_waitcnt vmcnt(0)" ::: "memory");
    __syncthreads();
    if (threadIdx.x == 0) {
        unsigned* bar = b.bar;
        __builtin_amdgcn_s_waitcnt(0);
        unsigned nloc = b.st[0], nx = b.st[1];
        if (nloc == 0u) { xcd_barrier_complete(bar, b.x, nloc, nx); b.st[0] = nloc; b.st[1] = nx; }
        const unsigned old = xb_add(&bar[XB_XSUB(b.x)], 1u);
        const unsigned gen = old / nloc;
        if (old + 1u == (gen + 1u) * nloc) {
            __builtin_amdgcn_fence(__ATOMIC_RELEASE, "agent");
            asm volatile("s_waitcnt vmcnt(0)" ::: "memory");
            const unsigned og = xb_add(&bar[XB_TOP], 1u);
            const unsigned tg = og / nx;
            if (og + 1u == (tg + 1u) * nx) xb_add(&bar[XB_TOPGEN], 1u);
            else XB_SPIN(xb_ld(&bar[XB_TOPGEN]) == tg, bar);
            __builtin_amdgcn_fence(__ATOMIC_ACQUIRE, "agent");
            xb_add(&bar[XB_XGEN(b.x)], 1u);
            asm volatile("s_waitcnt vmcnt(0)" ::: "memory");
        } else {
            XB_SPIN(xb_ld(&bar[XB_XGEN(b.x)]) == gen, bar);
            __builtin_amdgcn_fence(__ATOMIC_ACQUIRE, "agent");
            asm volatile("s_waitcnt vmcnt(0)" ::: "memory");
        }
    }
    __syncthreads();
}

__device__ __forceinline__ int tid_opaque() { int t = threadIdx.x; asm volatile("" : "+v"(t)); return t; }
__device__ __forceinline__ int bid_opaque() { int t = blockIdx.x; asm volatile("" : "+s"(t)); return t; }
#define TIDX tid_opaque()
#define BIDX bid_opaque()
typedef __attribute__((ext_vector_type(8))) short bf16x8;
typedef __attribute__((ext_vector_type(4))) float f32x4;
typedef __attribute__((ext_vector_type(4))) unsigned u32x4;
typedef __attribute__((ext_vector_type(2))) __bf16 bf16x2_t;
__device__ __forceinline__ bf16_t f2bf(float f) { return __builtin_bit_cast(bf16_t, (__bf16)f); }
__device__ __forceinline__ float bf2f(bf16_t h) { return __uint_as_float(((unsigned)h) << 16); }
__device__ __forceinline__ unsigned pack2bf(float a, float b) { bf16x2_t v; v[0] = (__bf16)a; v[1] = (__bf16)b; return __builtin_bit_cast(unsigned, v); }
__device__ __forceinline__ float4 ld4bf(const bf16_t* p) { const uint2 u = *(const uint2*)p; float4 r; r.x = __uint_as_float(u.x << 16); r.y = __uint_as_float(u.x & 0xFFFF0000u); r.z = __uint_as_float(u.y << 16); r.w = __uint_as_float(u.y & 0xFFFF0000u); return r; }
__device__ __forceinline__ void st4bf(bf16_t* p, float4 v) { uint2 u; u.x = pack2bf(v.x, v.y); u.y = pack2bf(v.z, v.w); *(uint2*)p = u; }
__device__ __forceinline__ float wave_sum(float v) {
#pragma unroll
    for (int o = 32; o > 0; o >>= 1) v += __shfl_xor(v, o);
    return v;
}
__device__ __forceinline__ float sigmoidf_(float z) { return 1.f / (1.f + __expf(-z)); }
__device__ __forceinline__ float siluf_(float z) { return z / (1.f + __expf(-z)); }
__device__ __forceinline__ int bidx_of(int row) { return row < NLAT ? (row >> 11) : 8; }
__device__ __forceinline__ int kv_pos(int kidx) { const int w = kidx & 31; return (kidx & ~31) | (((w >> 2) & 3) * 8 + (w >> 4) * 4 + (w & 3)); }

__device__ __forceinline__ float block_sum(float v, float* red) {
    v = wave_sum(v);
    __syncthreads();
    if ((TIDX & 63) == 0) red[TIDX >> 6] = v;
    __syncthreads();
    float r = red[0] + red[1] + red[2] + red[3];
    __syncthreads();
    return r;
}

typedef __attribute__((address_space(1))) char gchar_t;
__device__ __forceinline__ gchar_t* ws_opaque(char* w) { gchar_t* g = (gchar_t*)w; asm volatile("" : "+s"(g)); return g; }
#define WQ_SLOTS 32
#define WQ_WORDS ((DEPTH + 1) * WQ_SLOTS * 16)
constexpr size_t ws_al(size_t v) { return (v + 255) / 256 * 256; }
#define WSB(p) ws_opaque((p).ws)
constexpr size_t OFF_bar = 0;
constexpr size_t OFF_cnt = ws_al(OFF_bar + ((XCD_BAR_WORDS + WQ_WORDS) * 4));
constexpr size_t OFF_X = ws_al(OFF_cnt + (DEPTH * 32 * 4));
constexpr size_t OFF_MOD = ws_al(OFF_X + ((size_t)TT * 1024 * 4));
constexpr size_t OFF_LB = ws_al(OFF_MOD + ((size_t)DEPTH * 9 * 6144 * 4));
constexpr size_t OFF_HDN = ws_al(OFF_LB + (DEPTH * 512 * 4));
constexpr size_t OFF_TW = ws_al(OFF_HDN + ((size_t)DEPTH * 2 * 2048 * 64 * 4));
constexpr size_t OFF_KSPEC = ws_al(OFF_TW + (4096 * 8));
constexpr size_t OFF_HYKC = ws_al(OFF_KSPEC + ((size_t)DEPTH * 2 * 256 * 4096 * 8));
constexpr size_t OFF_H = ws_al(OFF_HYKC + ((size_t)DEPTH * 2 * 256 * 2 * 256 * 4));
constexpr size_t OFF_P = ws_al(OFF_H + ((size_t)TT * 1024 * 2));
constexpr size_t OFF_OF = ws_al(OFF_P + ((size_t)TT * DIN * 2));
constexpr size_t OFF_HU = ws_al(OFF_OF + ((size_t)TT * 256 * 4));
constexpr size_t OFF_HQ = ws_al(OFF_HU + ((size_t)1152 * 2 * 4096 * 4));
constexpr size_t OFF_HD = ws_al(OFF_HQ + ((size_t)1152 * 2 * 4096 * 4));
constexpr size_t OFF_NQ = ws_al(OFF_HD + ((size_t)1152 * 2 * 64 * 4));
constexpr size_t OFF_NK = ws_al(OFF_NQ + ((size_t)TT * 256 * 2));
constexpr size_t OFF_NVT = ws_al(OFF_NK + ((size_t)TT * 256 * 2));
constexpr size_t OFF_MQ = ws_al(OFF_NVT + ((size_t)NB * 4 * 64 * 2304 * 2));
constexpr size_t OFF_MK = ws_al(OFF_MQ + ((size_t)TT * 384 * 2));
constexpr size_t OFF_MVT = ws_al(OFF_MK + ((size_t)TT * 384 * 2));
constexpr size_t OFF_CAT = ws_al(OFF_MVT + ((size_t)NB * 4 * 64 * 2304 * 2));
constexpr size_t OFF_EW = ws_al(OFF_CAT + ((size_t)TT * 1024 * 2));
constexpr size_t OFF_LIST = ws_al(OFF_EW + ((size_t)TT * 2 * 4));
constexpr size_t OFF_ACT = ws_al(OFF_LIST + ((size_t)32 * TT * 4));
constexpr size_t OFF_YEXP = ws_al(OFF_ACT + ((size_t)TT * 2 * 512 * 2));
constexpr size_t OFF_norm1_g = ws_al(OFF_YEXP + ((size_t)TT * 2 * 1024 * 4));
constexpr size_t OFF_norm2_g = ws_al(OFF_norm1_g + ((size_t)(DEPTH * 1024) * 4));
constexpr size_t OFF_hgrn_norm_g = ws_al(OFF_norm2_g + ((size_t)(DEPTH * 1024) * 4));
constexpr size_t OFF_hy_short_w = ws_al(OFF_hgrn_norm_g + ((size_t)(DEPTH * 64) * 4));
constexpr size_t OFF_hy_short_b = ws_al(OFF_hy_short_w + ((size_t)(DEPTH * 3 * 768) * 4));
constexpr size_t OFF_hy_bias = ws_al(OFF_hy_short_b + ((size_t)(DEPTH * 768) * 4));
constexpr size_t OFF_na_rpb = ws_al(OFF_hy_bias + ((size_t)(DEPTH * 2 * 256) * 4));
constexpr size_t OFF_na_q_g = ws_al(OFF_na_rpb + ((size_t)(DEPTH * 4 * 15 * 31) * 4));
constexpr size_t OFF_na_k_g = ws_al(OFF_na_q_g + ((size_t)(DEPTH * 64) * 4));
constexpr size_t OFF_mla_q_a_g = ws_al(OFF_na_k_g + ((size_t)(DEPTH * 64) * 4));
constexpr size_t OFF_mla_kv_a_g = ws_al(OFF_mla_q_a_g + ((size_t)(DEPTH * 256) * 4));
constexpr size_t OFF_mla_w_uq = ws_al(OFF_mla_kv_a_g + ((size_t)(DEPTH * 128) * 4));
constexpr size_t OFF_mla_w_ukv = ws_al(OFF_mla_w_uq + ((size_t)(DEPTH * 256 * 384) * 4));
constexpr size_t OFF_mla_q_g = ws_al(OFF_mla_w_ukv + ((size_t)(DEPTH * 128 * 512) * 4));
constexpr size_t OFF_mla_k_g = ws_al(OFF_mla_q_g + ((size_t)(DEPTH * 96) * 4));
constexpr size_t OFF_moe_wg = ws_al(OFF_mla_k_g + ((size_t)(DEPTH * 96) * 4));
constexpr size_t OFF_moe_bg = ws_al(OFF_moe_wg + ((size_t)(DEPTH * 1024 * 4) * 4));
constexpr size_t OFF_moe_we = ws_al(OFF_moe_bg + ((size_t)(DEPTH * 4) * 4));
constexpr size_t OFF_moe_be = ws_al(OFF_moe_we + ((size_t)(DEPTH * 1024 * 32) * 4));
constexpr size_t OFF_WUQT = ws_al(OFF_moe_be + ((size_t)(DEPTH * 32) * 4));
constexpr size_t OFF_WUKVT = ws_al(OFF_WUQT + (size_t)DEPTH * 384 * 256 * 2);
constexpr size_t OFF_ROPE = ws_al(OFF_WUKVT + (size_t)DEPTH * 512 * 128 * 2);
constexpr size_t OFF_SP = ws_al(OFF_ROPE + (size_t)2048 * 16 * 8);
constexpr size_t OFF_WINT = ws_al(OFF_SP + (size_t)1152 * 2 * 4096 * 4);
constexpr size_t OFF_WOUTT = ws_al(OFF_WINT + (size_t)DEPTH * DIN * 1024 * 2);
constexpr size_t WS_TOTAL = ws_al(OFF_WOUTT + (size_t)DEPTH * 1024 * 1024 * 2);
#define W_WINT ((bf16_t*)(WSB(p) + OFF_WINT))
#define W_WOUTT ((bf16_t*)(WSB(p) + OFF_WOUTT))
#define W_SP ((float*)(WSB(p) + OFF_SP))
#define W_WUQT ((bf16_t*)(WSB(p) + OFF_WUQT))
#define W_WUKVT ((bf16_t*)(WSB(p) + OFF_WUKVT))
#define W_ROPE ((float2*)(WSB(p) + OFF_ROPE))
#define W_bar ((unsigned*)(WSB(p) + OFF_bar))
#define W_cnt ((int*)(WSB(p) + OFF_cnt))
#define W_X ((float*)(WSB(p) + OFF_X))
#define W_MOD ((float*)(WSB(p) + OFF_MOD))
#define W_LB ((float*)(WSB(p) + OFF_LB))
#define W_HDN ((float*)(WSB(p) + OFF_HDN))
#define W_TW ((float2*)(WSB(p) + OFF_TW))
#define W_KSPEC ((float2*)(WSB(p) + OFF_KSPEC))
#define W_HYKC ((float*)(WSB(p) + OFF_HYKC))
#define W_H ((bf16_t*)(WSB(p) + OFF_H))
#define W_P ((bf16_t*)(WSB(p) + OFF_P))
#define W_OF ((float*)(WSB(p) + OFF_OF))
#define W_HU ((float*)(WSB(p) + OFF_HU))
#define W_HQ ((float*)(WSB(p) + OFF_HQ))
#define W_HD ((float*)(WSB(p) + OFF_HD))
#define W_NQ ((bf16_t*)(WSB(p) + OFF_NQ))
#define W_NK ((bf16_t*)(WSB(p) + OFF_NK))
#define W_NVT ((bf16_t*)(WSB(p) + OFF_NVT))
#define W_MQ ((bf16_t*)(WSB(p) + OFF_MQ))
#define W_MK ((bf16_t*)(WSB(p) + OFF_MK))
#define W_MVT ((bf16_t*)(WSB(p) + OFF_MVT))
#define W_CAT ((bf16_t*)(WSB(p) + OFF_CAT))
#define W_EW ((float*)(WSB(p) + OFF_EW))
#define W_LIST ((int*)(WSB(p) + OFF_LIST))
#define W_ACT ((bf16_t*)(WSB(p) + OFF_ACT))
#define W_YEXP ((bf16_t*)(WSB(p) + OFF_YEXP))
#define W_wq (W_bar + XCD_BAR_WORDS)
#define W_norm1_g ((const float*)(WSB(p) + OFF_norm1_g))
#define W_norm2_g ((const float*)(WSB(p) + OFF_norm2_g))
#define W_hgrn_norm_g ((const float*)(WSB(p) + OFF_hgrn_norm_g))
#define W_hy_short_w ((const float*)(WSB(p) + OFF_hy_short_w))
#define W_hy_short_b ((const float*)(WSB(p) + OFF_hy_short_b))
#define W_hy_bias ((const float*)(WSB(p) + OFF_hy_bias))
#define W_na_rpb ((const float*)(WSB(p) + OFF_na_rpb))
#define W_na_q_g ((const float*)(WSB(p) + OFF_na_q_g))
#define W_na_k_g ((const float*)(WSB(p) + OFF_na_k_g))
#define W_mla_q_a_g ((const float*)(WSB(p) + OFF_mla_q_a_g))
#define W_mla_kv_a_g ((const float*)(WSB(p) + OFF_mla_kv_a_g))
#define W_mla_w_uq ((const float*)(WSB(p) + OFF_mla_w_uq))
#define W_mla_w_ukv ((const float*)(WSB(p) + OFF_mla_w_ukv))
#define W_mla_q_g ((const float*)(WSB(p) + OFF_mla_q_g))
#define W_mla_k_g ((const float*)(WSB(p) + OFF_mla_k_g))
#define W_moe_wg ((const float*)(WSB(p) + OFF_moe_wg))
#define W_moe_bg ((const float*)(WSB(p) + OFF_moe_bg))
#define W_moe_we ((const float*)(WSB(p) + OFF_moe_we))
#define W_moe_be ((const float*)(WSB(p) + OFF_moe_be))

__device__ __forceinline__ int wq_next(unsigned* ctr, float* sm) {
    int* slot = (int*)(sm + SMF - 1);
    __syncthreads();
    if (TIDX == 0) *slot = (int)__hip_atomic_fetch_add(ctr, 1u, __ATOMIC_RELAXED, __HIP_MEMORY_SCOPE_AGENT);
    __syncthreads();
    return *slot;
}
#define WQ(p, l, site) (W_wq + (((l) + 1) * WQ_SLOTS + (site) + 16 * ((const int*)sm)[SMF - 2]) * 16)
template <class FA, class FB, class FE>
__device__ __forceinline__ void gemm_tile_f32(int K, float* sm, FA fa, FB fb, FE fe) {
    float* As = sm;
    float* Bs = sm + 16 * 68;
    const int tid = TIDX, tx = tid & 15, ty = tid >> 4;
    float acc[4][4];
#pragma unroll
    for (int a = 0; a < 4; a++)
#pragma unroll
        for (int b = 0; b < 4; b++) acc[a][b] = 0.f;
    for (int k0 = 0; k0 < K; k0 += 16) {
#pragma unroll
        for (int q = 0; q < 4; q++) { int e = tid + 256 * q; int i = e >> 4, kk = e & 15; As[kk * 68 + i] = fa(i, k0 + kk); }
#pragma unroll
        for (int q = 0; q < 4; q++) { int e = tid + 256 * q; int kk = e >> 6, j = e & 63; Bs[kk * 68 + j] = fb(k0 + kk, j); }
        __syncthreads();
#pragma unroll
        for (int kk = 0; kk < 16; kk++) {
            float4 a4 = *(const float4*)&As[kk * 68 + ty * 4];
            float4 b4 = *(const float4*)&Bs[kk * 68 + tx * 4];
            float av[4] = {a4.x, a4.y, a4.z, a4.w}, bv[4] = {b4.x, b4.y, b4.z, b4.w};
#pragma unroll
            for (int a = 0; a < 4; a++)
#pragma unroll
                for (int b = 0; b < 4; b++) acc[a][b] += av[a] * bv[b];
        }
        __syncthreads();
    }
#pragma unroll
    for (int a = 0; a < 4; a++)
#pragma unroll
        for (int b = 0; b < 4; b++) fe(ty * 4 + a, tx * 4 + b, acc[a][b]);
}


#define GEMM_LOAD(k0) { _Pragma("unroll") for (int i_ = 0; i_ < 4; i_++) ra[i_] = *(const u32x4*)(ap[i_] + (k0)); \
    _Pragma("unroll") for (int i_ = 0; i_ < 4; i_++) _Pragma("unroll") for (int j_ = 0; j_ < 8; j_++) rb[i_][j_] = bload((k0) + (bkg + 2 * i_) * 8 + j_, bn); }
#define GEMM_WRITE(buf) { char* As_ = smc + (buf) * 16384; char* Bs_ = smc + 32768 + (buf) * 16384; \
    _Pragma("unroll") for (int i_ = 0; i_ < 4; i_++) *(u32x4*)(As_ + (arow + 32 * i_) * 128 + ((ac ^ (arow & 7)) * 16)) = ra[i_]; \
    _Pragma("unroll") for (int i_ = 0; i_ < 4; i_++) { u32x4 b_; b_[0] = pack2bf(rb[i_][0], rb[i_][1]); b_[1] = pack2bf(rb[i_][2], rb[i_][3]); \
        b_[2] = pack2bf(rb[i_][4], rb[i_][5]); b_[3] = pack2bf(rb[i_][6], rb[i_][7]); \
        *(u32x4*)(Bs_ + bn * 128 + (((bkg + 2 * i_) ^ (bn & 7)) * 16)) = b_; } }
template <bool SWAP, class FA, class FB>
__device__ __forceinline__ void gemm128_main(int K, char* smc, FA arowp, FB bload, f32x4 (&acc)[4][4]) {
    const int tid = TIDX, lane = tid & 63, w = tid >> 6;
    const int wm = w >> 1, wn = w & 1, r16 = lane & 15, q = lane >> 4;
#pragma unroll
    for (int i = 0; i < 4; i++)
#pragma unroll
        for (int j = 0; j < 4; j++) acc[i][j] = (f32x4){0.f, 0.f, 0.f, 0.f};
    const int arow = tid >> 3, ac = tid & 7;
    const int bn = tid & 127, bkg = tid >> 7;
    const bf16_t* ap[4];
#pragma unroll
    for (int i = 0; i < 4; i++) ap[i] = arowp(arow + 32 * i) + ac * 8;
    u32x4 ra[4];
    float rb[4][8];
    GEMM_LOAD(0)
    __syncthreads();
    GEMM_WRITE(0)
    __syncthreads();
    const int KT = K >> 6;
    for (int kt = 0; kt < KT; kt++) {
        const bool more = (kt + 1 < KT);
        if (more) GEMM_LOAD((kt + 1) * 64)
        const char* As = smc + (kt & 1) * 16384;
        const char* Bs = smc + 32768 + (kt & 1) * 16384;
#pragma unroll
        for (int ks = 0; ks < 2; ks++) {
            bf16x8 af[4], bfr[4];
            const int sw = ((ks * 4 + q) ^ (r16 & 7)) * 16;
#pragma unroll
            for (int i = 0; i < 4; i++) af[i] = *(const bf16x8*)(As + (wm * 64 + i * 16 + r16) * 128 + sw);
#pragma unroll
            for (int j = 0; j < 4; j++) bfr[j] = *(const bf16x8*)(Bs + (wn * 64 + j * 16 + r16) * 128 + sw);
#pragma unroll
            for (int i = 0; i < 4; i++)
#pragma unroll
                for (int j = 0; j < 4; j++)
                    acc[i][j] = SWAP ? __builtin_amdgcn_mfma_f32_16x16x32_bf16(bfr[j], af[i], acc[i][j], 0, 0, 0)
                                     : __builtin_amdgcn_mfma_f32_16x16x32_bf16(af[i], bfr[j], acc[i][j], 0, 0, 0);
        }
        if (more) GEMM_WRITE((kt + 1) & 1)
        __syncthreads();
    }
}

#define GEMMBT_LOAD(k0) { _Pragma("unroll") for (int i_ = 0; i_ < 4; i_++) { ra[i_] = *(const u32x4*)(ap[i_] + (k0)); rbv[i_] = *(const u32x4*)(bp[i_] + (k0)); } }
#define GEMMBT_WRITE(buf) { char* As_ = smc + (buf) * 16384; char* Bs_ = smc + 32768 + (buf) * 16384; \
    _Pragma("unroll") for (int i_ = 0; i_ < 4; i_++) { *(u32x4*)(As_ + (arow + 32 * i_) * 128 + ((ac ^ (arow & 7)) * 16)) = ra[i_]; \
                                                      *(u32x4*)(Bs_ + (arow + 32 * i_) * 128 + ((ac ^ (arow & 7)) * 16)) = rbv[i_]; } }
#define GEMMBT_LOADS(k0, RA, RB) { _Pragma("unroll") for (int i_ = 0; i_ < 4; i_++) { RA[i_] = *(const u32x4*)(ap[i_] + (k0)); RB[i_] = *(const u32x4*)(bp[i_] + (k0)); } }
#define GEMMBT_WRITES(buf, RA, RB) { char* As_ = smc + (buf) * 16384; char* Bs_ = smc + 32768 + (buf) * 16384; \
    _Pragma("unroll") for (int i_ = 0; i_ < 4; i_++) { *(u32x4*)(As_ + (arow + 32 * i_) * 128 + ((ac ^ (arow & 7)) * 16)) = RA[i_]; \
                                                      *(u32x4*)(Bs_ + (arow + 32 * i_) * 128 + ((ac ^ (arow & 7)) * 16)) = RB[i_]; } }
#define GEMMBT_COMPUTE(buf) { const char* As = smc + (buf) * 16384; const char* Bs = smc + 32768 + (buf) * 16384; \
    _Pragma("unroll") for (int ks = 0; ks < 2; ks++) { bf16x8 af[4], bfr[4]; const int sw = ((ks * 4 + q) ^ (r16 & 7)) * 16; \
        _Pragma("unroll") for (int i = 0; i < 4; i++) af[i] = *(const bf16x8*)(As + (wm * 64 + i * 16 + r16) * 128 + sw); \
        _Pragma("unroll") for (int j = 0; j < 4; j++) bfr[j] = *(const bf16x8*)(Bs + (wn * 64 + j * 16 + r16) * 128 + sw); \
        _Pragma("unroll") for (int i = 0; i < 4; i++) _Pragma("unroll") for (int j = 0; j < 4; j++) \
            acc[i][j] = SWAP ? __builtin_amdgcn_mfma_f32_16x16x32_bf16(bfr[j], af[i], acc[i][j], 0, 0, 0) \
                             : __builtin_amdgcn_mfma_f32_16x16x32_bf16(af[i], bfr[j], acc[i][j], 0, 0, 0); } }
template <bool SWAP, class FA, class FBR>
__device__ __forceinline__ void gemm128_bt(int K, char* smc, FA arowp, FBR browp, f32x4 (&acc)[4][4]) {
    const int tid = TIDX, lane = tid & 63, w = tid >> 6;
    const int wm = w >> 1, wn = w & 1, r16 = lane & 15, q = lane >> 4;
#pragma unroll
    for (int i = 0; i < 4; i++)
#pragma unroll
        for (int j = 0; j < 4; j++) acc[i][j] = (f32x4){0.f, 0.f, 0.f, 0.f};
    const int arow = tid >> 3, ac = tid & 7;
    const bf16_t* ap[4];
    const bf16_t* bp[4];
#pragma unroll
    for (int i = 0; i < 4; i++) { ap[i] = arowp(arow + 32 * i) + ac * 8; bp[i] = browp(arow + 32 * i) + ac * 8; }
    u32x4 ra0[4], rb0[4], ra1[4], rb1[4];
    GEMMBT_LOADS(0, ra0, rb0)
    GEMMBT_LOADS(64, ra1, rb1)
    __syncthreads();
    GEMMBT_WRITES(0, ra0, rb0)
    __syncthreads();
    const int KT = K >> 6;
    for (int kt = 0; kt < KT; kt += 2) {
        if (kt + 2 < KT) GEMMBT_LOADS((kt + 2) * 64, ra0, rb0)
        GEMMBT_COMPUTE(0)
        GEMMBT_WRITES(1, ra1, rb1)
        __syncthreads();
        if (kt + 3 < KT) GEMMBT_LOADS((kt + 3) * 64, ra1, rb1)
        GEMMBT_COMPUTE(1)
        if (kt + 2 < KT) GEMMBT_WRITES(0, ra0, rb0)
        __syncthreads();
    }
}

#define FFT_PHYS(pos) ((pos) + ((pos) >> 4))
__device__ __forceinline__ float2 cmul(float2 a, float2 b) { return make_float2(a.x * b.x - a.y * b.y, a.x * b.y + a.y * b.x); }
__device__ __forceinline__ float2 cmulc(float2 a, float2 b) { return make_float2(a.x * b.x + a.y * b.y, a.y * b.x - a.x * b.y); }
__device__ __forceinline__ void dft4f(float2& a0, float2& a1, float2& a2, float2& a3) {
    const float2 t0 = make_float2(a0.x + a2.x, a0.y + a2.y), t1 = make_float2(a0.x - a2.x, a0.y - a2.y);
    const float2 t2 = make_float2(a1.x + a3.x, a1.y + a3.y), t3 = make_float2(a1.x - a3.x, a1.y - a3.y);
    a0 = make_float2(t0.x + t2.x, t0.y + t2.y);
    a1 = make_float2(t1.x + t3.y, t1.y - t3.x);
    a2 = make_float2(t0.x - t2.x, t0.y - t2.y);
    a3 = make_float2(t1.x - t3.y, t1.y + t3.x);
}
__device__ __forceinline__ void dft4i(float2& a0, float2& a1, float2& a2, float2& a3) {
    const float2 t0 = make_float2(a0.x + a2.x, a0.y + a2.y), t1 = make_float2(a0.x - a2.x, a0.y - a2.y);
    const float2 t2 = make_float2(a1.x + a3.x, a1.y + a3.y), t3 = make_float2(a1.x - a3.x, a1.y - a3.y);
    a0 = make_float2(t0.x + t2.x, t0.y + t2.y);
    a1 = make_float2(t1.x - t3.y, t1.y + t3.x);
    a2 = make_float2(t0.x - t2.x, t0.y - t2.y);
    a3 = make_float2(t1.x + t3.y, t1.y - t3.x);
}
template <int S> struct FftGeo { static constexpr int Ns = 4096 >> (2 * S), Ms = Ns / 4, Ms1 = Ms / 4; };
template <int S>
__device__ __forceinline__ int fft_phys_base(int tid) {
    if (S == 0) return tid + (tid >> 4);
    if (S == 2) return (tid >> 4) * 272 + (tid & 15);
    return tid * 17;
}
template <int S>
__device__ __forceinline__ constexpr int fft_phys_off(int r1, int r2) {
    return S == 0 ? 272 * (r1 * 4 + r2) : (S == 2 ? 68 * r1 + 17 * r2 : 4 * r1 + r2);
}
template <int S>
__device__ __forceinline__ void fft_fwd_pass(float2 (&v)[4][4], int tid, const float2* __restrict__ TW) {
    const int jp = tid % FftGeo<S>::Ms1;
#pragma unroll
    for (int r2 = 0; r2 < 4; r2++) {
        dft4f(v[0][r2], v[1][r2], v[2][r2], v[3][r2]);
        const float2 w = TW[((jp + r2 * FftGeo<S>::Ms1) << (2 * S)) & 4095];
        const float2 w2 = cmul(w, w), w3 = cmul(w2, w);
        v[1][r2] = cmul(v[1][r2], w); v[2][r2] = cmul(v[2][r2], w2); v[3][r2] = cmul(v[3][r2], w3);
    }
    if (S < 4) {
        const float2 w = TW[(jp << (2 * S + 2)) & 4095];
        const float2 w2 = cmul(w, w), w3 = cmul(w2, w);
#pragma unroll
        for (int q1 = 0; q1 < 4; q1++) {
            dft4f(v[q1][0], v[q1][1], v[q1][2], v[q1][3]);
            v[q1][1] = cmul(v[q1][1], w); v[q1][2] = cmul(v[q1][2], w2); v[q1][3] = cmul(v[q1][3], w3);
        }
    } else {
#pragma unroll
        for (int q1 = 0; q1 < 4; q1++) dft4f(v[q1][0], v[q1][1], v[q1][2], v[q1][3]);
    }
}
template <int S>
__device__ __forceinline__ void fft_inv_pass(float2 (&v)[4][4], int tid, const float2* __restrict__ TW) {
    const int jp = tid % FftGeo<S>::Ms1;
    if (S < 4) {
        const float2 w = TW[(jp << (2 * S + 2)) & 4095];
        const float2 w2 = cmul(w, w), w3 = cmul(w2, w);
#pragma unroll
        for (int q1 = 0; q1 < 4; q1++) {
            v[q1][1] = cmulc(v[q1][1], w); v[q1][2] = cmulc(v[q1][2], w2); v[q1][3] = cmulc(v[q1][3], w3);
            dft4i(v[q1][0], v[q1][1], v[q1][2], v[q1][3]);
        }
    } else {
#pragma unroll
        for (int q1 = 0; q1 < 4; q1++) dft4i(v[q1][0], v[q1][1], v[q1][2], v[q1][3]);
    }
#pragma unroll
    for (int r2 = 0; r2 < 4; r2++) {
        const float2 w = TW[((jp + r2 * FftGeo<S>::Ms1) << (2 * S)) & 4095];
        const float2 w2 = cmul(w, w), w3 = cmul(w2, w);
        v[1][r2] = cmulc(v[1][r2], w); v[2][r2] = cmulc(v[2][r2], w2); v[3][r2] = cmulc(v[3][r2], w3);
        dft4i(v[0][r2], v[1][r2], v[2][r2], v[3][r2]);
    }
}
template <int S>
__device__ __forceinline__ void fft_lds_read(float2 (&v)[4][4], int tid, const float2* fb) {
    const float2* fbb = fb + fft_phys_base<S>(tid);
#pragma unroll
    for (int r1 = 0; r1 < 4; r1++)
#pragma unroll
        for (int r2 = 0; r2 < 4; r2++) v[r1][r2] = fbb[fft_phys_off<S>(r1, r2)];
}
template <int S>
__device__ __forceinline__ void fft_lds_write(const float2 (&v)[4][4], int tid, float2* fb) {
    float2* fbb = fb + fft_phys_base<S>(tid);
#pragma unroll
    for (int r1 = 0; r1 < 4; r1++)
#pragma unroll
        for (int r2 = 0; r2 < 4; r2++) fbb[fft_phys_off<S>(r1, r2)] = v[r1][r2];
}

__device__ void phase_pro1(const Params& p, float* sm) {
    const int tid = TIDX, nth = blockDim.x * gridDim.x, gtid = BIDX * blockDim.x + tid;
    for (int i = gtid; i < DEPTH * 32; i += nth) W_cnt[i] = 0;
    for (int i = gtid; i < 4096; i += nth) { float sn, cs; sincospif((float)i * (1.f / 2048.f), &sn, &cs); W_TW[i] = make_float2(cs, -sn); }
    for (int i = gtid; i < 512; i += nth) {
        float z0 = p.lb_logits[i], z1 = p.lb_logits[512 + i], z2 = p.lb_logits[1024 + i], z3 = p.lb_logits[1536 + i];
        float m = fmaxf(fmaxf(z0, z1), fmaxf(z2, z3));
        float e0 = expf(z0 - m), e1 = expf(z1 - m), e2 = expf(z2 - m), e3 = expf(z3 - m);
        float inv = 1.f / (e0 + e1 + e2 + e3);
        W_LB[i] = 0.f; W_LB[512 + i] = e1 * inv; W_LB[1024 + i] = (e1 + e2) * inv; W_LB[1536 + i] = (e1 + e2 + e3) * inv;
    }
    for (int i = gtid; i < DEPTH * 384 * 256; i += nth) {
        const int k = i & 255, n = (i >> 8) % 384, ll = i / (384 * 256);
        ((bf16_t*)(p.ws + OFF_WUQT))[i] = f2bf(p.mla_q_a_g[ll * 256 + k] * p.mla_w_uq[(size_t)(ll * 256 + k) * 384 + n]);
    }
    for (int i = gtid; i < DEPTH * 512 * 128; i += nth) {
        const int k = i & 127, n = (i >> 7) & 511, ll = i >> 16;
        ((bf16_t*)(p.ws + OFF_WUKVT))[i] = f2bf(p.mla_kv_a_g[ll * 128 + k] * p.mla_w_ukv[(size_t)(ll * 128 + k) * 512 + n]);
    }
    for (int i = gtid; i < 2048 * 16; i += nth) {
        const int t = i >> 4, j = i & 15;
        const float pos = j < 8 ? (float)(t >> 6) : (float)(t & 63);
        const float inv = expf(-9.210340371976184f * (float)(j & 7) * 0.125f);
        float sn, cs;
        sincosf(pos * inv, &sn, &cs);
        ((float2*)(p.ws + OFF_ROPE))[i] = make_float2(cs, sn);
    }
    {
        const int NT_IN = DEPTH * 16 * 51, NT_OUT = DEPTH * 16 * 16;
        for (int u = wq_next(WQ(p, -1, 2), sm); u < NT_IN + NT_OUT; u = wq_next(WQ(p, -1, 2), sm)) {
            const float* src; bf16_t* dst; int N, kt, nt;
            if (u < NT_IN) { const int ll = u / (16 * 51), r = u % (16 * 51); kt = r / 51; nt = r % 51; N = DIN; src = p.w_in + (size_t)ll * 1024 * DIN; dst = (bf16_t*)(p.ws + OFF_WINT) + (size_t)ll * DIN * 1024; }
            else { const int v = u - NT_IN; const int ll = v >> 8, r = v & 255; kt = r >> 4; nt = r & 15; N = 1024; src = p.w_out + (size_t)ll * 1024 * 1024; dst = (bf16_t*)(p.ws + OFF_WOUTT) + (size_t)ll * 1024 * 1024; }
#pragma unroll
            for (int i = 0; i < 4; i++) {
                const int idx = tid + 256 * i, kr = idx >> 4, c4 = idx & 15;
                const int n = nt * 64 + c4 * 4;
                float4 v = make_float4(0.f, 0.f, 0.f, 0.f);
                if (n < N) v = *(const float4*)&src[(size_t)(kt * 64 + kr) * N + n];
                sm[kr * 68 + c4 * 4 + 0] = v.x; sm[kr * 68 + c4 * 4 + 1] = v.y; sm[kr * 68 + c4 * 4 + 2] = v.z; sm[kr * 68 + c4 * 4 + 3] = v.w;
            }
            __syncthreads();
#pragma unroll
            for (int i = 0; i < 2; i++) {
                const int idx = tid + 256 * i, nr = idx >> 3, c8 = idx & 7;
                const int n = nt * 64 + nr;
                if (n < N) {
                    u32x4 o;
                    o[0] = pack2bf(sm[(c8 * 8 + 0) * 68 + nr], sm[(c8 * 8 + 1) * 68 + nr]); o[1] = pack2bf(sm[(c8 * 8 + 2) * 68 + nr], sm[(c8 * 8 + 3) * 68 + nr]);
                    o[2] = pack2bf(sm[(c8 * 8 + 4) * 68 + nr], sm[(c8 * 8 + 5) * 68 + nr]); o[3] = pack2bf(sm[(c8 * 8 + 6) * 68 + nr], sm[(c8 * 8 + 7) * 68 + nr]);
                    *(u32x4*)&dst[(size_t)n * 1024 + kt * 64 + c8 * 8] = o;
                }
            }
        }
    }
    for (int i = gtid; i < (DEPTH * 1024); i += nth) ((float*)(WSB(p) + OFF_norm1_g))[i] = p.norm1_g[i];
    for (int i = gtid; i < (DEPTH * 1024); i += nth) ((float*)(WSB(p) + OFF_norm2_g))[i] = p.norm2_g[i];
    for (int i = gtid; i < (DEPTH * 64); i += nth) ((float*)(WSB(p) + OFF_hgrn_norm_g))[i] = p.hgrn_norm_g[i];
    for (int i = gtid; i < (DEPTH * 3 * 768); i += nth) ((float*)(WSB(p) + OFF_hy_short_w))[i] = p.hy_short_w[i];
    for (int i = gtid; i < (DEPTH * 768); i += nth) ((float*)(WSB(p) + OFF_hy_short_b))[i] = p.hy_short_b[i];
    for (int i = gtid; i < (DEPTH * 2 * 256); i += nth) ((float*)(WSB(p) + OFF_hy_bias))[i] = p.hy_bias[i];
    for (int i = gtid; i < (DEPTH * 4 * 15 * 31); i += nth) ((float*)(WSB(p) + OFF_na_rpb))[i] = p.na_rpb[i];
    for (int i = gtid; i < (DEPTH * 64); i += nth) ((float*)(WSB(p) + OFF_na_q_g))[i] = p.na_q_g[i];
    for (int i = gtid; i < (DEPTH * 64); i += nth) ((float*)(WSB(p) + OFF_na_k_g))[i] = p.na_k_g[i];
    for (int i = gtid; i < (DEPTH * 256); i += nth) ((float*)(WSB(p) + OFF_mla_q_a_g))[i] = p.mla_q_a_g[i];
    for (int i = gtid; i < (DEPTH * 128); i += nth) ((float*)(WSB(p) + OFF_mla_kv_a_g))[i] = p.mla_kv_a_g[i];
    for (int i = gtid; i < (DEPTH * 256 * 384); i += nth) ((float*)(WSB(p) + OFF_mla_w_uq))[i] = p.mla_w_uq[i];
    for (int i = gtid; i < (DEPTH * 128 * 512); i += nth) ((float*)(WSB(p) + OFF_mla_w_ukv))[i] = p.mla_w_ukv[i];
    for (int i = gtid; i < (DEPTH * 96); i += nth) ((float*)(WSB(p) + OFF_mla_q_g))[i] = p.mla_q_g[i];
    for (int i = gtid; i < (DEPTH * 96); i += nth) ((float*)(WSB(p) + OFF_mla_k_g))[i] = p.mla_k_g[i];
    for (int i = gtid; i < (DEPTH * 1024 * 4); i += nth) ((float*)(WSB(p) + OFF_moe_wg))[i] = p.moe_wg[i];
    for (int i = gtid; i < (DEPTH * 4); i += nth) ((float*)(WSB(p) + OFF_moe_bg))[i] = p.moe_bg[i];
    for (int i = gtid; i < (DEPTH * 1024 * 32); i += nth) ((float*)(WSB(p) + OFF_moe_we))[i] = p.moe_we[i];
    for (int i = gtid; i < (DEPTH * 32); i += nth) ((float*)(WSB(p) + OFF_moe_be))[i] = p.moe_be[i];
    for (int u = wq_next(WQ(p, -1, 0), sm); u < DEPTH * 96; u = wq_next(WQ(p, -1, 0), sm)) {
        const int l = u / 96, cg = u % 96;
        for (int i = tid; i < 9 * 1024; i += 256) { float v = i < 8192 ? p.c[i] : p.c_ctx[i - 8192]; sm[i] = siluf_(v); }
        __syncthreads();
        const int col = cg * 64 + (tid & 63), kq = tid >> 6;
        float acc[9];
#pragma unroll
        for (int r = 0; r < 9; r++) acc[r] = 0.f;
        const float* w = p.w_ada + (size_t)l * 1024 * 6144 + col;
        for (int k = kq * 256; k < kq * 256 + 256; k++) {
            float wv = w[(size_t)k * 6144];
#pragma unroll
            for (int r = 0; r < 9; r++) acc[r] += sm[r * 1024 + k] * wv;
        }
        float* red = sm + 9 * 1024;
#pragma unroll
        for (int r = 0; r < 9; r++) red[(kq * 9 + r) * 64 + (tid & 63)] = acc[r];
        __syncthreads();
        if (tid < 64) {
#pragma unroll
            for (int r = 0; r < 9; r++)
                W_MOD[(size_t)(l * 9 + r) * 6144 + col] = red[(0 * 9 + r) * 64 + tid] + red[(1 * 9 + r) * 64 + tid] + red[(2 * 9 + r) * 64 + tid] +
                                                          red[(3 * 9 + r) * 64 + tid] + p.b_ada[l * 6144 + col];
        }
        __syncthreads();
    }
    {
        const int wave = tid >> 6, lane = tid & 63;
        for (int wu = BIDX * 4 + wave; wu < DEPTH * 2304; wu += gridDim.x * 4) {
            const int l = wu / 2304, rem = wu % 2304;
            const int which = rem >= 2048 ? 1 : 0;
            const int t = which ? rem - 2048 : rem;
            const int L = which ? 256 : 2048;
            const float tu = (float)t / (float)(L - 1);
            float feat = 0.f;
            if (lane == 0) feat = tu;
            else if (lane <= 32) {
                const int bi = (lane - 1) & 15;
                const float band = 1e-4f + (float)bi * ((15.f - 1e-4f) / 15.f);
                float uu = (float)t * band / (float)L;
                uu -= floorf(uu);
                float s_, c_;
                sincospif(2.f * uu, &s_, &c_);
                feat = lane <= 16 ? c_ : -s_;
            }
            const float fr = p.hy_freq[l * 64 + lane];
            float a = p.hy_b1[l * 64 + lane];
            for (int e = 0; e < 33; e++) a += __shfl(feat, e) * p.hy_w1[(l * 33 + e) * 64 + lane];
            const float h1 = sinf(fr * a);
            float a2 = p.hy_b2[l * 64 + lane];
            for (int i = 0; i < 64; i++) a2 += __shfl(h1, i) * p.hy_w2[(l * 64 + i) * 64 + lane];
            const float h2 = sinf(fr * a2);
            W_HDN[((size_t)(l * 2 + which) * 2048 + t) * 64 + lane] = h2;
        }
    }
}

template <int LL>
__device__ __forceinline__ void hyk_unit(const Params& p, int l, int o, int c, float* sm) {
    constexpr int NT = LL / 256;
    constexpr int which = (LL == 256) ? 1 : 0;
    const int tid = TIDX;
    const int colf = o * 512 + c, colb = o * 512 + 256 + c;
    __syncthreads();
    if (tid < 64) { sm[tid] = p.hy_w3[(size_t)(l * 64 + tid) * 1024 + colf]; sm[64 + tid] = p.hy_w3[(size_t)(l * 64 + tid) * 1024 + colb]; }
    __syncthreads();
    const float bf = p.hy_b3[l * 1024 + colf], bb = p.hy_b3[l * 1024 + colb];
    const float df = p.hy_decay[((l * 2 + o) * 2 + 0) * 256 + c], dbw = p.hy_decay[((l * 2 + o) * 2 + 1) * 256 + c];
    float vf[NT], vb[NT];
    float ss = 0.f;
#pragma unroll
    for (int i = 0; i < NT; i++) {
        const int t = tid + 256 * i;
        const float* h = W_HDN + ((size_t)(l * 2 + which) * 2048 + t) * 64;
        float af = bf, ab = bb;
#pragma unroll 4
        for (int k = 0; k < 64; k++) { float hv = h[k]; af += hv * sm[k]; ab += hv * sm[64 + k]; }
        const float tu = (float)t / (float)(LL - 1);
        af *= expf(-tu * df); ab *= expf(-tu * dbw);
        vf[i] = af; vb[i] = ab;
        ss += af * af + (t > 0 ? ab * ab : 0.f);
    }
    const float tot = block_sum(ss, sm + 128);
    const float scale = rsqrtf(tot + EPSF);
    if (which) {
        float* outp = W_HYKC + (size_t)((l * 2 + o) * 256 + c) * 2 * LL;
#pragma unroll
        for (int i = 0; i < NT; i++) { const int t = tid + 256 * i; outp[t] = vf[i] * scale; outp[LL + t] = vb[i] * scale; }
    } else {
        float* kl = sm + 256;
        float2* fb = (float2*)(sm + 256 + 4096);
#pragma unroll
        for (int i = 0; i < NT; i++) {
            const int t = tid + 256 * i;
            kl[t] = vf[i] * scale;
            if (t > 0) kl[4096 - t] = vb[i] * scale;
        }
        if (tid == 0) kl[2048] = 0.f;
        __syncthreads();
        float2 v[4][4];
#pragma unroll
        for (int r1 = 0; r1 < 4; r1++)
#pragma unroll
            for (int r2 = 0; r2 < 4; r2++) v[r1][r2] = make_float2(kl[tid + 256 * (r1 * 4 + r2)], 0.f);
        fft_fwd_pass<0>(v, tid, W_TW);
        fft_lds_write<0>(v, tid, fb);
        __syncthreads();
        fft_lds_read<2>(v, tid, fb);
        fft_fwd_pass<2>(v, tid, W_TW);
        fft_lds_write<2>(v, tid, fb);
        __syncthreads();
        fft_lds_read<4>(v, tid, fb);
        fft_fwd_pass<4>(v, tid, W_TW);
        float2* outp = W_KSPEC + (size_t)((l * 2 + o) * 256 + c) * 4096 + tid * 16;
#pragma unroll
        for (int r1 = 0; r1 < 4; r1++)
#pragma unroll
            for (int r2 = 0; r2 < 4; r2++) outp[r1 * 4 + r2] = make_float2(v[r1][r2].x * (1.f / 4096.f), v[r1][r2].y * (1.f / 4096.f));
    }
}
__device__ void phase_pro2(const Params& p, float* sm) {
    for (int u = wq_next(WQ(p, -1, 1), sm); u < DEPTH * 512 + (DEPTH - 1) * 512; u = wq_next(WQ(p, -1, 1), sm)) {
        const int which = u / (DEPTH * 512), r = u % (DEPTH * 512);
        const int l = r / 512, o = (r / 256) & 1, c = r & 255;
        if (which == 0) hyk_unit<2048>(p, l, o, c, sm); else hyk_unit<256>(p, l, o, c, sm);
    }
}

__device__ void phase_norm1(const Params& p, int l, float* sm) {
    const int wave = TIDX >> 6, lane = TIDX & 63;
    for (int row = BIDX * 4 + wave; row < TT; row += gridDim.x * 4) {
        const int bi = bidx_of(row);
        float4 xv[4];
        float ss = 0.f;
#pragma unroll
        for (int i = 0; i < 4; i++) {
            const int k = i * 256 + lane * 4;
            const float* xsrc = l > 0 ? &W_X[(size_t)row * 1024 + k] : (row < NLAT ? &p.x[(size_t)row * 1024 + k] : &p.ctx[(size_t)(row - NLAT) * 1024 + k]);
            float4 v = *(const float4*)xsrc;
            if (l > 0) {
                const float4 g2 = *(const float4*)&W_MOD[(size_t)((l - 1) * 9 + bi) * 6144 + 5120 + k];
                const float4 y0 = ld4bf(&W_YEXP[((size_t)row * 2 + 0) * 1024 + k]);
                const float4 y1 = ld4bf(&W_YEXP[((size_t)row * 2 + 1) * 1024 + k]);
                v.x += g2.x * (y0.x + y1.x); v.y += g2.y * (y0.y + y1.y); v.z += g2.z * (y0.z + y1.z); v.w += g2.w * (y0.w + y1.w);
                *(float4*)&W_X[(size_t)row * 1024 + k] = v;
            }
            xv[i] = v;
            ss += v.x * v.x + v.y * v.y + v.z * v.z + v.w * v.w;
        }
        ss = wave_sum(ss);
        const float rstd = rsqrtf(ss * (1.f / 1024.f) + EPSF);
        const float* md = W_MOD + (size_t)(l * 9 + bi) * 6144;
#pragma unroll
        for (int i = 0; i < 4; i++) {
            const int k = i * 256 + lane * 4;
            const float4 g = *(const float4*)&W_norm1_g[l * 1024 + k];
            const float4 sh = *(const float4*)&md[k];
            const float4 sc = *(const float4*)&md[1024 + k];
            float4 o;
            o.x = xv[i].x * rstd * g.x * (1.f + sc.x) + sh.x;
            o.y = xv[i].y * rstd * g.y * (1.f + sc.y) + sh.y;
            o.z = xv[i].z * rstd * g.z * (1.f + sc.z) + sh.z;
            o.w = xv[i].w * rstd * g.w * (1.f + sc.w) + sh.w;
            st4bf(&W_H[(size_t)row * 1024 + k], o);
        }
    }
}

__device__ void phase_final(const Params& p, float* sm) {
    const int nth = blockDim.x * gridDim.x, gtid = BIDX * blockDim.x + TIDX;
    for (int i = gtid; i < NLAT * 256; i += nth) {
        const int row = i >> 8, k = (i & 255) * 4;
        const int bi = row >> 11;
        float4 v = *(const float4*)&W_X[(size_t)row * 1024 + k];
        const float4 g2 = *(const float4*)&W_MOD[(size_t)(3 * 9 + bi) * 6144 + 5120 + k];
        const float4 y0 = ld4bf(&W_YEXP[((size_t)row * 2 + 0) * 1024 + k]);
        const float4 y1 = ld4bf(&W_YEXP[((size_t)row * 2 + 1) * 1024 + k]);
        v.x += g2.x * (y0.x + y1.x); v.y += g2.y * (y0.y + y1.y); v.z += g2.z * (y0.z + y1.z); v.w += g2.w * (y0.w + y1.w);
        *(float4*)&p.out[(size_t)row * 1024 + k] = v;
    }
}

__device__ void phase_gemm1(const Params& p, int l, float* sm) {
    const int NTN = (DIN + 127) / 128;
    const float* W = p.w_in + (size_t)l * 1024 * DIN;
    const int tid = TIDX, lane = tid & 63, w = tid >> 6, wm = w >> 1, wn = w & 1, r16 = lane & 15, q = lane >> 4;
    for (int u = wq_next(WQ(p, l, 0), sm); u < 144 * 4 * 7; u = wq_next(WQ(p, l, 0), sm)) {
        const int band = u / (144 * 4), rem = u % (144 * 4);
        const int bw = min(4, NTN - band * 4);
        const int rb = rem / bw, cb = band * 4 + rem % bw;
        if (rb >= 144) continue;
        const int r0 = rb * 128, n0 = cb * 128;
        f32x4 acc[4][4];
        const bf16_t* hb = W_H + (size_t)r0 * 1024;
        const bf16_t* wb = W_WINT + (size_t)l * DIN * 1024;
        gemm128_bt<true>(1024, (char*)sm, [&](int r) { return hb + (size_t)r * 1024; },
                         [&](int r) { return wb + (size_t)min(n0 + r, DIN - 1) * 1024; }, acc);
#pragma unroll
        for (int i = 0; i < 4; i++)
#pragma unroll
            for (int j = 0; j < 4; j++) {
                const int m = r0 + wm * 64 + i * 16 + r16, n = n0 + wn * 64 + j * 16 + q * 4;
                if (n < DIN) st4bf(&W_P[(size_t)m * DIN + n], make_float4(acc[i][j][0], acc[i][j][1], acc[i][j][2], acc[i][j][3]));
            }
    }
}

__device__ void phase_prep_main(const Params& p, int l, float* sm);
__device__ __forceinline__ void hgrn_local_unit(const Params& p, int l, int u, float* sm);
__device__ void phase_prep(const Params& p, int l, float* sm) {
    const bool main_first = (BIDX >> 8) & 1;
    if (main_first) phase_prep_main(p, l, sm);
    for (int u = wq_next(WQ(p, l, 1), sm); u < 1152; u = wq_next(WQ(p, l, 1), sm)) hgrn_local_unit(p, l, u, sm);
    if (!main_first) phase_prep_main(p, l, sm);
}
__device__ void phase_prep_main(const Params& p, int l, float* sm) {
    const int tid = TIDX, lane = tid & 63, w = tid >> 6, r16 = lane & 15, q4 = lane >> 4;
    char* smc = (char*)sm;
    char* Acq = smc;
    char* Ackv = smc + 8448;
    float* R = (float*)(smc + 12800);
    float* krf = (float*)(smc + 12800 + 16 * 516 * 4);
    float* rsq = krf + 512;
    float* rskv = rsq + 16;
    for (int u = wq_next(WQ(p, l, 2), sm); u < TT / 16; u = wq_next(WQ(p, l, 2), sm)) {
        const int r0 = u * 16;
        const bool lat = r0 < NLAT;
        const int bb = lat ? (r0 >> 11) : ((r0 - NLAT) >> 8);
        const int kidx0 = lat ? (r0 & 2047) : 2048 + ((r0 - NLAT) & 255);
        const int posb = (kidx0 & ~31) + ((kidx0 >> 4) & 1) * 4;
        const bf16_t* Pb = W_P + (size_t)r0 * DIN;
        {
            for (int c = tid; c < 512; c += 256) { const int row = c >> 5, cc = c & 31; *(u32x4*)(Acq + row * 528 + cc * 16) = *(const u32x4*)(Pb + (size_t)row * DIN + C_CQ + cc * 8); }
            { const int row = tid >> 4, cc = tid & 15; *(u32x4*)(Ackv + row * 272 + cc * 16) = *(const u32x4*)(Pb + (size_t)row * DIN + C_CKV + cc * 8); }
            for (int i = tid; i < 512; i += 256) krf[i] = bf2f(Pb[(size_t)(i >> 5) * DIN + C_KR + (i & 31)]);
        }
        {
            const float4 gq = *(const float4*)&W_na_q_g[l * 64 + r16 * 4];
            const float4 gk = *(const float4*)&W_na_k_g[l * 64 + r16 * 4];
#pragma unroll 2
            for (int ps = 0; ps < 8; ps++) {
                const int item = ps * 16 + (tid >> 4);
                const int tk = item >> 3, h = (item >> 1) & 3, wh = item & 1;
                const float4 v = ld4bf(Pb + (size_t)tk * DIN + C_NA + wh * 256 + h * 64 + r16 * 4);
                float ss = v.x * v.x + v.y * v.y + v.z * v.z + v.w * v.w;
                ss += __shfl_xor(ss, 1); ss += __shfl_xor(ss, 2); ss += __shfl_xor(ss, 4); ss += __shfl_xor(ss, 8);
                const float rs = rsqrtf(ss * (1.f / 64.f) + EPSF);
                const float4 g = wh ? gk : gq;
                st4bf((wh ? W_NK : W_NQ) + (size_t)(r0 + tk) * 256 + h * 64 + r16 * 4, make_float4(v.x * rs * g.x, v.y * rs * g.y, v.z * rs * g.z, v.w * rs * g.w));
            }
            const int h = tid >> 6, d = tid & 63;
            bf16_t* dst = W_NVT + (size_t)((bb * 4 + h) * 64 + d) * 2304 + posb;
#pragma unroll
            for (int qq = 0; qq < 4; qq++) {
                const bf16_t* src = Pb + (size_t)(qq * 4) * DIN + C_NA + 512 + h * 64 + d;
                uint2 pk;
                pk.x = (unsigned)src[0] | ((unsigned)src[DIN] << 16);
                pk.y = (unsigned)src[2 * DIN] | ((unsigned)src[3 * DIN] << 16);
                *(uint2*)(dst + qq * 8) = pk;
            }
        }
        __syncthreads();
        {
            const int tk = w * 4 + q4;
            float ss = 0.f;
#pragma unroll
            for (int j = 0; j < 2; j++) { const float4 a = ld4bf((const bf16_t*)(Acq + tk * 528) + r16 * 16 + j * 8), b = ld4bf((const bf16_t*)(Acq + tk * 528) + r16 * 16 + j * 8 + 4);
                ss += a.x * a.x + a.y * a.y + a.z * a.z + a.w * a.w + b.x * b.x + b.y * b.y + b.z * b.z + b.w * b.w; }
            ss += __shfl_xor(ss, 1); ss += __shfl_xor(ss, 2); ss += __shfl_xor(ss, 4); ss += __shfl_xor(ss, 8);
            float s2 = 0.f;
            { const float4 a = ld4bf((const bf16_t*)(Ackv + tk * 272) + r16 * 8), b = ld4bf((const bf16_t*)(Ackv + tk * 272) + r16 * 8 + 4);
              s2 = a.x * a.x + a.y * a.y + a.z * a.z + a.w * a.w + b.x * b.x + b.y * b.y + b.z * b.z + b.w * b.w; }
            s2 += __shfl_xor(s2, 1); s2 += __shfl_xor(s2, 2); s2 += __shfl_xor(s2, 4); s2 += __shfl_xor(s2, 8);
            if (r16 == 0) { rsq[tk] = rsqrtf(ss * (1.f / 256.f) + EPSF); rskv[tk] = rsqrtf(s2 * (1.f / 128.f) + EPSF); }
        }
        __syncthreads();
        {
            const bf16_t* WB = W_WUQT + (size_t)l * 384 * 256;
            const float rs = rsq[r16];
#pragma unroll 2
            for (int it = 0; it < 6; it++) {
                const int nt = it * 4 + w;
                f32x4 acc = (f32x4){0.f, 0.f, 0.f, 0.f};
#pragma unroll
                for (int ks = 0; ks < 8; ks++) {
                    const bf16x8 bfr = *(const bf16x8*)(WB + (size_t)(nt * 16 + r16) * 256 + ks * 32 + q4 * 8);
                    const bf16x8 afr = *(const bf16x8*)(Acq + r16 * 528 + ks * 64 + q4 * 16);
                    acc = __builtin_amdgcn_mfma_f32_16x16x32_bf16(bfr, afr, acc, 0, 0, 0);
                }
                *(float4*)&R[r16 * 516 + nt * 16 + q4 * 4] = make_float4(acc[0] * rs, acc[1] * rs, acc[2] * rs, acc[3] * rs);
            }
        }
        __syncthreads();
        {
            const int tk = w * 4 + q4;
            const int trow = r0 + tk;
            const float* gq = W_mla_q_g + l * 96;
            const float2* rp = W_ROPE + (size_t)(trow & 2047) * 16;
#pragma unroll 1
            for (int h = 0; h < 4; h++) {
                float v[6];
                float ss = 0.f;
#pragma unroll
                for (int m = 0; m < 6; m++) { v[m] = R[tk * 516 + h * 96 + m * 16 + r16]; ss += v[m] * v[m]; }
                ss += __shfl_xor(ss, 1); ss += __shfl_xor(ss, 2); ss += __shfl_xor(ss, 4); ss += __shfl_xor(ss, 8);
                const float rs = rsqrtf(ss * (1.f / 96.f) + EPSF);
#pragma unroll
                for (int m = 0; m < 6; m++) v[m] = v[m] * rs * gq[m * 16 + r16];
                if (lat) {
#pragma unroll
                    for (int m = 4; m < 6; m++) {
                        const float other = __shfl_xor(v[m], 8);
                        const float2 cs = rp[(m - 4) * 8 + (r16 & 7)];
                        v[m] = (r16 < 8) ? (v[m] * cs.x - other * cs.y) : (other * cs.y + v[m] * cs.x);
                    }
                }
                bf16_t* dst = W_MQ + (size_t)trow * 384 + h * 96;
#pragma unroll
                for (int m = 0; m < 6; m++) dst[m * 16 + r16] = f2bf(v[m]);
            }
        }
        __syncthreads();
        {
            const bf16_t* WB = W_WUKVT + (size_t)l * 512 * 128;
            const float rs = rskv[r16];
#pragma unroll 2
            for (int it = 0; it < 8; it++) {
                const int nt = it * 4 + w;
                f32x4 acc = (f32x4){0.f, 0.f, 0.f, 0.f};
#pragma unroll
                for (int ks = 0; ks < 4; ks++) {
                    const bf16x8 bfr = *(const bf16x8*)(WB + (size_t)(nt * 16 + r16) * 128 + ks * 32 + q4 * 8);
                    const bf16x8 afr = *(const bf16x8*)(Ackv + r16 * 272 + ks * 64 + q4 * 16);
                    acc = __builtin_amdgcn_mfma_f32_16x16x32_bf16(bfr, afr, acc, 0, 0, 0);
                }
                *(float4*)&R[r16 * 516 + nt * 16 + q4 * 4] = make_float4(acc[0] * rs, acc[1] * rs, acc[2] * rs, acc[3] * rs);
            }
        }
        __syncthreads();
        {
            const int tk = w * 4 + q4;
            const int trow = r0 + tk;
            const float* gk = W_mla_k_g + l * 96;
            const float2* rp = W_ROPE + (size_t)(trow & 2047) * 16;
            const float kr0 = krf[tk * 32 + r16], kr1 = krf[tk * 32 + 16 + r16];
#pragma unroll 1
            for (int h = 0; h < 4; h++) {
                float v[6];
                float ss = 0.f;
#pragma unroll
                for (int m = 0; m < 4; m++) { v[m] = R[tk * 516 + h * 128 + m * 16 + r16]; ss += v[m] * v[m]; }
                v[4] = kr0; v[5] = kr1; ss += kr0 * kr0 + kr1 * kr1;
                ss += __shfl_xor(ss, 1); ss += __shfl_xor(ss, 2); ss += __shfl_xor(ss, 4); ss += __shfl_xor(ss, 8);
                const float rs = rsqrtf(ss * (1.f / 96.f) + EPSF);
#pragma unroll
                for (int m = 0; m < 6; m++) v[m] = v[m] * rs * gk[m * 16 + r16];
                if (lat) {
#pragma unroll
                    for (int m = 4; m < 6; m++) {
                        const float other = __shfl_xor(v[m], 8);
                        const float2 cs = rp[(m - 4) * 8 + (r16 & 7)];
                        v[m] = (r16 < 8) ? (v[m] * cs.x - other * cs.y) : (other * cs.y + v[m] * cs.x);
                    }
                }
                bf16_t* dst = W_MK + (size_t)trow * 384 + h * 96;
#pragma unroll
                for (int m = 0; m < 6; m++) dst[m * 16 + r16] = f2bf(v[m]);
            }
        }
        {
            const int h = tid >> 6, d = tid & 63;
            bf16_t* dst = W_MVT + (size_t)((bb * 4 + h) * 64 + d) * 2304 + posb;
            const float* src = R + h * 128 + 64 + d;
#pragma unroll
            for (int qq = 0; qq < 4; qq++) {
                uint2 pk;
                pk.x = pack2bf(src[(qq * 4 + 0) * 516], src[(qq * 4 + 1) * 516]);
                pk.y = pack2bf(src[(qq * 4 + 2) * 516], src[(qq * 4 + 3) * 516]);
                *(uint2*)(dst + qq * 8) = pk;
            }
        }
    }
}

template <int DQK, int QT, bool NA, class KIDX>
__device__ __forceinline__ void flash_attn(char* smc, const bf16_t* qrow0, int qstride, const bf16_t* kbuf_h, int kstride, int b,
                                           const bf16_t* vbase_bh, int nkb, KIDX kidx_of, float scale, bf16_t* orow0, int ostride,
                                           const float* rpbs, int na_r, int na_rs) {
    constexpr int KS = DQK / 32, CPR = DQK / 8, KSTR = DQK * 2 + 16, KBUF = 64 * KSTR, NKC = 64 * CPR / 256, VSTR = 144, VBUF = 64 * VSTR;
    const int tid = TIDX, lane = tid & 63, w = tid >> 6, r16 = lane & 15, q = lane >> 4;
    char* Kb = smc;
    char* Vb = smc + 2 * KBUF;
    bf16x8 qf[QT][KS];
#pragma unroll
    for (int qt = 0; qt < QT; qt++)
#pragma unroll
        for (int ks = 0; ks < KS; ks++) qf[qt][ks] = *(const bf16x8*)(qrow0 + (size_t)(w * QT * 16 + qt * 16 + r16) * qstride + ks * 32 + q * 8);
    f32x4 o[4][QT];
    float m[QT], ls[QT];
#pragma unroll
    for (int qt = 0; qt < QT; qt++) {
        m[qt] = -1e30f; ls[qt] = 0.f;
#pragma unroll
        for (int dt = 0; dt < 4; dt++) o[dt][qt] = (f32x4){0.f, 0.f, 0.f, 0.f};
    }
    u32x4 rk[NKC], rv[2];
    {
        const int kidx = kidx_of(0);
        const int trow = kidx < 2048 ? b * 2048 + kidx : NLAT + b * 256 + (kidx - 2048);
        const bf16_t* kp = kbuf_h + (size_t)trow * kstride;
        const bf16_t* vp = vbase_bh + kidx;
#pragma unroll
        for (int i = 0; i < NKC; i++) { const int c = tid + 256 * i; const int row = c / CPR, cc = c % CPR; rk[i] = *(const u32x4*)(kp + (size_t)row * kstride + cc * 8); }
#pragma unroll
        for (int i = 0; i < 2; i++) { const int c = tid + 256 * i; const int row = c >> 3, cc = c & 7; rv[i] = *(const u32x4*)(vp + (size_t)row * 2304 + cc * 8); }
    }
    __syncthreads();
#pragma unroll
    for (int i = 0; i < NKC; i++) { const int c = tid + 256 * i; const int row = c / CPR, cc = c % CPR; *(u32x4*)(Kb + row * KSTR + cc * 16) = rk[i]; }
#pragma unroll
    for (int i = 0; i < 2; i++) { const int c = tid + 256 * i; const int row = c >> 3, cc = c & 7; *(u32x4*)(Vb + row * VSTR + cc * 16) = rv[i]; }
    __syncthreads();
    for (int kb = 0; kb < nkb; kb++) {
        const bool more = kb + 1 < nkb;
        if (more) {
            const int kidx = kidx_of(kb + 1);
            const int trow = kidx < 2048 ? b * 2048 + kidx : NLAT + b * 256 + (kidx - 2048);
            const bf16_t* kp = kbuf_h + (size_t)trow * kstride;
            const bf16_t* vp = vbase_bh + kidx;
#pragma unroll
            for (int i = 0; i < NKC; i++) { const int c = tid + 256 * i; const int row = c / CPR, cc = c % CPR; rk[i] = *(const u32x4*)(kp + (size_t)row * kstride + cc * 8); }
#pragma unroll
            for (int i = 0; i < 2; i++) { const int c = tid + 256 * i; const int row = c >> 3, cc = c & 7; rv[i] = *(const u32x4*)(vp + (size_t)row * 2304 + cc * 8); }
        }
        const char* Ks_ = Kb + (kb & 1) * KBUF;
        const char* Vs_ = Vb + (kb & 1) * VBUF;
        f32x4 s[4][QT];
#pragma unroll
        for (int kt = 0; kt < 4; kt++) {
#pragma unroll
            for (int qt = 0; qt < QT; qt++) s[kt][qt] = (f32x4){0.f, 0.f, 0.f, 0.f};
#pragma unroll
            for (int ks = 0; ks < KS; ks++) {
                const bf16x8 kf = *(const bf16x8*)(Ks_ + (kt * 16 + r16) * KSTR + ks * 64 + q * 16);
#pragma unroll
                for (int qt = 0; qt < QT; qt++) s[kt][qt] = __builtin_amdgcn_mfma_f32_16x16x32_bf16(kf, qf[qt][ks], s[kt][qt], 0, 0, 0);
            }
        }
#pragma unroll
        for (int qt = 0; qt < QT; qt++) {
            float bm = -1e30f;
#pragma unroll
            for (int kt = 0; kt < 4; kt++)
#pragma unroll
                for (int e = 0; e < 4; e++) {
                    float v = s[kt][qt][e] * scale;
                    if (NA) {
                        if (kb < 8) {
                            const int kc = kt * 16 + q * 4 + e;
                            const int cq = w * 16 + r16;
                            const int dr = na_rs + kb - na_r + 7;
                            const int dc = min(max(kc - cq + 15, 0), 30);
                            const int cs = min(max(cq - 8, 0), 48);
                            const bool ok = (kc >= cs) && (kc < cs + 16);
                            v = ok ? v + rpbs[dr * 31 + dc] : -1e30f;
                        }
                    }
                    s[kt][qt][e] = v;
                    bm = fmaxf(bm, v);
                }
            bm = fmaxf(bm, __shfl_xor(bm, 16));
            bm = fmaxf(bm, __shfl_xor(bm, 32));
            const float mn = fmaxf(m[qt], bm);
            const float corr = __builtin_amdgcn_exp2f(m[qt] - mn);
            m[qt] = mn;
            float rsum = 0.f;
#pragma unroll
            for (int kt = 0; kt < 4; kt++)
#pragma unroll
                for (int e = 0; e < 4; e++) { const float pe = __builtin_amdgcn_exp2f(s[kt][qt][e] - mn); s[kt][qt][e] = pe; rsum += pe; }
            ls[qt] = ls[qt] * corr + rsum;
#pragma unroll
            for (int dt = 0; dt < 4; dt++) { o[dt][qt][0] *= corr; o[dt][qt][1] *= corr; o[dt][qt][2] *= corr; o[dt][qt][3] *= corr; }
        }
#pragma unroll
        for (int g = 0; g < 2; g++) {
            bf16x8 pf[QT];
#pragma unroll
            for (int qt = 0; qt < QT; qt++) {
                union { bf16x8 v; unsigned u[4]; } pk;
                pk.u[0] = pack2bf(s[2 * g][qt][0], s[2 * g][qt][1]); pk.u[1] = pack2bf(s[2 * g][qt][2], s[2 * g][qt][3]);
                pk.u[2] = pack2bf(s[2 * g + 1][qt][0], s[2 * g + 1][qt][1]); pk.u[3] = pack2bf(s[2 * g + 1][qt][2], s[2 * g + 1][qt][3]);
                pf[qt] = pk.v;
            }
#pragma unroll
            for (int dt = 0; dt < 4; dt++) {
                const bf16x8 vf = *(const bf16x8*)(Vs_ + (dt * 16 + r16) * VSTR + g * 64 + q * 16);
#pragma unroll
                for (int qt = 0; qt < QT; qt++) o[dt][qt] = __builtin_amdgcn_mfma_f32_16x16x32_bf16(vf, pf[qt], o[dt][qt], 0, 0, 0);
            }
        }
        if (more) {
            char* Kw = Kb + ((kb + 1) & 1) * KBUF;
            char* Vw = Vb + ((kb + 1) & 1) * VBUF;
#pragma unroll
            for (int i = 0; i < NKC; i++) { const int c = tid + 256 * i; const int row = c / CPR, cc = c % CPR; *(u32x4*)(Kw + row * KSTR + cc * 16) = rk[i]; }
#pragma unroll
            for (int i = 0; i < 2; i++) { const int c = tid + 256 * i; const int row = c >> 3, cc = c & 7; *(u32x4*)(Vw + row * VSTR + cc * 16) = rv[i]; }
        }
        __syncthreads();
    }
#pragma unroll
    for (int qt = 0; qt < QT; qt++) {
        float lt = ls[qt];
        lt += __shfl_xor(lt, 16);
        lt += __shfl_xor(lt, 32);
        const float inv = 1.f / lt;
#pragma unroll
        for (int dt = 0; dt < 4; dt++)
            st4bf(orow0 + (size_t)(w * QT * 16 + qt * 16 + r16) * ostride + dt * 16 + q * 4,
                  make_float4(o[dt][qt][0] * inv, o[dt][qt][1] * inv, o[dt][qt][2] * inv, o[dt][qt][3] * inv));
    }
}

__device__ __forceinline__ void mla_unit(const Params& p, int l, int u, bool isctx, float* sm) {
    int b, h, qb;
    if (!isctx) { b = u >> 6; h = (u >> 4) & 3; qb = u & 15; } else { b = u >> 3; h = (u >> 1) & 3; qb = u & 1; }
    const int qrow = (isctx ? NLAT + b * 256 : b * 2048) + qb * 128;
    const bf16_t* vb = W_MVT + (size_t)((b * 4 + h) * 64) * 2304;
    const float scale = 0.10206207261596577f * 1.4426950408889634f;
    if (!isctx)
        flash_attn<96, 2, false>((char*)sm, W_MQ + (size_t)qrow * 384 + h * 96, 384, W_MK + h * 96, 384, b, vb, 36, [](int kb) { return kb * 64; }, scale,
                                 W_CAT + (size_t)qrow * 1024 + 768 + h * 64, 1024, nullptr, 0, 0);
    else
        flash_attn<96, 2, false>((char*)sm, W_MQ + (size_t)qrow * 384 + h * 96, 384, W_MK + h * 96, 384, b, vb, 4, [](int kb) { return 2048 + kb * 64; }, scale,
                                 W_CAT + (size_t)qrow * 1024 + 768 + h * 64, 1024, nullptr, 0, 0);
}
__device__ __forceinline__ void na_unit(const Params& p, int l, int u, bool isctx, float* sm) {
    if (!isctx) {
        const int b = u >> 7, h = (u >> 5) & 3, r = u & 31;
        const int rs = min(max(r - 4, 0), 24);
        float* rpbs = sm + 9216;
        __syncthreads();
        for (int i = TIDX; i < 15 * 31; i += 256) rpbs[i] = W_na_rpb[(size_t)(l * 4 + h) * 465 + i] * 1.4426950408889634f;
        const int qrow = b * 2048 + r * 64;
        flash_attn<64, 1, true>((char*)sm, W_NQ + (size_t)qrow * 256 + h * 64, 256, W_NK + h * 64, 256, b, W_NVT + (size_t)((b * 4 + h) * 64) * 2304, 12,
                                [rs](int kb) { return kb < 8 ? (rs + kb) * 64 : 2048 + (kb - 8) * 64; }, 0.125f * 1.4426950408889634f,
                                W_CAT + (size_t)qrow * 1024 + 512 + h * 64, 1024, rpbs, r, rs);
    } else {
        const int b = u >> 4, h = (u >> 2) & 3, qb = u & 3;
        const int qrow = NLAT + b * 256 + qb * 64;
        flash_attn<64, 1, false>((char*)sm, W_NQ + (size_t)qrow * 256 + h * 64, 256, W_NK + h * 64, 256, b, W_NVT + (size_t)((b * 4 + h) * 64) * 2304, 4,
                                 [](int kb) { return 2048 + kb * 64; }, 0.125f * 1.4426950408889634f, W_CAT + (size_t)qrow * 1024 + 512 + h * 64, 1024, nullptr, 0, 0);
    }
}

__device__ __forceinline__ void hgrn_local_unit(const Params& p, int l, int u, float* sm) {
    const int tid = TIDX;
    const int b = u / 144, h = (u / 36) & 3, cid = u % 36;
    const int row0 = cid < 4 ? NLAT + b * 256 + cid * 64 : b * 2048 + (cid - 4) * 64;
    float* B0 = sm;
    char* VT = (char*)(sm + 4352);
    char* KB = (char*)(sm + 6656);
    float* B2 = sm + 8960;
    float* B3 = sm + 13312;
    float* SC = sm + 17408;
    const int lane_ = tid & 63, w_ = tid >> 6, r16 = lane_ & 15, q4 = lane_ >> 4;
    const int k = tid & 63, seg = tid >> 6;
    const int ti = tid >> 4, ts = tid & 15;
    float acc[4][4];
#pragma unroll
    for (int a = 0; a < 4; a++)
#pragma unroll
        for (int c = 0; c < 4; c++) acc[a][c] = 0.f;
    __syncthreads();
    {
        const int s_ = tid >> 2, c0 = (tid & 3) * 16;
        const bf16_t* src = W_P + (size_t)(row0 + s_) * DIN + C_HI + h * 64 + c0;
        const u32x4 v0 = *(const u32x4*)src, v1 = *(const u32x4*)(src + 8);
#pragma unroll
        for (int j = 0; j < 4; j++) {
            *(bf16_t*)(VT + (c0 + 2 * j) * 144 + s_ * 2) = (bf16_t)(v0[j] & 0xFFFFu);
            *(bf16_t*)(VT + (c0 + 2 * j + 1) * 144 + s_ * 2) = (bf16_t)(v0[j] >> 16);
            *(bf16_t*)(VT + (c0 + 8 + 2 * j) * 144 + s_ * 2) = (bf16_t)(v1[j] & 0xFFFFu);
            *(bf16_t*)(VT + (c0 + 8 + 2 * j + 1) * 144 + s_ * 2) = (bf16_t)(v1[j] >> 16);
        }
    }
    float qv[16];
#pragma unroll
    for (int j = 0; j < 16; j++) qv[j] = bf2f(W_P[(size_t)(row0 + seg * 16 + j) * DIN + C_HQ + h * 64 + k]);
#pragma unroll
    for (int j = 0; j < 4; j++) *(float4*)&B0[k * 68 + seg * 16 + 4 * j] = make_float4(qv[4 * j], qv[4 * j + 1], qv[4 * j + 2], qv[4 * j + 3]);
#pragma unroll 1
    for (int dir = 0; dir < 2; dir++) {
        const int zoff = dir ? C_ZB : C_ZF;
        const float lbv = W_LB[(l * 2 + dir) * 256 + h * 64 + k];
        const size_t ud = (size_t)u * 2 + dir;
        float bl[16], kkv[16];
#pragma unroll
        for (int j = 0; j < 16; j++) {
            float z = bf2f(W_P[(size_t)(row0 + seg * 16 + j) * DIN + zoff + h * 64 + k]);
            z = fminf(fmaxf(z, -20.f), 20.f);
            const float e_ = __expf(-z);
            const float sg = 1.f / (1.f + e_);
            const float f = lbv + (1.f - lbv) * sg;
            bl[j] = __log2f(f);
            kkv[j] = (1.f - lbv) * (e_ * sg);
        }
        float tot;
        if (dir == 0) {
#pragma unroll
            for (int j = 1; j < 16; j++) bl[j] += bl[j - 1];
            tot = bl[15];
        } else {
#pragma unroll
            for (int j = 14; j >= 0; j--) bl[j] += bl[j + 1];
            tot = bl[0];
        }
        SC[seg * 64 + k] = tot;
        __syncthreads();
        float off = 0.f;
#pragma unroll
        for (int s2 = 0; s2 < 4; s2++) if (dir ? (s2 > seg) : (s2 < seg)) off += SC[s2 * 64 + k];
        const float btot = SC[k] + SC[64 + k] + SC[128 + k] + SC[192 + k];
#pragma unroll
        for (int j = 0; j < 16; j++) bl[j] += off;
#pragma unroll
        for (int j = 0; j < 4; j++) {
            const float Rj = dir ? bl[4 * j] : bl[4 * j + 3];
            *(float4*)&B2[k * 68 + seg * 16 + 4 * j] = make_float4(kkv[4 * j] * __builtin_amdgcn_exp2f(Rj - bl[4 * j]), kkv[4 * j + 1] * __builtin_amdgcn_exp2f(Rj - bl[4 * j + 1]),
                                                                   kkv[4 * j + 2] * __builtin_amdgcn_exp2f(Rj - bl[4 * j + 2]), kkv[4 * j + 3] * __builtin_amdgcn_exp2f(Rj - bl[4 * j + 3]));
            *(float4*)&B3[k * 64 + seg * 16 + 4 * j] = make_float4(bl[4 * j], bl[4 * j + 1], bl[4 * j + 2], bl[4 * j + 3]);
#pragma unroll
            for (int jj = 0; jj < 4; jj++)
                ((bf16_t*)W_HQ)[(ud * 64 + seg * 16 + 4 * j + jj) * 64 + k] = f2bf(qv[4 * j + jj] * __builtin_amdgcn_exp2f(bl[4 * j + jj]));
        }
        if (seg == 0) W_HD[ud * 64 + k] = __builtin_amdgcn_exp2f(btot);
        {
            u32x4 k0, k1;
#pragma unroll
            for (int j = 0; j < 4; j++) {
                k0[j] = pack2bf(kkv[2 * j] * __builtin_amdgcn_exp2f(btot - bl[2 * j]), kkv[2 * j + 1] * __builtin_amdgcn_exp2f(btot - bl[2 * j + 1]));
                k1[j] = pack2bf(kkv[8 + 2 * j] * __builtin_amdgcn_exp2f(btot - bl[8 + 2 * j]), kkv[8 + 2 * j + 1] * __builtin_amdgcn_exp2f(btot - bl[8 + 2 * j + 1]));
            }
            *(u32x4*)(KB + k * 144 + seg * 32) = k0;
            *(u32x4*)(KB + k * 144 + seg * 32 + 16) = k1;
        }
        __syncthreads();
        const bool active = dir ? (ts >= ti) : (ts <= ti);
        if (active) {
            float a2[4][4];
#pragma unroll
            for (int a = 0; a < 4; a++)
#pragma unroll
                for (int c = 0; c < 4; c++) a2[a][c] = 0.f;
#pragma unroll 2
            for (int kk_ = 0; kk_ < 64; kk_++) {
                const float4 q4 = *(const float4*)&B0[kk_ * 68 + ti * 4];
                const float4 bq4 = *(const float4*)&B3[kk_ * 64 + ti * 4];
                const float4 k4 = *(const float4*)&B2[kk_ * 68 + ts * 4];
                const float4 bk4 = *(const float4*)&B3[kk_ * 64 + ts * 4];
                const float R = dir ? bk4.x : bk4.w;
                const float qr[4] = {q4.x * __builtin_amdgcn_exp2f(bq4.x - R), q4.y * __builtin_amdgcn_exp2f(bq4.y - R), q4.z * __builtin_amdgcn_exp2f(bq4.z - R), q4.w * __builtin_amdgcn_exp2f(bq4.w - R)};
                const float ka[4] = {k4.x, k4.y, k4.z, k4.w};
#pragma unroll
                for (int a = 0; a < 4; a++)
#pragma unroll
                    for (int c = 0; c < 4; c++) a2[a][c] += qr[a] * ka[c];
            }
#pragma unroll
            for (int a = 0; a < 4; a++)
#pragma unroll
                for (int c = 0; c < 4; c++) {
                    const int i_ = ti * 4 + a, s_ = ts * 4 + c;
                    const bool valid = dir ? (s_ >= i_) : (s_ <= i_);
                    acc[a][c] += valid ? a2[a][c] : 0.f;
                }
        }
        {
            f32x4 ua[4];
#pragma unroll
            for (int vt = 0; vt < 4; vt++) ua[vt] = (f32x4){0.f, 0.f, 0.f, 0.f};
#pragma unroll
            for (int ss_ = 0; ss_ < 2; ss_++) {
                const bf16x8 kbf = *(const bf16x8*)(KB + (w_ * 16 + r16) * 144 + ss_ * 64 + q4 * 16);
#pragma unroll
                for (int vt = 0; vt < 4; vt++) {
                    const bf16x8 vtf = *(const bf16x8*)(VT + (vt * 16 + r16) * 144 + ss_ * 64 + q4 * 16);
                    ua[vt] = __builtin_amdgcn_mfma_f32_16x16x32_bf16(vtf, kbf, ua[vt], 0, 0, 0);
                }
            }
#pragma unroll
            for (int vt = 0; vt < 4; vt++) *(f32x4*)&W_HU[ud * 4096 + (w_ * 16 + r16) * 64 + vt * 16 + q4 * 4] = ua[vt];
        }
    }
    __syncthreads();
    {
        char* AB = (char*)B2;
#pragma unroll
        for (int a2_ = 0; a2_ < 4; a2_++) {
            uint2 pk; pk.x = pack2bf(acc[a2_][0], acc[a2_][1]); pk.y = pack2bf(acc[a2_][2], acc[a2_][3]);
            *(uint2*)(AB + (ti * 4 + a2_) * 144 + ts * 8) = pk;
        }
        __syncthreads();
        f32x4 oa[4];
#pragma unroll
        for (int vt = 0; vt < 4; vt++) oa[vt] = (f32x4){0.f, 0.f, 0.f, 0.f};
#pragma unroll
        for (int ss_ = 0; ss_ < 2; ss_++) {
            const bf16x8 abf = *(const bf16x8*)(AB + (w_ * 16 + r16) * 144 + ss_ * 64 + q4 * 16);
#pragma unroll
            for (int vt = 0; vt < 4; vt++) {
                const bf16x8 vtf = *(const bf16x8*)(VT + (vt * 16 + r16) * 144 + ss_ * 64 + q4 * 16);
                oa[vt] = __builtin_amdgcn_mfma_f32_16x16x32_bf16(vtf, abf, oa[vt], 0, 0, 0);
            }
        }
#pragma unroll
        for (int vt = 0; vt < 4; vt++) *(f32x4*)&W_OF[(size_t)(row0 + w_ * 16 + r16) * 256 + h * 64 + vt * 16 + q4 * 4] = oa[vt];
    }
}

__device__ __forceinline__ void hgrn_scan_unit(const Params& p, int l, int u) {
    const int tid = TIDX;
    const int bh = u >> 5, dir = (u >> 4) & 1, sl = u & 15;
    const int ubase = bh * 36;
    const int e = sl * 256 + tid;
    const int kq = e >> 6;
    const float* HUb = W_HU; const float* HDb = W_HD; float* SPb = W_SP;
    float S = 0.f;
#pragma unroll 6
    for (int n = 0; n < 36; n++) {
        const int cn = dir == 0 ? n : (n < 4 ? 3 - n : 39 - n);
        const size_t ud = (size_t)(ubase + cn) * 2 + dir;
        SPb[ud * 4096 + e] = S;
        S = S * HDb[ud * 64 + kq] + HUb[ud * 4096 + e];
    }
}
__device__ __forceinline__ void hgrn_final_unit(const Params& p, int l, int u, float* sm) {
    const int tid = TIDX, lane = tid & 63, w = tid >> 6, r16 = lane & 15, q4 = lane >> 4;
    const int b = u / 144, h = (u / 36) & 3, cid = u % 36;
    const int row0 = cid < 4 ? NLAT + b * 256 + cid * 64 : b * 2048 + (cid - 4) * 64;
    char* ST = (char*)sm;
    __syncthreads();
#pragma unroll
    for (int dir = 0; dir < 2; dir++) {
        const float* sp = W_SP + ((size_t)u * 2 + dir) * 4096;
#pragma unroll
        for (int j = 0; j < 4; j++) {
            const int e4 = tid + 256 * j, kk_ = e4 >> 4, v0 = (e4 & 15) * 4;
            const float4 sv = *(const float4*)&sp[e4 * 4];
            char* dst = ST + dir * 9216 + kk_ * 2;
            *(bf16_t*)(dst + (v0 + 0) * 144) = f2bf(sv.x); *(bf16_t*)(dst + (v0 + 1) * 144) = f2bf(sv.y);
            *(bf16_t*)(dst + (v0 + 2) * 144) = f2bf(sv.z); *(bf16_t*)(dst + (v0 + 3) * 144) = f2bf(sv.w);
        }
    }
    const int row = row0 + w * 16 + r16;
    f32x4 oa[4];
#pragma unroll
    for (int vt = 0; vt < 4; vt++) oa[vt] = *(const f32x4*)&W_OF[(size_t)row * 256 + h * 64 + vt * 16 + q4 * 4];
    bf16x8 qd[2][2];
#pragma unroll
    for (int dir = 0; dir < 2; dir++)
#pragma unroll
        for (int ks = 0; ks < 2; ks++) qd[dir][ks] = *(const bf16x8*)((const bf16_t*)W_HQ + (((size_t)u * 2 + dir) * 64 + w * 16 + r16) * 64 + ks * 32 + q4 * 8);
    __syncthreads();
#pragma unroll
    for (int dir = 0; dir < 2; dir++)
#pragma unroll
        for (int ks = 0; ks < 2; ks++)
#pragma unroll
            for (int vt = 0; vt < 4; vt++) {
                const bf16x8 stf = *(const bf16x8*)(ST + dir * 9216 + (vt * 16 + r16) * 144 + ks * 64 + q4 * 16);
                oa[vt] = __builtin_amdgcn_mfma_f32_16x16x32_bf16(stf, qd[dir][ks], oa[vt], 0, 0, 0);
            }
    float ss = 0.f;
#pragma unroll
    for (int vt = 0; vt < 4; vt++) ss += oa[vt][0] * oa[vt][0] + oa[vt][1] * oa[vt][1] + oa[vt][2] * oa[vt][2] + oa[vt][3] * oa[vt][3];
    ss += __shfl_xor(ss, 16); ss += __shfl_xor(ss, 32);
    const float rs = rsqrtf(ss * (1.f / 64.f) + EPSF);
#pragma unroll
    for (int vt = 0; vt < 4; vt++) {
        const int v0 = vt * 16 + q4 * 4;
        const float4 g = *(const float4*)&W_hgrn_norm_g[l * 64 + v0];
        const float4 gt = ld4bf(&W_P[(size_t)row * DIN + C_HG + h * 64 + v0]);
        st4bf(&W_CAT[(size_t)row * 1024 + h * 64 + v0],
              make_float4(oa[vt][0] * rs * g.x * siluf_(gt.x), oa[vt][1] * rs * g.y * siluf_(gt.y), oa[vt][2] * rs * g.z * siluf_(gt.z), oa[vt][3] * rs * g.w * siluf_(gt.w)));
    }
}

template <int LL>
__device__ __forceinline__ void hyena_unit(const Params& p, int l, int b, int cp, float* sm) {
    constexpr int NT = LL / 256;
    float zprev[NT];
#pragma unroll 1
    for (int chh = 0; chh < 2; chh++) {
    const int c = cp * 2 + chh;
    constexpr bool isctx = (LL == 256);
    const int tid = TIDX;
    float* zs = sm;
    float* kc = sm + LL;
    const int rowbase = isctx ? NLAT + b * 256 : b * 2048;
    float z[NT], x1[NT], x2[NT];
#pragma unroll
    for (int i = 0; i < NT; i++) {
        const int t = tid + 256 * i;
        float val[3];
#pragma unroll
        for (int q = 0; q < 3; q++) {
            const int chn = q * 256 + c;
            const int col = C_HY + chn;
            const float um = t > 0 ? bf2f(W_P[(size_t)(rowbase + t - 1) * DIN + col]) : 0.f;
            const float u0 = bf2f(W_P[(size_t)(rowbase + t) * DIN + col]);
            const float up = t < LL - 1 ? bf2f(W_P[(size_t)(rowbase + t + 1) * DIN + col]) : 0.f;
            val[q] = W_hy_short_w[(l * 3 + 0) * 768 + chn] * um + W_hy_short_w[(l * 3 + 1) * 768 + chn] * u0 + W_hy_short_w[(l * 3 + 2) * 768 + chn] * up +
                     W_hy_short_b[l * 768 + chn];
        }
        z[i] = val[0]; x1[i] = val[1]; x2[i] = val[2];
    }
#pragma unroll
    for (int o = 0; o < 2; o++) {
        const float* kbase = W_HYKC + (size_t)((l * 2 + o) * 256 + c) * 2 * LL;
        __syncthreads();
        for (int i = tid; i < 2 * LL - 1; i += 256) { const int d = i - (LL - 1); kc[i] = d >= 0 ? kbase[d] : kbase[LL - d]; }
#pragma unroll
        for (int i = 0; i < NT; i++) zs[tid + 256 * i] = z[i];
        __syncthreads();
        float acc[NT];
#pragma unroll
        for (int i = 0; i < NT; i++) acc[i] = 0.f;
        for (int s = 0; s < LL; s++) {
            const float zv = zs[s];
#pragma unroll
            for (int i = 0; i < NT; i++) acc[i] += kc[(tid + 256 * i) - s + (LL - 1)] * zv;
        }
        const float dbv = W_hy_bias[(l * 2 + o) * 256 + c];
#pragma unroll
        for (int i = 0; i < NT; i++) z[i] = (o == 0 ? x1[i] : x2[i]) * (acc[i] + dbv * z[i]);
    }
    if (chh == 0) {
#pragma unroll
        for (int i = 0; i < NT; i++) zprev[i] = z[i];
    } else {
#pragma unroll
        for (int i = 0; i < NT; i++) *(unsigned*)&W_CAT[(size_t)(rowbase + tid + 256 * i) * 1024 + 256 + cp * 2] = pack2bf(zprev[i], z[i]);
    }
    }
}

__device__ __forceinline__ void hyena_fft_unit(const Params& p, int l, int bp, int cp, float* sm) {
    const int tid = TIDX;
    float2* fb = (float2*)sm;
    float* raw = sm + 8704;
    bf16_t* zp = (bf16_t*)(sm + 12808);
    float2* twl = (float2*)(sm + 14856);
    __syncthreads();
    { const float2* twg = W_TW;
#pragma unroll
      for (int i = 0; i < 4; i++) twl[tid + 256 * i] = twg[tid + 256 * i]; }
    if (tid < 2) { raw[tid * 2050] = 0.f; raw[tid * 2050 + 2049] = 0.f; }
#pragma unroll 1
    for (int chh = 0; chh < 2; chh++) {
        const int c = cp * 2 + chh;
        float z[2][8];
#pragma unroll 1
        for (int st = 0; st < 3; st++) {
            if (st > 0) {
                const int o = st - 1;
                float2 v[4][4];
#pragma unroll
                for (int r1 = 0; r1 < 4; r1++)
#pragma unroll
                    for (int r2 = 0; r2 < 4; r2++) v[r1][r2] = r1 < 2 ? make_float2(z[0][(r1 & 1) * 4 + r2], z[1][(r1 & 1) * 4 + r2]) : make_float2(0.f, 0.f);
                fft_fwd_pass<0>(v, tid, twl);
                fft_lds_write<0>(v, tid, fb);
                __syncthreads();
                const float2* ks = W_KSPEC + (size_t)((l * 2 + o) * 256 + c) * 4096 + tid * 16;
                float2 kv[16];
#pragma unroll
                for (int j = 0; j < 16; j++) kv[j] = ks[j];
                fft_lds_read<2>(v, tid, fb);
                fft_fwd_pass<2>(v, tid, twl);
                fft_lds_write<2>(v, tid, fb);
                __syncthreads();
                fft_lds_read<4>(v, tid, fb);
                fft_fwd_pass<4>(v, tid, twl);
#pragma unroll
                for (int r1 = 0; r1 < 4; r1++)
#pragma unroll
                    for (int r2 = 0; r2 < 4; r2++) v[r1][r2] = cmul(v[r1][r2], kv[r1 * 4 + r2]);
                fft_inv_pass<4>(v, tid, twl);
                fft_lds_write<4>(v, tid, fb);
                __syncthreads();
                fft_lds_read<2>(v, tid, fb);
                fft_inv_pass<2>(v, tid, twl);
                fft_lds_write<2>(v, tid, fb);
                __syncthreads();
                fft_lds_read<0>(v, tid, fb);
                fft_inv_pass<0>(v, tid, twl);
                const float dbv = W_hy_bias[(l * 2 + o) * 256 + c];
#pragma unroll
                for (int r1 = 0; r1 < 2; r1++)
#pragma unroll
                    for (int r2 = 0; r2 < 4; r2++) {
                        const int i = r1 * 4 + r2;
                        z[0][i] = v[r1][r2].x + dbv * z[0][i];
                        z[1][i] = v[r1][r2].y + dbv * z[1][i];
                    }
            }
            const int chn = st * 256 + c;
#pragma unroll 1
            for (int b2 = 0; b2 < 2; b2++)
#pragma unroll 4
                for (int i = 0; i < 8; i++) {
                    const int t = tid + 256 * i;
                    raw[b2 * 2050 + 1 + t] = bf2f(W_P[(size_t)((bp * 2 + b2) * 2048 + t) * DIN + C_HY + chn]);
                }
            __syncthreads();
            const float w0 = W_hy_short_w[(l * 3 + 0) * 768 + chn], w1 = W_hy_short_w[(l * 3 + 1) * 768 + chn], w2 = W_hy_short_w[(l * 3 + 2) * 768 + chn];
            const float sb = W_hy_short_b[l * 768 + chn];
#pragma unroll
            for (int b2 = 0; b2 < 2; b2++)
#pragma unroll
                for (int i = 0; i < 8; i++) {
                    const int t = tid + 256 * i;
                    const float val = w0 * raw[b2 * 2050 + t] + w1 * raw[b2 * 2050 + t + 1] + w2 * raw[b2 * 2050 + t + 2] + sb;
                    z[b2][i] = st == 0 ? val : val * z[b2][i];
                }
            __syncthreads();
        }
        if (chh == 0) {
#pragma unroll
            for (int b2 = 0; b2 < 2; b2++)
#pragma unroll
                for (int i = 0; i < 8; i++) zp[(b2 * 8 + i) * 256 + tid] = f2bf(z[b2][i]);
        } else {
#pragma unroll
            for (int b2 = 0; b2 < 2; b2++)
#pragma unroll
                for (int i = 0; i < 8; i++)
                    *(unsigned*)&W_CAT[(size_t)((bp * 2 + b2) * 2048 + tid + 256 * i) * 1024 + 256 + cp * 2] = ((unsigned)zp[(b2 * 8 + i) * 256 + tid] | ((unsigned)f2bf(z[b2][i]) << 16));
        }
    }
}

__device__ void phase_mix(const Params& p, int l, float* sm) {
    const bool need_ctx = l < DEPTH - 1;
    const int G = gridDim.x, bid = BIDX;
    for (int u = wq_next(WQ(p, l, 3), sm); u < 512; u = wq_next(WQ(p, l, 3), sm)) hyena_fft_unit(p, l, u >> 7, u & 127, sm);
    for (int u = wq_next(WQ(p, l, 13), sm); u < 1024; u = wq_next(WQ(p, l, 13), sm)) hgrn_scan_unit(p, l, u);
    for (int u = wq_next(WQ(p, l, 4), sm); u < 1024; u = wq_next(WQ(p, l, 4), sm)) na_unit(p, l, u, false, sm);
    if (need_ctx) {
        for (int u = wq_next(WQ(p, l, 5), sm); u < 128; u = wq_next(WQ(p, l, 5), sm)) na_unit(p, l, u, true, sm);
        for (int u = wq_next(WQ(p, l, 6), sm); u < 1024; u = wq_next(WQ(p, l, 6), sm)) hyena_unit<256>(p, l, u >> 7, u & 127, sm);
    }
}
__device__ void phase_mix2(const Params& p, int l, float* sm) {
    const bool need_ctx = l < DEPTH - 1;
    const int G = gridDim.x, bid = BIDX;
    for (int u = wq_next(WQ(p, l, 7), sm); u < 512; u = wq_next(WQ(p, l, 7), sm)) mla_unit(p, l, u, false, sm);
    for (int u = wq_next(WQ(p, l, 8), sm); u < 1152; u = wq_next(WQ(p, l, 8), sm)) { if (need_ctx || (u % 36) >= 4) hgrn_final_unit(p, l, u, sm); }
    if (need_ctx) for (int u = wq_next(WQ(p, l, 9), sm); u < 64; u = wq_next(WQ(p, l, 9), sm)) mla_unit(p, l, u, true, sm);
}

__device__ void phase_gemm2(const Params& p, int l, float* sm) {
    const int nrows = (l < DEPTH - 1) ? TT : NLAT;
    const float* W = p.w_out + (size_t)l * 1024 * 1024;
    const int tid = TIDX, lane = tid & 63, w = tid >> 6, wm = w >> 1, wn = w & 1, r16 = lane & 15, q = lane >> 4;
    for (int u = wq_next(WQ(p, l, 10), sm); u < (nrows / 128) * 8; u = wq_next(WQ(p, l, 10), sm)) {
        const int rb = u >> 3, cb = u & 7;
        const int r0 = rb * 128, n0 = cb * 128;
        const float* g1 = W_MOD + (size_t)(l * 9 + bidx_of(r0)) * 6144 + 2048;
        f32x4 acc[4][4];
        const bf16_t* cb_ = W_CAT + (size_t)r0 * 1024;
        const bf16_t* wb = W_WOUTT + (size_t)l * 1024 * 1024 + (size_t)n0 * 1024;
        gemm128_bt<true>(1024, (char*)sm, [&](int r) { return cb_ + (size_t)r * 1024; }, [&](int r) { return wb + (size_t)r * 1024; }, acc);
#pragma unroll
        for (int i = 0; i < 4; i++)
#pragma unroll
            for (int j = 0; j < 4; j++) {
                const int m = r0 + wm * 64 + i * 16 + r16, n = n0 + wn * 64 + j * 16 + q * 4;
                const float* xsrc = l > 0 ? &W_X[(size_t)m * 1024 + n] : (m < NLAT ? &p.x[(size_t)m * 1024 + n] : &p.ctx[(size_t)(m - NLAT) * 1024 + n]);
                float4 xv = *(const float4*)xsrc;
                const float4 g = *(const float4*)&g1[n];
                xv.x += g.x * acc[i][j][0]; xv.y += g.y * acc[i][j][1]; xv.z += g.z * acc[i][j][2]; xv.w += g.w * acc[i][j][3];
                *(float4*)&W_X[(size_t)m * 1024 + n] = xv;
            }
    }
}

__device__ void phase_norm2(const Params& p, int l, float* sm) {
    const int tid = TIDX, wave = tid >> 6, lane = tid & 63, r16 = lane & 15, kq = lane >> 4;
    const int nrows = (l < DEPTH - 1) ? TT : NLAT;
    float* red = sm;
    float* lg = sm + 64;
    for (int t16 = wq_next(WQ(p, l, 14), sm); t16 < nrows / 16; t16 = wq_next(WQ(p, l, 14), sm)) {
        const int row = t16 * 16 + r16;
        const int bi = bidx_of(t16 * 16);
        const int kb = wave * 256 + kq * 64;
        const float* xr = W_X + (size_t)row * 1024 + kb;
        float ss = 0.f;
#pragma unroll
        for (int i = 0; i < 16; i++) { const float4 v = *(const float4*)&xr[i * 4]; ss += v.x * v.x + v.y * v.y + v.z * v.z + v.w * v.w; }
        ss += __shfl_xor(ss, 16); ss += __shfl_xor(ss, 32);
        if (kq == 0) red[wave * 16 + r16] = ss;
        __syncthreads();
        const float rstd = rsqrtf((red[r16] + red[16 + r16] + red[32 + r16] + red[48 + r16]) * (1.f / 1024.f) + EPSF);
        const float* md = W_MOD + (size_t)(l * 9 + bi) * 6144 + kb;
        const float* gn = W_norm2_g + l * 1024 + kb;
        const float* we = W_moe_we + (size_t)(l * 1024 + kb) * 32 + r16;
        const float* wg = W_moe_wg + (size_t)(l * 1024 + kb) * 4 + (r16 & 3);
        bf16_t* hr = W_H + (size_t)row * 1024 + kb;
        f32x4 a0 = (f32x4){0.f, 0.f, 0.f, 0.f}, a1 = a0, a2 = a0;
#pragma unroll 2
        for (int i = 0; i < 16; i++) {
            const float4 xq = *(const float4*)&xr[i * 4];
            const float4 g = *(const float4*)&gn[i * 4];
            const float4 sh = *(const float4*)&md[3072 + i * 4];
            const float4 sc = *(const float4*)&md[4096 + i * 4];
            float h[4];
            h[0] = xq.x * rstd * g.x * (1.f + sc.x) + sh.x; h[1] = xq.y * rstd * g.y * (1.f + sc.y) + sh.y;
            h[2] = xq.z * rstd * g.z * (1.f + sc.z) + sh.z; h[3] = xq.w * rstd * g.w * (1.f + sc.w) + sh.w;
            st4bf(hr + i * 4, make_float4(h[0], h[1], h[2], h[3]));
#pragma unroll
            for (int e = 0; e < 4; e++) {
                const int k = i * 4 + e;
                const float b0 = we[k * 32], b1 = we[k * 32 + 16];
                const float b2 = r16 < 4 ? wg[k * 4] : 0.f;
                a0 = __builtin_amdgcn_mfma_f32_16x16x4f32(h[e], b0, a0, 0, 0, 0);
                a1 = __builtin_amdgcn_mfma_f32_16x16x4f32(h[e], b1, a1, 0, 0, 0);
                a2 = __builtin_amdgcn_mfma_f32_16x16x4f32(h[e], b2, a2, 0, 0, 0);
            }
        }
        float* lw = lg + wave * 768;
#pragma unroll
        for (int e = 0; e < 4; e++) {
            lw[(kq * 4 + e) * 48 + r16] = a0[e];
            lw[(kq * 4 + e) * 48 + 16 + r16] = a1[e];
            lw[(kq * 4 + e) * 48 + 32 + r16] = a2[e];
        }
        __syncthreads();
        if (tid < 16) {
            const float* L0 = lg + tid * 48;
            const int rrow = t16 * 16 + tid;
            float gl[4];
#pragma unroll
            for (int c = 0; c < 4; c++) gl[c] = L0[32 + c] + L0[768 + 32 + c] + L0[1536 + 32 + c] + L0[2304 + 32 + c] + W_moe_bg[l * 4 + c];
            int gs = 0; float best = gl[0];
#pragma unroll
            for (int c = 1; c < 4; c++) if (gl[c] > best) { best = gl[c]; gs = c; }
            float den = 0.f;
#pragma unroll
            for (int c = 0; c < 4; c++) den += expf(gl[c] - best);
            const float psel = 1.f / den;
            float le[8];
#pragma unroll
            for (int i = 0; i < 8; i++) { const int c = gs * 8 + i; le[i] = L0[c] + L0[768 + c] + L0[1536 + c] + L0[2304 + c] + W_moe_be[l * 32 + c]; }
            int i1 = 0; float v1 = le[0];
#pragma unroll
            for (int i = 1; i < 8; i++) if (le[i] > v1) { v1 = le[i]; i1 = i; }
            int i2 = -1; float v2 = -3.0e38f;
#pragma unroll
            for (int i = 0; i < 8; i++) if (i != i1 && le[i] > v2) { v2 = le[i]; i2 = i; }
            const float e2 = expf(v2 - v1);
            const float w1 = psel / (1.f + e2), w2 = psel * e2 / (1.f + e2);
            const int ea = gs * 8 + i1, eb = gs * 8 + i2;
            const int n0 = rrow * 2, n1 = rrow * 2 + 1;
            W_EW[n0] = w1; W_EW[n1] = w2;
            const int pa = atomicAdd(&W_cnt[l * 32 + ea], 1);
            W_LIST[(size_t)ea * TT + pa] = n0;
            const int pb = atomicAdd(&W_cnt[l * 32 + eb], 1);
            W_LIST[(size_t)eb * TT + pb] = n1;
        }
    }
}

__device__ void phase_moe1(const Params& p, int l, float* sm) {
    int* offs = (int*)(sm + 16384);
    int* ns = (int*)(sm + 16384 + 64);
    const int tid = TIDX, lane = tid & 63, w = tid >> 6, wm = w >> 1, wn = w & 1, r16 = lane & 15, q = lane >> 4;
    __syncthreads();
    if (tid == 0) { int a = 0; for (int e = 0; e < 32; e++) { offs[e] = a; a += (W_cnt[l * 32 + e] + 127) >> 7; } offs[32] = a; }
    __syncthreads();
    const int total = offs[32] * 8;
    for (int u = wq_next(WQ(p, l, 11), sm); u < total; u = wq_next(WQ(p, l, 11), sm)) {
        const int rbg = u >> 3, cb = u & 7;
        int e = 0;
        while (offs[e + 1] <= rbg) e++;
        const int rbi = rbg - offs[e];
        const int ce = W_cnt[l * 32 + e];
        __syncthreads();
        if (tid < 128) { const int idx = rbi * 128 + tid; ns[tid] = idx < ce ? W_LIST[(size_t)e * TT + idx] : -1; }
        __syncthreads();
        const int j0 = cb * 64;
        const bf16_t* hb = W_H;
        const int c = tid & 127;
        const int hid = j0 + (c >> 6) * 32 + ((c >> 4) & 1) * 16 + (c & 15);
        const float* wp = (((c >> 4) & 3) >= 2 ? p.moe_w_up : p.moe_w_gate) + (size_t)(l * 32 + e) * 1024 * 512 + hid;
        f32x4 acc[4][4];
        gemm128_main<true>(1024, (char*)sm, [&](int r) { return hb + (size_t)(max(ns[r], 0) >> 1) * 1024; },
                           [&](int k, int n) { return wp[(size_t)k * 512]; }, acc);
#pragma unroll
        for (int i = 0; i < 4; i++) {
            const int n = ns[wm * 64 + i * 16 + r16];
            if (n >= 0) {
#pragma unroll
                for (int j = 0; j < 2; j++) {
                    const int hh = j0 + wn * 32 + j * 16 + q * 4;
                    float4 a;
                    a.x = siluf_(acc[i][j][0]) * acc[i][j + 2][0]; a.y = siluf_(acc[i][j][1]) * acc[i][j + 2][1];
                    a.z = siluf_(acc[i][j][2]) * acc[i][j + 2][2]; a.w = siluf_(acc[i][j][3]) * acc[i][j + 2][3];
                    st4bf(&W_ACT[(size_t)n * 512 + hh], a);
                }
            }
        }
    }
}
__device__ void phase_moe2(const Params& p, int l, float* sm) {
    int* offs = (int*)(sm + 16384);
    int* ns = (int*)(sm + 16384 + 64);
    const int tid = TIDX, lane = tid & 63, w = tid >> 6, wm = w >> 1, wn = w & 1, r16 = lane & 15, q = lane >> 4;
    __syncthreads();
    if (tid == 0) { int a = 0; for (int e = 0; e < 32; e++) { offs[e] = a; a += (W_cnt[l * 32 + e] + 127) >> 7; } offs[32] = a; }
    __syncthreads();
    const int total = offs[32] * 8;
    for (int u = wq_next(WQ(p, l, 12), sm); u < total; u = wq_next(WQ(p, l, 12), sm)) {
        const int rbg = u >> 3, cb = u & 7;
        int e = 0;
        while (offs[e + 1] <= rbg) e++;
        const int rbi = rbg - offs[e];
        const int ce = W_cnt[l * 32 + e];
        __syncthreads();
        if (tid < 128) { const int idx = rbi * 128 + tid; ns[tid] = idx < ce ? W_LIST[(size_t)e * TT + idx] : -1; }
        __syncthreads();
        const int n0 = cb * 128;
        const bf16_t* ab_ = W_ACT;
        const float* wp = p.moe_w_down + (size_t)(l * 32 + e) * 512 * 1024 + n0 + (tid & 127);
        f32x4 acc[4][4];
        gemm128_main<true>(512, (char*)sm, [&](int r) { return ab_ + (size_t)max(ns[r], 0) * 512; }, [&](int k, int n) { return wp[(size_t)k * 1024]; }, acc);
#pragma unroll
        for (int i = 0; i < 4; i++) {
            const int n = ns[wm * 64 + i * 16 + r16];
            if (n >= 0) {
                const float wt = W_EW[n];
#pragma unroll
                for (int j = 0; j < 4; j++) {
                    const int col = n0 + wn * 64 + j * 16 + q * 4;
                    st4bf(&W_YEXP[(size_t)n * 1024 + col], make_float4(acc[i][j][0] * wt, acc[i][j][1] * wt, acc[i][j][2] * wt, acc[i][j][3] * wt));
                }
            }
        }
    }
}

enum { PH_PRO1 = 0, PH_PRO2, PH_NORM1, PH_GEMM1, PH_PREP, PH_MIX, PH_HGOUT, PH_GEMM2, PH_NORM2, PH_MOE1, PH_MOE2, PH_FINAL };

template <int PH>
__device__ __forceinline__ void run_phase(const Params& p, int l, float* sm) {
    if (PH == PH_PRO1) phase_pro1(p, sm);
    else if (PH == PH_PRO2) phase_pro2(p, sm);
    else if (PH == PH_NORM1) phase_norm1(p, l, sm);
    else if (PH == PH_GEMM1) phase_gemm1(p, l, sm);
    else if (PH == PH_PREP) phase_prep(p, l, sm);
    else if (PH == PH_MIX) phase_mix(p, l, sm);
    else if (PH == PH_HGOUT) phase_mix2(p, l, sm);
    else if (PH == PH_GEMM2) phase_gemm2(p, l, sm);
    else if (PH == PH_NORM2) phase_norm2(p, l, sm);
    else if (PH == PH_MOE1) phase_moe1(p, l, sm);
    else if (PH == PH_MOE2) phase_moe2(p, l, sm);
    else if (PH == PH_FINAL) phase_final(p, sm);
}

#if !MEGA
template <int PH>
__global__ void __launch_bounds__(256, 2) k_phase(Params p, int l) {
    __shared__ float sm[SMF];
    run_phase<PH>(p, l, sm);
}
#else
__global__ void __launch_bounds__(256, 2) k_mega(Params p) {
    __shared__ float sm[SMF];
    __shared__ uint4 xb_words;
    if (TIDX == 0) xb_words = make_uint4(0u, 0u, 0u, 0u);
    __syncthreads();
    if (threadIdx.x == 0) ((int*)sm)[SMF - 2] = 0;
    __syncthreads();
    XcdBarrier bar = xcd_barrier_post(W_bar, (volatile LAS unsigned*)&xb_words);
#if USE_CG
#define xcd_barrier(b) cooperative_groups::this_grid().sync()
#endif
    for (int r = 0; r < p.rep[PH_PRO1]; r++) { if (threadIdx.x == 0) ((int*)sm)[SMF - 2] = r; __syncthreads(); run_phase<PH_PRO1>(p, 0, sm); xcd_barrier(bar); }
    for (int r = 0; r < p.rep[PH_PRO2]; r++) { if (threadIdx.x == 0) ((int*)sm)[SMF - 2] = r; __syncthreads(); run_phase<PH_PRO2>(p, 0, sm); xcd_barrier(bar); }
    for (int l = 0; l < DEPTH; l++) {
        if (threadIdx.x == 0) ((int*)sm)[SMF - 2] = 0; __syncthreads(); run_phase<PH_NORM1>(p, l, sm); xcd_barrier(bar);
        for (int r = 0; r < p.rep[PH_GEMM1]; r++) { if (threadIdx.x == 0) ((int*)sm)[SMF - 2] = r; __syncthreads(); run_phase<PH_GEMM1>(p, l, sm); xcd_barrier(bar); }
        for (int r = 0; r < p.rep[PH_PREP]; r++) { if (threadIdx.x == 0) ((int*)sm)[SMF - 2] = r; __syncthreads(); run_phase<PH_PREP>(p, l, sm); xcd_barrier(bar); }
        for (int r = 0; r < p.rep[PH_MIX]; r++) { if (threadIdx.x == 0) ((int*)sm)[SMF - 2] = r; __syncthreads(); run_phase<PH_MIX>(p, l, sm); xcd_barrier(bar); }
        for (int r = 0; r < p.rep[PH_HGOUT]; r++) { if (threadIdx.x == 0) ((int*)sm)[SMF - 2] = r; __syncthreads(); run_phase<PH_HGOUT>(p, l, sm); xcd_barrier(bar); }
        if (threadIdx.x == 0) ((int*)sm)[SMF - 2] = 0; __syncthreads(); run_phase<PH_GEMM2>(p, l, sm); xcd_barrier(bar);
        run_phase<PH_NORM2>(p, l, sm); xcd_barrier(bar);
        for (int r = 0; r < p.rep[PH_MOE1]; r++) { if (threadIdx.x == 0) ((int*)sm)[SMF - 2] = r; __syncthreads(); run_phase<PH_MOE1>(p, l, sm); xcd_barrier(bar); }
        for (int r = 0; r < p.rep[PH_MOE2]; r++) { if (threadIdx.x == 0) ((int*)sm)[SMF - 2] = r; __syncthreads(); run_phase<PH_MOE2>(p, l, sm); xcd_barrier(bar); }
    }
    run_phase<PH_FINAL>(p, 0, sm);
}
#endif

static inline size_t align_up(size_t v, size_t a) { return (v + a - 1) / a * a; }

extern "C" void kernel_launch(void* const* d_in, const int* in_sizes, int n_in, void* d_out, int out_size, void* d_ws, size_t ws_size,
                              hipStream_t stream) {
    Params p{};
    const float* const* in = (const float* const*)d_in;
    p.x = in[0]; p.c = in[1]; p.ctx = in[2]; p.c_ctx = in[3]; p.w_ada = in[4]; p.b_ada = in[5]; p.norm1_g = in[6]; p.norm2_g = in[7];
    p.w_in = in[8]; p.w_out = in[9]; p.lb_logits = in[10]; p.hgrn_norm_g = in[11];
    p.hy_short_w = in[12]; p.hy_short_b = in[13]; p.hy_w1 = in[14]; p.hy_b1 = in[15]; p.hy_freq = in[16]; p.hy_w2 = in[17]; p.hy_b2 = in[18];
    p.hy_w3 = in[19]; p.hy_b3 = in[20]; p.hy_decay = in[21]; p.hy_bias = in[22];
    p.na_rpb = in[23]; p.na_q_g = in[24]; p.na_k_g = in[25];
    p.mla_q_a_g = in[26]; p.mla_kv_a_g = in[27]; p.mla_w_uq = in[28]; p.mla_w_ukv = in[29]; p.mla_q_g = in[30]; p.mla_k_g = in[31];
    p.moe_wg = in[32]; p.moe_bg = in[33]; p.moe_we = in[34]; p.moe_be = in[35]; p.moe_w_gate = in[36]; p.moe_w_up = in[37]; p.moe_w_down = in[38];
    p.out = (float*)d_out;
    for (int i = 0; i < 16; i++) p.rep[i] = 1;
#ifdef PROBE_PH
    p.rep[PROBE_PH] = 2;
#endif
#ifdef PROBE_PH2
    p.rep[PROBE_PH2] = 2;
#endif

    p.ws = (char*)d_ws;
    const size_t off = WS_TOTAL;
    if (off > ws_size) { fprintf(stderr, "workspace too small: need %zu have %zu\n", off, ws_size); return; }

#if !MEGA
#ifndef BIGMASK
#define BIGMASK 0xFFF
#endif
#define GR(ph) (((BIGMASK >> (ph)) & 1) ? 1024 : 256)
    k_phase<PH_PRO1><<<GR(PH_PRO1), 256, 0, stream>>>(p, 0);
    k_phase<PH_PRO2><<<GR(PH_PRO2), 256, 0, stream>>>(p, 0);
    for (int l = 0; l < DEPTH; l++) {
        k_phase<PH_NORM1><<<GR(PH_NORM1), 256, 0, stream>>>(p, l);
        k_phase<PH_GEMM1><<<GR(PH_GEMM1), 256, 0, stream>>>(p, l);
        k_phase<PH_PREP><<<GR(PH_PREP), 256, 0, stream>>>(p, l);
        k_phase<PH_MIX><<<GR(PH_MIX), 256, 0, stream>>>(p, l);
        k_phase<PH_HGOUT><<<GR(PH_HGOUT), 256, 0, stream>>>(p, l);
        k_phase<PH_GEMM2><<<GR(PH_GEMM2), 256, 0, stream>>>(p, l);
        k_phase<PH_NORM2><<<GR(PH_NORM2), 256, 0, stream>>>(p, l);
        k_phase<PH_MOE1><<<GR(PH_MOE1), 256, 0, stream>>>(p, l);
        k_phase<PH_MOE2><<<GR(PH_MOE2), 256, 0, stream>>>(p, l);
    }
    k_phase<PH_FINAL><<<GR(PH_FINAL), 256, 0, stream>>>(p, 0);
#else
    static int grid = 0;
    if (!grid) {
        int dev = 0, cus = 0, per_cu = 0;
        hipGetDevice(&dev);
        hipDeviceGetAttribute(&cus, hipDeviceAttributeMultiprocessorCount, dev);
        hipOccupancyMaxActiveBlocksPerMultiprocessor(&per_cu, k_mega, 256, 0);
        if (per_cu > 2) per_cu = 2;
        if (per_cu < 1) per_cu = 1;
        grid = cus * per_cu;
    }
    hipMemsetAsync(p.ws + OFF_bar, 0, (XCD_BAR_WORDS + WQ_WORDS) * sizeof(unsigned), stream);
#if USE_CG
    { void* args[] = {&p}; hipLaunchCooperativeKernel((void*)k_mega, dim3(grid), dim3(256), args, 0, stream); }
#else
    k_mega<<<grid, 256, 0, stream>>>(p);
#endif
#endif
}
```

```cpp
#include <hip/hip_runtime.h>
#include <stdint.h>
#include <stdio.h>
#include <hip/hip_cooperative_groups.h>
#define USE_CG 0

#ifndef MEGA
#define MEGA 1
#endif

#define DM 1024
#define NB 8
#define SEQ 2048
#define CTXL 256
#define NLAT (NB * SEQ)
#define NCTX (NB * CTXL)
#define TT (NLAT + NCTX)
#define DIN 3232
#define DEPTH 4
#define EPSF 1e-6f
#define C_HQ 0
#define C_ZF 256
#define C_ZB 512
#define C_HI 768
#define C_HG 1024
#define C_HY 1280
#define C_NA 2048
#define C_CQ 2816
#define C_CKV 3072
#define C_KR 3200

#define SMF 17920

typedef unsigned short bf16_t;

struct Params {
    const float *x, *c, *ctx, *c_ctx, *w_ada, *b_ada, *norm1_g, *norm2_g, *w_in, *w_out, *lb_logits, *hgrn_norm_g;
    const float *hy_short_w, *hy_short_b, *hy_w1, *hy_b1, *hy_freq, *hy_w2, *hy_b2, *hy_w3, *hy_b3, *hy_decay, *hy_bias;
    const float *na_rpb, *na_q_g, *na_k_g, *mla_q_a_g, *mla_kv_a_g, *mla_w_uq, *mla_w_ukv, *mla_q_g, *mla_k_g;
    const float *moe_wg, *moe_bg, *moe_we, *moe_be, *moe_w_gate, *moe_w_up, *moe_w_down;
    float* out;
    char* ws;
    int rep[16];
};

#define XB_TMO      128
#define XB_XCNT(j)  (256  + 64 * (j))
#define XB_XSUB(j)  (1280 + 64 * (j))
#define XB_XGEN(j)  (2304 + 64 * (j))
#define XB_TOP      3328
#define XB_TOPGEN   3392
#define XCD_BAR_WORDS 3456
#define XB_SPIN_CAP (1u << 22)
#define LAS __attribute__((address_space(3)))

__device__ __forceinline__ unsigned xb_ld(unsigned* p)              { return __hip_atomic_load(p, __ATOMIC_RELAXED, __HIP_MEMORY_SCOPE_AGENT); }
__device__ __forceinline__ unsigned xb_add(unsigned* p, unsigned v) { return __hip_atomic_fetch_add(p, v, __ATOMIC_RELAXED, __HIP_MEMORY_SCOPE_AGENT); }
__device__ __forceinline__ unsigned xb_xcc_id() { return (unsigned)__builtin_amdgcn_s_getreg((3 << 11) | 20) & 0xFu; }
#define XB_SPIN(cond, bar) do { unsigned _sp = 0; while (cond) { __builtin_amdgcn_s_sleep(1); \
    if ((++_sp & 255u) == 0u) { if (xb_ld(&(bar)[XB_TMO])) break; if (_sp > XB_SPIN_CAP) { atomicAdd(&(bar)[XB_TMO], 1u); break; } } } } while (0)

struct XcdBarrier { unsigned* bar; unsigned x; volatile LAS unsigned* st; };

__device__ __forceinline__ XcdBarrier xcd_barrier_post(unsigned* bar, volatile LAS unsigned* st) {
    XcdBarrier b; b.bar = bar; b.x = xb_xcc_id(); b.st = st;
    if (threadIdx.x == 0) (void)xb_add(&bar[XB_XCNT(b.x)], 1u);
    return b;
}
__device__ __forceinline__ void xcd_barrier_complete(unsigned* bar, unsigned x, unsigned& nloc, unsigned& nx) {
    const unsigned G = gridDim.x * gridDim.y * gridDim.z;
    unsigned sum, cnt, mine, sp = 0u;
    for (;;) {
        sum = 0u; cnt = 0u; mine = 0u;
#pragma unroll
        for (unsigned j = 0; j < 16; ++j) { const unsigned c = xb_ld(&bar[XB_XCNT(j)]); sum += c; cnt += (c > 0u) ? 1u : 0u; mine = (j == x) ? c : mine; }
        if (sum == G) break;
        __builtin_amdgcn_s_sleep(1);
        if ((++sp & 255u) == 0u) { if (xb_ld(&bar[XB_TMO])) break; if (sp > XB_SPIN_CAP) { atomicAdd(&bar[XB_TMO], 1u); break; } }
    }
    nloc = mine > 0u ? mine : 1u; nx = cnt > 0u ? cnt : 1u;
}
__device__ __forceinline__ void xcd_barrier(const XcdBarrier& b) {
    asm volatile("s_waitcnt vmcnt(0)" ::: "memory");
    __syncthreads();
    if (threadIdx.x == 0) {
        unsigned* bar = b.bar;
        __builtin_amdgcn_s_waitcnt(0);
        unsigned nloc = b.st[0], nx = b.st[1];
        if (nloc == 0u) { xcd_barrier_complete(bar, b.x, nloc, nx); b.st[0] = nloc; b.st[1] = nx; }
        const unsigned old = xb_add(&bar[XB_XSUB(b.x)], 1u);
        const unsigned gen = old / nloc;
        if (old + 1u == (gen + 1u) * nloc) {
            __builtin_amdgcn_fence(__ATOMIC_RELEASE, "agent");
            asm volatile("s_waitcnt vmcnt(0)" ::: "memory");
            const unsigned og = xb_add(&bar[XB_TOP], 1u);
            const unsigned tg = og / nx;
            if (og + 1u == (tg + 1u) * nx) xb_add(&bar[XB_TOPGEN], 1u);
            else XB_SPIN(xb_ld(&bar[XB_TOPGEN]) == tg, bar);
            __builtin_amdgcn_fence(__ATOMIC_ACQUIRE, "agent");
            xb_add(&bar[XB_XGEN(b.x)], 1u);
            asm volatile("s_waitcnt vmcnt(0)" ::: "memory");
        } else {
            XB_SPIN(xb_ld(&bar[XB_XGEN(b.x)]) == gen, bar);
            __builtin_amdgcn_fence(__ATOMIC_ACQUIRE, "agent");
            asm volatile("s_waitcnt vmcnt(0)" ::: "memory");
        }
    }
    __syncthreads();
}

__device__ __forceinline__ int tid_opaque() { int t = threadIdx.x; asm volatile("" : "+v"(t)); return t; }
__device__ __forceinline__ int bid_opaque() { int t = blockIdx.x; asm volatile("" : "+s"(t)); return t; }
#define TIDX tid_opaque()
#define BIDX bid_opaque()
typedef __attribute__((ext_vector_type(8))) short bf16x8;
typedef __attribute__((ext_vector_type(4))) float f32x4;
typedef __attribute__((ext_vector_type(4))) unsigned u32x4;
typedef __attribute__((ext_vector_type(2))) __bf16 bf16x2_t;
__device__ __forceinline__ bf16_t f2bf(float f) { return __builtin_bit_cast(bf16_t, (__bf16)f); }
__device__ __forceinline__ float bf2f(bf16_t h) { return __uint_as_float(((unsigned)h) << 16); }
__device__ __forceinline__ unsigned pack2bf(float a, float b) { bf16x2_t v; v[0] = (__bf16)a; v[1] = (__bf16)b; return __builtin_bit_cast(unsigned, v); }
__device__ __forceinline__ float4 ld4bf(const bf16_t* p) { const uint2 u = *(const uint2*)p; float4 r; r.x = __uint_as_float(u.x << 16); r.y = __uint_as_float(u.x & 0xFFFF0000u); r.z = __uint_as_float(u.y << 16); r.w = __uint_as_float(u.y & 0xFFFF0000u); return r; }
__device__ __forceinline__ void st4bf(bf16_t* p, float4 v) { uint2 u; u.x = pack2bf(v.x, v.y); u.y = pack2bf(v.z, v.w); *(uint2*)p = u; }
__device__ __forceinline__ float wave_sum(float v) {
#pragma unroll
    for (int o = 32; o > 0; o >>= 1) v += __shfl_xor(v, o);
    return v;
}
__device__ __forceinline__ float sigmoidf_(float z) { return 1.f / (1.f + __expf(-z)); }
__device__ __forceinline__ float siluf_(float z) { return z / (1.f + __expf(-z)); }
__device__ __forceinline__ int bidx_of(int row) { return row < NLAT ? (row >> 11) : 8; }
__device__ __forceinline__ int kv_pos(int kidx) { const int w = kidx & 31; return (kidx & ~31) | (((w >> 2) & 3) * 8 + (w >> 4) * 4 + (w & 3)); }

__device__ __forceinline__ float block_sum(float v, float* red) {
    v = wave_sum(v);
    __syncthreads();
    if ((TIDX & 63) == 0) red[TIDX >> 6] = v;
    __syncthreads();
    float r = red[0] + red[1] + red[2] + red[3];
    __syncthreads();
    return r;
}

typedef __attribute__((address_space(1))) char gchar_t;
__device__ __forceinline__ gchar_t* ws_opaque(char* w) { gchar_t* g = (gchar_t*)w; asm volatile("" : "+s"(g)); return g; }
#define WQ_SLOTS 32
#define WQ_WORDS ((DEPTH + 1) * WQ_SLOTS * 16)
constexpr size_t ws_al(size_t v) { return (v + 255) / 256 * 256; }
#define WSB(p) ws_opaque((p).ws)
constexpr size_t OFF_bar = 0;
constexpr size_t OFF_cnt = ws_al(OFF_bar + ((XCD_BAR_WORDS + WQ_WORDS) * 4));
constexpr size_t OFF_X = ws_al(OFF_cnt + (DEPTH * 32 * 4));
constexpr size_t OFF_MOD = ws_al(OFF_X + ((size_t)TT * 1024 * 4));
constexpr size_t OFF_LB = ws_al(OFF_MOD + ((size_t)DEPTH * 9 * 6144 * 4));
constexpr size_t OFF_HDN = ws_al(OFF_LB + (DEPTH * 512 * 4));
constexpr size_t OFF_TW = ws_al(OFF_HDN + ((size_t)DEPTH * 2 * 2048 * 64 * 4));
constexpr size_t OFF_KSPEC = ws_al(OFF_TW + (4096 * 8));
constexpr size_t OFF_HYKC = ws_al(OFF_KSPEC + ((size_t)DEPTH * 2 * 256 * 4096 * 8));
constexpr size_t OFF_H = ws_al(OFF_HYKC + ((size_t)DEPTH * 2 * 256 * 2 * 256 * 4));
constexpr size_t OFF_P = ws_al(OFF_H + ((size_t)TT * 1024 * 2));
constexpr size_t OFF_OF = ws_al(OFF_P + ((size_t)TT * DIN * 2));
constexpr size_t OFF_HU = ws_al(OFF_OF + ((size_t)TT * 256 * 4));
constexpr size_t OFF_HQ = ws_al(OFF_HU + ((size_t)1152 * 2 * 4096 * 4));
constexpr size_t OFF_HD = ws_al(OFF_HQ + ((size_t)1152 * 2 * 4096 * 4));
constexpr size_t OFF_NQ = ws_al(OFF_HD + ((size_t)1152 * 2 * 64 * 4));
constexpr size_t OFF_NK = ws_al(OFF_NQ + ((size_t)TT * 256 * 2));
constexpr size_t OFF_NVT = ws_al(OFF_NK + ((size_t)TT * 256 * 2));
constexpr size_t OFF_MQ = ws_al(OFF_NVT + ((size_t)NB * 4 * 64 * 2304 * 2));
constexpr size_t OFF_MK = ws_al(OFF_MQ + ((size_t)TT * 384 * 2));
constexpr size_t OFF_MVT = ws_al(OFF_MK + ((size_t)TT * 384 * 2));
constexpr size_t OFF_CAT = ws_al(OFF_MVT + ((size_t)NB * 4 * 64 * 2304 * 2));
constexpr size_t OFF_EW = ws_al(OFF_CAT + ((size_t)TT * 1024 * 2));
constexpr size_t OFF_LIST = ws_al(OFF_EW + ((size_t)TT * 2 * 4));
constexpr size_t OFF_ACT = ws_al(OFF_LIST + ((size_t)32 * TT * 4));
constexpr size_t OFF_YEXP = ws_al(OFF_ACT + ((size_t)TT * 2 * 512 * 2));
constexpr size_t OFF_norm1_g = ws_al(OFF_YEXP + ((size_t)TT * 2 * 1024 * 4));
constexpr size_t OFF_norm2_g = ws_al(OFF_norm1_g + ((size_t)(DEPTH * 1024) * 4));
constexpr size_t OFF_hgrn_norm_g = ws_al(OFF_norm2_g + ((size_t)(DEPTH * 1024) * 4));
constexpr size_t OFF_hy_short_w = ws_al(OFF_hgrn_norm_g + ((size_t)(DEPTH * 64) * 4));
constexpr size_t OFF_hy_short_b = ws_al(OFF_hy_short_w + ((size_t)(DEPTH * 3 * 768) * 4));
constexpr size_t OFF_hy_bias = ws_al(OFF_hy_short_b + ((size_t)(DEPTH * 768) * 4));
constexpr size_t OFF_na_rpb = ws_al(OFF_hy_bias + ((size_t)(DEPTH * 2 * 256) * 4));
constexpr size_t OFF_na_q_g = ws_al(OFF_na_rpb + ((size_t)(DEPTH * 4 * 15 * 31) * 4));
constexpr size_t OFF_na_k_g = ws_al(OFF_na_q_g + ((size_t)(DEPTH * 64) * 4));
constexpr size_t OFF_mla_q_a_g = ws_al(OFF_na_k_g + ((size_t)(DEPTH * 64) * 4));
constexpr size_t OFF_mla_kv_a_g = ws_al(OFF_mla_q_a_g + ((size_t)(DEPTH * 256) * 4));
constexpr size_t OFF_mla_w_uq = ws_al(OFF_mla_kv_a_g + ((size_t)(DEPTH * 128) * 4));
constexpr size_t OFF_mla_w_ukv = ws_al(OFF_mla_w_uq + ((size_t)(DEPTH * 256 * 384) * 4));
constexpr size_t OFF_mla_q_g = ws_al(OFF_mla_w_ukv + ((size_t)(DEPTH * 128 * 512) * 4));
constexpr size_t OFF_mla_k_g = ws_al(OFF_mla_q_g + ((size_t)(DEPTH * 96) * 4));
constexpr size_t OFF_moe_wg = ws_al(OFF_mla_k_g + ((size_t)(DEPTH * 96) * 4));
constexpr size_t OFF_moe_bg = ws_al(OFF_moe_wg + ((size_t)(DEPTH * 1024 * 4) * 4));
constexpr size_t OFF_moe_we = ws_al(OFF_moe_bg + ((size_t)(DEPTH * 4) * 4));
constexpr size_t OFF_moe_be = ws_al(OFF_moe_we + ((size_t)(DEPTH * 1024 * 32) * 4));
constexpr size_t OFF_WUQT = ws_al(OFF_moe_be + ((size_t)(DEPTH * 32) * 4));
constexpr size_t OFF_WUKVT = ws_al(OFF_WUQT + (size_t)DEPTH * 384 * 256 * 2);
constexpr size_t OFF_ROPE = ws_al(OFF_WUKVT + (size_t)DEPTH * 512 * 128 * 2);
constexpr size_t OFF_SP = ws_al(OFF_ROPE + (size_t)2048 * 16 * 8);
constexpr size_t OFF_WINT = ws_al(OFF_SP + (size_t)1152 * 2 * 4096 * 4);
constexpr size_t OFF_WOUTT = ws_al(OFF_WINT + (size_t)DEPTH * DIN * 1024 * 2);
constexpr size_t WS_TOTAL = ws_al(OFF_WOUTT + (size_t)DEPTH * 1024 * 1024 * 2);
#define W_WINT ((bf16_t*)(WSB(p) + OFF_WINT))
#define W_WOUTT ((bf16_t*)(WSB(p) + OFF_WOUTT))
#define W_SP ((float*)(WSB(p) + OFF_SP))
#define W_WUQT ((bf16_t*)(WSB(p) + OFF_WUQT))
#define W_WUKVT ((bf16_t*)(WSB(p) + OFF_WUKVT))
#define W_ROPE ((float2*)(WSB(p) + OFF_ROPE))
#define W_bar ((unsigned*)(WSB(p) + OFF_bar))
#define W_cnt ((int*)(WSB(p) + OFF_cnt))
#define W_X ((float*)(WSB(p) + OFF_X))
#define W_MOD ((float*)(WSB(p) + OFF_MOD))
#define W_LB ((float*)(WSB(p) + OFF_LB))
#define W_HDN ((float*)(WSB(p) + OFF_HDN))
#define W_TW ((float2*)(WSB(p) + OFF_TW))
#define W_KSPEC ((float2*)(WSB(p) + OFF_KSPEC))
#define W_HYKC ((float*)(WSB(p) + OFF_HYKC))
#define W_H ((bf16_t*)(WSB(p) + OFF_H))
#define W_P ((bf16_t*)(WSB(p) + OFF_P))
#define W_OF ((float*)(WSB(p) + OFF_OF))
#define W_HU ((float*)(WSB(p) + OFF_HU))
#define W_HQ ((float*)(WSB(p) + OFF_HQ))
#define W_HD ((float*)(WSB(p) + OFF_HD))
#define W_NQ ((bf16_t*)(WSB(p) + OFF_NQ))
#define W_NK ((bf16_t*)(WSB(p) + OFF_NK))
#define W_NVT ((bf16_t*)(WSB(p) + OFF_NVT))
#define W_MQ ((bf16_t*)(WSB(p) + OFF_MQ))
#define W_MK ((bf16_t*)(WSB(p) + OFF_MK))
#define W_MVT ((bf16_t*)(WSB(p) + OFF_MVT))
#define W_CAT ((bf16_t*)(WSB(p) + OFF_CAT))
#define W_EW ((float*)(WSB(p) + OFF_EW))
#define W_LIST ((int*)(WSB(p) + OFF_LIST))
#define W_ACT ((bf16_t*)(WSB(p) + OFF_ACT))
#define W_YEXP ((bf16_t*)(WSB(p) + OFF_YEXP))
#define W_wq (W_bar + XCD_BAR_WORDS)
#define W_norm1_g ((const float*)(WSB(p) + OFF_norm1_g))
#define W_norm2_g ((const float*)(WSB(p) + OFF_norm2_g))
#define W_hgrn_norm_g ((const float*)(WSB(p) + OFF_hgrn_norm_g))
#define W_hy_short_w ((const float*)(WSB(p) + OFF_hy_short_w))
#define W_hy_short_b ((const float*)(WSB(p) + OFF_hy_short_b))
#define W_hy_bias ((const float*)(WSB(p) + OFF_hy_bias))
#define W_na_rpb ((const float*)(WSB(p) + OFF_na_rpb))
#define W_na_q_g ((const float*)(WSB(p) + OFF_na_q_g))
#define W_na_k_g ((const float*)(WSB(p) + OFF_na_k_g))
#define W_mla_q_a_g ((const float*)(WSB(p) + OFF_mla_q_a_g))
#define W_mla_kv_a_g ((const float*)(WSB(p) + OFF_mla_kv_a_g))
#define W_mla_w_uq ((const float*)(WSB(p) + OFF_mla_w_uq))
#define W_mla_w_ukv ((const float*)(WSB(p) + OFF_mla_w_ukv))
#define W_mla_q_g ((const float*)(WSB(p) + OFF_mla_q_g))
#define W_mla_k_g ((const float*)(WSB(p) + OFF_mla_k_g))
#define W_moe_wg ((const float*)(WSB(p) + OFF_moe_wg))
#define W_moe_bg ((const float*)(WSB(p) + OFF_moe_bg))
#define W_moe_we ((const float*)(WSB(p) + OFF_moe_we))
#define W_moe_be ((const float*)(WSB(p) + OFF_moe_be))

__device__ __forceinline__ int wq_next(unsigned* ctr, float* sm) {
    int* slot = (int*)(sm + SMF - 1);
    __syncthreads();
    if (TIDX == 0) *slot = (int)__hip_atomic_fetch_add(ctr, 1u, __ATOMIC_RELAXED, __HIP_MEMORY_SCOPE_AGENT);
    __syncthreads();
    return *slot;
}
#define WQ(p, l, site) (W_wq + (((l) + 1) * WQ_SLOTS + (site) + 16 * ((const int*)sm)[SMF - 2]) * 16)
template <class FA, class FB, class FE>
__device__ __forceinline__ void gemm_tile_f32(int K, float* sm, FA fa, FB fb, FE fe) {
    float* As = sm;
    float* Bs = sm + 16 * 68;
    const int tid = TIDX, tx = tid & 15, ty = tid >> 4;
    float acc[4][4];
#pragma unroll
    for (int a = 0; a < 4; a++)
#pragma unroll
        for (int b = 0; b < 4; b++) acc[a][b] = 0.f;
    for (int k0 = 0; k0 < K; k0 += 16) {
#pragma unroll
        for (int q = 0; q < 4; q++) { int e = tid + 256 * q; int i = e >> 4, kk = e & 15; As[kk * 68 + i] = fa(i, k0 + kk); }
#pragma unroll
        for (int q = 0; q < 4; q++) { int e = tid + 256 * q; int kk = e >> 6, j = e & 63; Bs[kk * 68 + j] = fb(k0 + kk, j); }
        __syncthreads();
#pragma unroll
        for (int kk = 0; kk < 16; kk++) {
            float4 a4 = *(const float4*)&As[kk * 68 + ty * 4];
            float4 b4 = *(const float4*)&Bs[kk * 68 + tx * 4];
            float av[4] = {a4.x, a4.y, a4.z, a4.w}, bv[4] = {b4.x, b4.y, b4.z, b4.w};
#pragma unroll
            for (int a = 0; a < 4; a++)
#pragma unroll
                for (int b = 0; b < 4; b++) acc[a][b] += av[a] * bv[b];
        }
        __syncthreads();
    }
#pragma unroll
    for (int a = 0; a < 4; a++)
#pragma unroll
        for (int b = 0; b < 4; b++) fe(ty * 4 + a, tx * 4 + b, acc[a][b]);
}


#define GEMM_LOAD(k0) { _Pragma("unroll") for (int i_ = 0; i_ < 4; i_++) ra[i_] = *(const u32x4*)(ap[i_] + (k0)); \
    _Pragma("unroll") for (int i_ = 0; i_ < 4; i_++) _Pragma("unroll") for (int j_ = 0; j_ < 8; j_++) rb[i_][j_] = bload((k0) + (bkg + 2 * i_) * 8 + j_, bn); }
#define GEMM_WRITE(buf) { char* As_ = smc + (buf) * 16384; char* Bs_ = smc + 32768 + (buf) * 16384; \
    _Pragma("unroll") for (int i_ = 0; i_ < 4; i_++) *(u32x4*)(As_ + (arow + 32 * i_) * 128 + ((ac ^ (arow & 7)) * 16)) = ra[i_]; \
    _Pragma("unroll") for (int i_ = 0; i_ < 4; i_++) { u32x4 b_; b_[0] = pack2bf(rb[i_][0], rb[i_][1]); b_[1] = pack2bf(rb[i_][2], rb[i_][3]); \
        b_[2] = pack2bf(rb[i_][4], rb[i_][5]); b_[3] = pack2bf(rb[i_][6], rb[i_][7]); \
        *(u32x4*)(Bs_ + bn * 128 + (((bkg + 2 * i_) ^ (bn & 7)) * 16)) = b_; } }
template <bool SWAP, class FA, class FB>
__device__ __forceinline__ void gemm128_main(int K, char* smc, FA arowp, FB bload, f32x4 (&acc)[4][4]) {
    const int tid = TIDX, lane = tid & 63, w = tid >> 6;
    const int wm = w >> 1, wn = w & 1, r16 = lane & 15, q = lane >> 4;
#pragma unroll
    for (int i = 0; i < 4; i++)
#pragma unroll
        for (int j = 0; j < 4; j++) acc[i][j] = (f32x4){0.f, 0.f, 0.f, 0.f};
    const int arow = tid >> 3, ac = tid & 7;
    const int bn = tid & 127, bkg = tid >> 7;
    const bf16_t* ap[4];
#pragma unroll
    for (int i = 0; i < 4; i++) ap[i] = arowp(arow + 32 * i) + ac * 8;
    u32x4 ra[4];
    float rb[4][8];
    GEMM_LOAD(0)
    __syncthreads();
    GEMM_WRITE(0)
    __syncthreads();
    const int KT = K >> 6;
    for (int kt = 0; kt < KT; kt++) {
        const bool more = (kt + 1 < KT);
        if (more) GEMM_LOAD((kt + 1) * 64)
        const char* As = smc + (kt & 1) * 16384;
        const char* Bs = smc + 32768 + (kt & 1) * 16384;
#pragma unroll
        for (int ks = 0; ks < 2; ks++) {
            bf16x8 af[4], bfr[4];
            const int sw = ((ks * 4 + q) ^ (r16 & 7)) * 16;
#pragma unroll
            for (int i = 0; i < 4; i++) af[i] = *(const bf16x8*)(As + (wm * 64 + i * 16 + r16) * 128 + sw);
#pragma unroll
            for (int j = 0; j < 4; j++) bfr[j] = *(const bf16x8*)(Bs + (wn * 64 + j * 16 + r16) * 128 + sw);
#pragma unroll
            for (int i = 0; i < 4; i++)
#pragma unroll
                for (int j = 0; j < 4; j++)
                    acc[i][j] = SWAP ? __builtin_amdgcn_mfma_f32_16x16x32_bf16(bfr[j], af[i], acc[i][j], 0, 0, 0)
                                     : __builtin_amdgcn_mfma_f32_16x16x32_bf16(af[i], bfr[j], acc[i][j], 0, 0, 0);
        }
        if (more) GEMM_WRITE((kt + 1) & 1)
        __syncthreads();
    }
}

#define GEMMBT_LOAD(k0) { _Pragma("unroll") for (int i_ = 0; i_ < 4; i_++) { ra[i_] = *(const u32x4*)(ap[i_] + (k0)); rbv[i_] = *(const u32x4*)(bp[i_] + (k0)); } }
#define GEMMBT_WRITE(buf) { char* As_ = smc + (buf) * 16384; char* Bs_ = smc + 32768 + (buf) * 16384; \
    _Pragma("unroll") for (int i_ = 0; i_ < 4; i_++) { *(u32x4*)(As_ + (arow + 32 * i_) * 128 + ((ac ^ (arow & 7)) * 16)) = ra[i_]; \
                                                      *(u32x4*)(Bs_ + (arow + 32 * i_) * 128 + ((ac ^ (arow & 7)) * 16)) = rbv[i_]; } }
#define GEMMBT_LOADS(k0, RA, RB) { _Pragma("unroll") for (int i_ = 0; i_ < 4; i_++) { RA[i_] = *(const u32x4*)(ap[i_] + (k0)); RB[i_] = *(const u32x4*)(bp[i_] + (k0)); } }
#define GEMMBT_WRITES(buf, RA, RB) { char* As_ = smc + (buf) * 16384; char* Bs_ = smc + 32768 + (buf) * 16384; \
    _Pragma("unroll") for (int i_ = 0; i_ < 4; i_++) { *(u32x4*)(As_ + (arow + 32 * i_) * 128 + ((ac ^ (arow & 7)) * 16)) = RA[i_]; \
                                                      *(u32x4*)(Bs_ + (arow + 32 * i_) * 128 + ((ac ^ (arow & 7)) * 16)) = RB[i_]; } }
#define GEMMBT_COMPUTE(buf) { const char* As = smc + (buf) * 16384; const char* Bs = smc + 32768 + (buf) * 16384; \
    _Pragma("unroll") for (int ks = 0; ks < 2; ks++) { bf16x8 af[4], bfr[4]; const int sw = ((ks * 4 + q) ^ (r16 & 7)) * 16; \
        _Pragma("unroll") for (int i = 0; i < 4; i++) af[i] = *(const bf16x8*)(As + (wm * 64 + i * 16 + r16) * 128 + sw); \
        _Pragma("unroll") for (int j = 0; j < 4; j++) bfr[j] = *(const bf16x8*)(Bs + (wn * 64 + j * 16 + r16) * 128 + sw); \
        _Pragma("unroll") for (int i = 0; i < 4; i++) _Pragma("unroll") for (int j = 0; j < 4; j++) \
            acc[i][j] = SWAP ? __builtin_amdgcn_mfma_f32_16x16x32_bf16(bfr[j], af[i], acc[i][j], 0, 0, 0) \
                             : __builtin_amdgcn_mfma_f32_16x16x32_bf16(af[i], bfr[j], acc[i][j], 0, 0, 0); } }
template <bool SWAP, class FA, class FBR>
__device__ __forceinline__ void gemm128_bt(int K, char* smc, FA arowp, FBR browp, f32x4 (&acc)[4][4]) {
    const int tid = TIDX, lane = tid & 63, w = tid >> 6;
    const int wm = w >> 1, wn = w & 1, r16 = lane & 15, q = lane >> 4;
#pragma unroll
    for (int i = 0; i < 4; i++)
#pragma unroll
        for (int j = 0; j < 4; j++) acc[i][j] = (f32x4){0.f, 0.f, 0.f, 0.f};
    const int arow = tid >> 3, ac = tid & 7;
    const bf16_t* ap[4];
    const bf16_t* bp[4];
#pragma unroll
    for (int i = 0; i < 4; i++) { ap[i] = arowp(arow + 32 * i) + ac * 8; bp[i] = browp(arow + 32 * i) + ac * 8; }
    u32x4 ra0[4], rb0[4], ra1[4], rb1[4];
    GEMMBT_LOADS(0, ra0, rb0)
    GEMMBT_LOADS(64, ra1, rb1)
    __syncthreads();
    GEMMBT_WRITES(0, ra0, rb0)
    __syncthreads();
    const int KT = K >> 6;
    for (int kt = 0; kt < KT; kt += 2) {
        if (kt + 2 < KT) GEMMBT_LOADS((kt + 2) * 64, ra0, rb0)
        GEMMBT_COMPUTE(0)
        GEMMBT_WRITES(1, ra1, rb1)
        __syncthreads();
        if (kt + 3 < KT) GEMMBT_LOADS((kt + 3) * 64, ra1, rb1)
        GEMMBT_COMPUTE(1)
        if (kt + 2 < KT) GEMMBT_WRITES(0, ra0, rb0)
        __syncthreads();
    }
}

#define FFT_PHYS(pos) ((pos) + ((pos) >> 4))
__device__ __forceinline__ float2 cmul(float2 a, float2 b) { return make_float2(a.x * b.x - a.y * b.y, a.x * b.y + a.y * b.x); }
__device__ __forceinline__ float2 cmulc(float2 a, float2 b) { return make_float2(a.x * b.x + a.y * b.y, a.y * b.x - a.x * b.y); }
__device__ __forceinline__ void dft4f(float2& a0, float2& a1, float2& a2, float2& a3) {
    const float2 t0 = make_float2(a0.x + a2.x, a0.y + a2.y), t1 = make_float2(a0.x - a2.x, a0.y - a2.y);
    const float2 t2 = make_float2(a1.x + a3.x, a1.y + a3.y), t3 = make_float2(a1.x - a3.x, a1.y - a3.y);
    a0 = make_float2(t0.x + t2.x, t0.y + t2.y);
    a1 = make_float2(t1.x + t3.y, t1.y - t3.x);
    a2 = make_float2(t0.x - t2.x, t0.y - t2.y);
    a3 = make_float2(t1.x - t3.y, t1.y + t3.x);
}
__device__ __forceinline__ void dft4i(float2& a0, float2& a1, float2& a2, float2& a3) {
    const float2 t0 = make_float2(a0.x + a2.x, a0.y + a2.y), t1 = make_float2(a0.x - a2.x, a0.y - a2.y);
    const float2 t2 = make_float2(a1.x + a3.x, a1.y + a3.y), t3 = make_float2(a1.x - a3.x, a1.y - a3.y);
    a0 = make_float2(t0.x + t2.x, t0.y + t2.y);
    a1 = make_float2(t1.x - t3.y, t1.y + t3.x);
    a2 = make_float2(t0.x - t2.x, t0.y - t2.y);
    a3 = make_float2(t1.x + t3.y, t1.y - t3.x);
}
template <int S> struct FftGeo { static constexpr int Ns = 4096 >> (2 * S), Ms = Ns / 4, Ms1 = Ms / 4; };
template <int S>
__device__ __forceinline__ int fft_phys_base(int tid) {
    if (S == 0) return tid + (tid >> 4);
    if (S == 2) return (tid >> 4) * 272 + (tid & 15);
    return tid * 17;
}
template <int S>
__device__ __forceinline__ constexpr int fft_phys_off(int r1, int r2) {
    return S == 0 ? 272 * (r1 * 4 + r2) : (S == 2 ? 68 * r1 + 17 * r2 : 4 * r1 + r2);
}
template <int S>
__device__ __forceinline__ void fft_fwd_pass(float2 (&v)[4][4], int tid, const float2* __restrict__ TW) {
    const int jp = tid % FftGeo<S>::Ms1;
#pragma unroll
    for (int r2 = 0; r2 < 4; r2++) {
        dft4f(v[0][r2], v[1][r2], v[2][r2], v[3][r2]);
        const float2 w = TW[((jp + r2 * FftGeo<S>::Ms1) << (2 * S)) & 4095];
        const float2 w2 = cmul(w, w), w3 = cmul(w2, w);
        v[1][r2] = cmul(v[1][r2], w); v[2][r2] = cmul(v[2][r2], w2); v[3][r2] = cmul(v[3][r2], w3);
    }
    if (S < 4) {
        const float2 w = TW[(jp << (2 * S + 2)) & 4095];
        const float2 w2 = cmul(w, w), w3 = cmul(w2, w);
#pragma unroll
        for (int q1 = 0; q1 < 4; q1++) {
            dft4f(v[q1][0], v[q1][1], v[q1][2], v[q1][3]);
            v[q1][1] = cmul(v[q1][1], w); v[q1][2] = cmul(v[q1][2], w2); v[q1][3] = cmul(v[q1][3], w3);
        }
    } else {
#pragma unroll
        for (int q1 = 0; q1 < 4; q1++) dft4f(v[q1][0], v[q1][1], v[q1][2], v[q1][3]);
    }
}
template <int S>
__device__ __forceinline__ void fft_inv_pass(float2 (&v)[4][4], int tid, const float2* __restrict__ TW) {
    const int jp = tid % FftGeo<S>::Ms1;
    if (S < 4) {
        const float2 w = TW[(jp << (2 * S + 2)) & 4095];
        const float2 w2 = cmul(w, w), w3 = cmul(w2, w);
#pragma unroll
        for (int q1 = 0; q1 < 4; q1++) {
            v[q1][1] = cmulc(v[q1][1], w); v[q1][2] = cmulc(v[q1][2], w2); v[q1][3] = cmulc(v[q1][3], w3);
            dft4i(v[q1][0], v[q1][1], v[q1][2], v[q1][3]);
        }
    } else {
#pragma unroll
        for (int q1 = 0; q1 < 4; q1++) dft4i(v[q1][0], v[q1][1], v[q1][2], v[q1][3]);
    }
#pragma unroll
    for (int r2 = 0; r2 < 4; r2++) {
        const float2 w = TW[((jp + r2 * FftGeo<S>::Ms1) << (2 * S)) & 4095];
        const float2 w2 = cmul(w, w), w3 = cmul(w2, w);
        v[1][r2] = cmulc(v[1][r2], w); v[2][r2] = cmulc(v[2][r2], w2); v[3][r2] = cmulc(v[3][r2], w3);
        dft4i(v[0][r2], v[1][r2], v[2][r2], v[3][r2]);
    }
}
template <int S>
__device__ __forceinline__ void fft_lds_read(float2 (&v)[4][4], int tid, const float2* fb) {
    const float2* fbb = fb + fft_phys_base<S>(tid);
#pragma unroll
    for (int r1 = 0; r1 < 4; r1++)
#pragma unroll
        for (int r2 = 0; r2 < 4; r2++) v[r1][r2] = fbb[fft_phys_off<S>(r1, r2)];
}
template <int S>
__device__ __forceinline__ void fft_lds_write(const float2 (&v)[4][4], int tid, float2* fb) {
    float2* fbb = fb + fft_phys_base<S>(tid);
#pragma unroll
    for (int r1 = 0; r1 < 4; r1++)
#pragma unroll
        for (int r2 = 0; r2 < 4; r2++) fbb[fft_phys_off<S>(r1, r2)] = v[r1][r2];
}

__device__ void phase_pro1(const Params& p, float* sm) {
    const int tid = TIDX, nth = blockDim.x * gridDim.x, gtid = BIDX * blockDim.x + tid;
    for (int i = gtid; i < DEPTH * 32; i += nth) W_cnt[i] = 0;
    for (int i = gtid; i < 4096; i += nth) { float sn, cs; sincospif((float)i * (1.f / 2048.f), &sn, &cs); W_TW[i] = make_float2(cs, -sn); }
    for (int i = gtid; i < 512; i += nth) {
        float z0 = p.lb_logits[i], z1 = p.lb_logits[512 + i], z2 = p.lb_logits[1024 + i], z3 = p.lb_logits[1536 + i];
        float m = fmaxf(fmaxf(z0, z1), fmaxf(z2, z3));
        float e0 = expf(z0 - m), e1 = expf(z1 - m), e2 = expf(z2 - m), e3 = expf(z3 - m);
        float inv = 1.f / (e0 + e1 + e2 + e3);
        W_LB[i] = 0.f; W_LB[512 + i] = e1 * inv; W_LB[1024 + i] = (e1 + e2) * inv; W_LB[1536 + i] = (e1 + e2 + e3) * inv;
    }
    for (int i = gtid; i < DEPTH * 384 * 256; i += nth) {
        const int k = i & 255, n = (i >> 8) % 384, ll = i / (384 * 256);
        ((bf16_t*)(p.ws + OFF_WUQT))[i] = f2bf(p.mla_q_a_g[ll * 256 + k] * p.mla_w_uq[(size_t)(ll * 256 + k) * 384 + n]);
    }
    for (int i = gtid; i < DEPTH * 512 * 128; i += nth) {
        const int k = i & 127, n = (i >> 7) & 511, ll = i >> 16;
        ((bf16_t*)(p.ws + OFF_WUKVT))[i] = f2bf(p.mla_kv_a_g[ll * 128 + k] * p.mla_w_ukv[(size_t)(ll * 128 + k) * 512 + n]);
    }
    for (int i = gtid; i < 2048 * 16; i += nth) {
        const int t = i >> 4, j = i & 15;
        const float pos = j < 8 ? (float)(t >> 6) : (float)(t & 63);
        const float inv = expf(-9.210340371976184f * (float)(j & 7) * 0.125f);
        float sn, cs;
        sincosf(pos * inv, &sn, &cs);
        ((float2*)(p.ws + OFF_ROPE))[i] = make_float2(cs, sn);
    }
    {
        const int NT_IN = DEPTH * 16 * 51, NT_OUT = DEPTH * 16 * 16;
        for (int u = wq_next(WQ(p, -1, 2), sm); u < NT_IN + NT_OUT; u = wq_next(WQ(p, -1, 2), sm)) {
            const float* src; bf16_t* dst; int N, kt, nt;
            if (u < NT_IN) { const int ll = u / (16 * 51), r = u % (16 * 51); kt = r / 51; nt = r % 51; N = DIN; src = p.w_in + (size_t)ll * 1024 * DIN; dst = (bf16_t*)(p.ws + OFF_WINT) + (size_t)ll * DIN * 1024; }
            else { const int v = u - NT_IN; const int ll = v >> 8, r = v & 255; kt = r >> 4; nt = r & 15; N = 1024; src = p.w_out + (size_t)ll * 1024 * 1024; dst = (bf16_t*)(p.ws + OFF_WOUTT) + (size_t)ll * 1024 * 1024; }
#pragma unroll
            for (int i = 0; i < 4; i++) {
                const int idx = tid + 256 * i, kr = idx >> 4, c4 = idx & 15;
                const int n = nt * 64 + c4 * 4;
                float4 v = make_float4(0.f, 0.f, 0.f, 0.f);
                if (n < N) v = *(const float4*)&src[(size_t)(kt * 64 + kr) * N + n];
                sm[kr * 68 + c4 * 4 + 0] = v.x; sm[kr * 68 + c4 * 4 + 1] = v.y; sm[kr * 68 + c4 * 4 + 2] = v.z; sm[kr * 68 + c4 * 4 + 3] = v.w;
            }
            __syncthreads();
#pragma unroll
            for (int i = 0; i < 2; i++) {
                const int idx = tid + 256 * i, nr = idx >> 3, c8 = idx & 7;
                const int n = nt * 64 + nr;
                if (n < N) {
                    u32x4 o;
                    o[0] = pack2bf(sm[(c8 * 8 + 0) * 68 + nr], sm[(c8 * 8 + 1) * 68 + nr]); o[1] = pack2bf(sm[(c8 * 8 + 2) * 68 + nr], sm[(c8 * 8 + 3) * 68 + nr]);
                    o[2] = pack2bf(sm[(c8 * 8 + 4) * 68 + nr], sm[(c8 * 8 + 5) * 68 + nr]); o[3] = pack2bf(sm[(c8 * 8 + 6) * 68 + nr], sm[(c8 * 8 + 7) * 68 + nr]);
                    *(u32x4*)&dst[(size_t)n * 1024 + kt * 64 + c8 * 8] = o;
                }
            }
        }
    }
    for (int i = gtid; i < (DEPTH * 1024); i += nth) ((float*)(WSB(p) + OFF_norm1_g))[i] = p.norm1_g[i];
    for (int i = gtid; i < (DEPTH * 1024); i += nth) ((float*)(WSB(p) + OFF_norm2_g))[i] = p.norm2_g[i];
    for (int i = gtid; i < (DEPTH * 64); i += nth) ((float*)(WSB(p) + OFF_hgrn_norm_g))[i] = p.hgrn_norm_g[i];
    for (int i = gtid; i < (DEPTH * 3 * 768); i += nth) ((float*)(WSB(p) + OFF_hy_short_w))[i] = p.hy_short_w[i];
    for (int i = gtid; i < (DEPTH * 768); i += nth) ((float*)(WSB(p) + OFF_hy_short_b))[i] = p.hy_short_b[i];
    for (int i = gtid; i < (DEPTH * 2 * 256); i += nth) ((float*)(WSB(p) + OFF_hy_bias))[i] = p.hy_bias[i];
    for (int i = gtid; i < (DEPTH * 4 * 15 * 31); i += nth) ((float*)(WSB(p) + OFF_na_rpb))[i] = p.na_rpb[i];
    for (int i = gtid; i < (DEPTH * 64); i += nth) ((float*)(WSB(p) + OFF_na_q_g))[i] = p.na_q_g[i];
    for (int i = gtid; i < (DEPTH * 64); i += nth) ((float*)(WSB(p) + OFF_na_k_g))[i] = p.na_k_g[i];
    for (int i = gtid; i < (DEPTH * 256); i += nth) ((float*)(WSB(p) + OFF_mla_q_a_g))[i] = p.mla_q_a_g[i];
    for (int i = gtid; i < (DEPTH * 128); i += nth) ((float*)(WSB(p) + OFF_mla_kv_a_g))[i] = p.mla_kv_a_g[i];
    for (int i = gtid; i < (DEPTH * 256 * 384); i += nth) ((float*)(WSB(p) + OFF_mla_w_uq))[i] = p.mla_w_uq[i];
    for (int i = gtid; i < (DEPTH * 128 * 512); i += nth) ((float*)(WSB(p) + OFF_mla_w_ukv))[i] = p.mla_w_ukv[i];
    for (int i = gtid; i < (DEPTH * 96); i += nth) ((float*)(WSB(p) + OFF_mla_q_g))[i] = p.mla_q_g[i];
    for (int i = gtid; i < (DEPTH * 96); i += nth) ((float*)(WSB(p) + OFF_mla_k_g))[i] = p.mla_k_g[i];
    for (int i = gtid; i < (DEPTH * 1024 * 4); i += nth) ((float*)(WSB(p) + OFF_moe_wg))[i] = p.moe_wg[i];
    for (int i = gtid; i < (DEPTH * 4); i += nth) ((float*)(WSB(p) + OFF_moe_bg))[i] = p.moe_bg[i];
    for (int i = gtid; i < (DEPTH * 1024 * 32); i += nth) ((float*)(WSB(p) + OFF_moe_we))[i] = p.moe_we[i];
    for (int i = gtid; i < (DEPTH * 32); i += nth) ((float*)(WSB(p) + OFF_moe_be))[i] = p.moe_be[i];
    for (int u = wq_next(WQ(p, -1, 0), sm); u < DEPTH * 96; u = wq_next(WQ(p, -1, 0), sm)) {
        const int l = u / 96, cg = u % 96;
        for (int i = tid; i < 9 * 1024; i += 256) { float v = i < 8192 ? p.c[i] : p.c_ctx[i - 8192]; sm[i] = siluf_(v); }
        __syncthreads();
        const int col = cg * 64 + (tid & 63), kq = tid >> 6;
        float acc[9];
#pragma unroll
        for (int r = 0; r < 9; r++) acc[r] = 0.f;
        const float* w = p.w_ada + (size_t)l * 1024 * 6144 + col;
        for (int k = kq * 256; k < kq * 256 + 256; k++) {
            float wv = w[(size_t)k * 6144];
#pragma unroll
            for (int r = 0; r < 9; r++) acc[r] += sm[r * 1024 + k] * wv;
        }
        float* red = sm + 9 * 1024;
#pragma unroll
        for (int r = 0; r < 9; r++) red[(kq * 9 + r) * 64 + (tid & 63)] = acc[r];
        __syncthreads();
        if (tid < 64) {
#pragma unroll
            for (int r = 0; r < 9; r++)
                W_MOD[(size_t)(l * 9 + r) * 6144 + col] = red[(0 * 9 + r) * 64 + tid] + red[(1 * 9 + r) * 64 + tid] + red[(2 * 9 + r) * 64 + tid] +
                                                          red[(3 * 9 + r) * 64 + tid] + p.b_ada[l * 6144 + col];
        }
        __syncthreads();
    }
    {
        const int wave = tid >> 6, lane = tid & 63;
        for (int wu = BIDX * 4 + wave; wu < DEPTH * 2304; wu += gridDim.x * 4) {
            const int l = wu / 2304, rem = wu % 2304;
            const int which = rem >= 2048 ? 1 : 0;
            const int t = which ? rem - 2048 : rem;
            const int L = which ? 256 : 2048;
            const float tu = (float)t / (float)(L - 1);
            float feat = 0.f;
            if (lane == 0) feat = tu;
            else if (lane <= 32) {
                const int bi = (lane - 1) & 15;
                const float band = 1e-4f + (float)bi * ((15.f - 1e-4f) / 15.f);
                float uu = (float)t * band / (float)L;
                uu -= floorf(uu);
                float s_, c_;
                sincospif(2.f * uu, &s_, &c_);
                feat = lane <= 16 ? c_ : -s_;
            }
            const float fr = p.hy_freq[l * 64 + lane];
            float a = p.hy_b1[l * 64 + lane];
            for (int e = 0; e < 33; e++) a += __shfl(feat, e) * p.hy_w1[(l * 33 + e) * 64 + lane];
            const float h1 = sinf(fr * a);
            float a2 = p.hy_b2[l * 64 + lane];
            for (int i = 0; i < 64; i++) a2 += __shfl(h1, i) * p.hy_w2[(l * 64 + i) * 64 + lane];
            const float h2 = sinf(fr * a2);
            W_HDN[((size_t)(l * 2 + which) * 2048 + t) * 64 + lane] = h2;
        }
    }
}

template <int LL>
__device__ __forceinline__ void hyk_unit(const Params& p, int l, int o, int c, float* sm) {
    constexpr int NT = LL / 256;
    constexpr int which = (LL == 256) ? 1 : 0;
    const int tid = TIDX;
    const int colf = o * 512 + c, colb = o * 512 + 256 + c;
    __syncthreads();
    if (tid < 64) { sm[tid] = p.hy_w3[(size_t)(l * 64 + tid) * 1024 + colf]; sm[64 + tid] = p.hy_w3[(size_t)(l * 64 + tid) * 1024 + colb]; }
    __syncthreads();
    const float bf = p.hy_b3[l * 1024 + colf], bb = p.hy_b3[l * 1024 + colb];
    const float df = p.hy_decay[((l * 2 + o) * 2 + 0) * 256 + c], dbw = p.hy_decay[((l * 2 + o) * 2 + 1) * 256 + c];
    float vf[NT], vb[NT];
    float ss = 0.f;
#pragma unroll
    for (int i = 0; i < NT; i++) {
        const int t = tid + 256 * i;
        const float* h = W_HDN + ((size_t)(l * 2 + which) * 2048 + t) * 64;
        float af = bf, ab = bb;
#pragma unroll 4
        for (int k = 0; k < 64; k++) { float hv = h[k]; af += hv * sm[k]; ab += hv * sm[64 + k]; }
        const float tu = (float)t / (float)(LL - 1);
        af *= expf(-tu * df); ab *= expf(-tu * dbw);
        vf[i] = af; vb[i] = ab;
        ss += af * af + (t > 0 ? ab * ab : 0.f);
    }
    const float tot = block_sum(ss, sm + 128);
    const float scale = rsqrtf(tot + EPSF);
    if (which) {
        float* outp = W_HYKC + (size_t)((l * 2 + o) * 256 + c) * 2 * LL;
#pragma unroll
        for (int i = 0; i < NT; i++) { const int t = tid + 256 * i; outp[t] = vf[i] * scale; outp[LL + t] = vb[i] * scale; }
    } else {
        float* kl = sm + 256;
        float2* fb = (float2*)(sm + 256 + 4096);
#pragma unroll
        for (int i = 0; i < NT; i++) {
            const int t = tid + 256 * i;
            kl[t] = vf[i] * scale;
            if (t > 0) kl[4096 - t] = vb[i] * scale;
        }
        if (tid == 0) kl[2048] = 0.f;
        __syncthreads();
        float2 v[4][4];
#pragma unroll
        for (int r1 = 0; r1 < 4; r1++)
#pragma unroll
            for (int r2 = 0; r2 < 4; r2++) v[r1][r2] = make_float2(kl[tid + 256 * (r1 * 4 + r2)], 0.f);
        fft_fwd_pass<0>(v, tid, W_TW);
        fft_lds_write<0>(v, tid, fb);
        __syncthreads();
        fft_lds_read<2>(v, tid, fb);
        fft_fwd_pass<2>(v, tid, W_TW);
        fft_lds_write<2>(v, tid, fb);
        __syncthreads();
        fft_lds_read<4>(v, tid, fb);
        fft_fwd_pass<4>(v, tid, W_TW);
        float2* outp = W_KSPEC + (size_t)((l * 2 + o) * 256 + c) * 4096 + tid * 16;
#pragma unroll
        for (int r1 = 0; r1 < 4; r1++)
#pragma unroll
            for (int r2 = 0; r2 < 4; r2++) outp[r1 * 4 + r2] = make_float2(v[r1][r2].x * (1.f / 4096.f), v[r1][r2].y * (1.f / 4096.f));
    }
}
__device__ void phase_pro2(const Params& p, float* sm) {
    for (int u = wq_next(WQ(p, -1, 1), sm); u < DEPTH * 512 + (DEPTH - 1) * 512; u = wq_next(WQ(p, -1, 1), sm)) {
        const int which = u / (DEPTH * 512), r = u % (DEPTH * 512);
        const int l = r / 512, o = (r / 256) & 1, c = r & 255;
        if (which == 0) hyk_unit<2048>(p, l, o, c, sm); else hyk_unit<256>(p, l, o, c, sm);
    }
}

__device__ void phase_norm1(const Params& p, int l, float* sm) {
    const int wave = TIDX >> 6, lane = TIDX & 63;
    for (int row = BIDX * 4 + wave; row < TT; row += gridDim.x * 4) {
        const int bi = bidx_of(row);
        float4 xv[4];
        float ss = 0.f;
#pragma unroll
        for (int i = 0; i < 4; i++) {
            const int k = i * 256 + lane * 4;
            const float* xsrc = l > 0 ? &W_X[(size_t)row * 1024 + k] : (row < NLAT ? &p.x[(size_t)row * 1024 + k] : &p.ctx[(size_t)(row - NLAT) * 1024 + k]);
            float4 v = *(const float4*)xsrc;
            if (l > 0) {
                const float4 g2 = *(const float4*)&W_MOD[(size_t)((l - 1) * 9 + bi) * 6144 + 5120 + k];
                const float4 y0 = ld4bf(&W_YEXP[((size_t)row * 2 + 0) * 1024 + k]);
                const float4 y1 = ld4bf(&W_YEXP[((size_t)row * 2 + 1) * 1024 + k]);
                v.x += g2.x * (y0.x + y1.x); v.y += g2.y * (y0.y + y1.y); v.z += g2.z * (y0.z + y1.z); v.w += g2.w * (y0.w + y1.w);
                *(float4*)&W_X[(size_t)row * 1024 + k] = v;
            }
            xv[i] = v;
            ss += v.x * v.x + v.y * v.y + v.z * v.z + v.w * v.w;
        }
        ss = wave_sum(ss);
        const float rstd = rsqrtf(ss * (1.f / 1024.f) + EPSF);
        const float* md = W_MOD + (size_t)(l * 9 + bi) * 6144;
#pragma unroll
        for (int i = 0; i < 4; i++) {
            const int k = i * 256 + lane * 4;
            const float4 g = *(const float4*)&W_norm1_g[l * 1024 + k];
            const float4 sh = *(const float4*)&md[k];
            const float4 sc = *(const float4*)&md[1024 + k];
            float4 o;
            o.x = xv[i].x * rstd * g.x * (1.f + sc.x) + sh.x;
            o.y = xv[i].y * rstd * g.y * (1.f + sc.y) + sh.y;
            o.z = xv[i].z * rstd * g.z * (1.f + sc.z) + sh.z;
            o.w = xv[i].w * rstd * g.w * (1.f + sc.w) + sh.w;
            st4bf(&W_H[(size_t)row * 1024 + k], o);
        }
    }
}

__device__ void phase_final(const Params& p, float* sm) {
    const int nth = blockDim.x * gridDim.x, gtid = BIDX * blockDim.x + TIDX;
    for (int i = gtid; i < NLAT * 256; i += nth) {
        const int row = i >> 8, k = (i & 255) * 4;
        const int bi = row >> 11;
        float4 v = *(const float4*)&W_X[(size_t)row * 1024 + k];
        const float4 g2 = *(const float4*)&W_MOD[(size_t)(3 * 9 + bi) * 6144 + 5120 + k];
        const float4 y0 = ld4bf(&W_YEXP[((size_t)row * 2 + 0) * 1024 + k]);
        const float4 y1 = ld4bf(&W_YEXP[((size_t)row * 2 + 1) * 1024 + k]);
        v.x += g2.x * (y0.x + y1.x); v.y += g2.y * (y0.y + y1.y); v.z += g2.z * (y0.z + y1.z); v.w += g2.w * (y0.w + y1.w);
        *(float4*)&p.out[(size_t)row * 1024 + k] = v;
    }
}

__device__ void phase_gemm1(const Params& p, int l, float* sm) {
    const int NTN = (DIN + 127) / 128;
    const float* W = p.w_in + (size_t)l * 1024 * DIN;
    const int tid = TIDX, lane = tid & 63, w = tid >> 6, wm = w >> 1, wn = w & 1, r16 = lane & 15, q = lane >> 4;
    for (int u = wq_next(WQ(p, l, 0), sm); u < 144 * 4 * 7; u = wq_next(WQ(p, l, 0), sm)) {
        const int band = u / (144 * 4), rem = u % (144 * 4);
        const int bw = min(4, NTN - band * 4);
        const int rb = rem / bw, cb = band * 4 + rem % bw;
        if (rb >= 144) continue;
        const int r0 = rb * 128, n0 = cb * 128;
        f32x4 acc[4][4];
        const bf16_t* hb = W_H + (size_t)r0 * 1024;
        const bf16_t* wb = W_WINT + (size_t)l * DIN * 1024;
        gemm128_bt<true>(1024, (char*)sm, [&](int r) { return hb + (size_t)r * 1024; },
                         [&](int r) { return wb + (size_t)min(n0 + r, DIN - 1) * 1024; }, acc);
#pragma unroll
        for (int i = 0; i < 4; i++)
#pragma unroll
            for (int j = 0; j < 4; j++) {
                const int m = r0 + wm * 64 + i * 16 + r16, n = n0 + wn * 64 + j * 16 + q * 4;
                if (n < DIN) st4bf(&W_P[(size_t)m * DIN + n], make_float4(acc[i][j][0], acc[i][j][1], acc[i][j][2], acc[i][j][3]));
            }
    }
}

__device__ void phase_prep_main(const Params& p, int l, float* sm);
__device__ __forceinline__ void hgrn_local_unit(const Params& p, int l, int u, float* sm);
__device__ void phase_prep(const Params& p, int l, float* sm) {
    const bool main_first = (BIDX >> 8) & 1;
    if (main_first) phase_prep_main(p, l, sm);
    for (int u = wq_next(WQ(p, l, 1), sm); u < 1152; u = wq_next(WQ(p, l, 1), sm)) hgrn_local_unit(p, l, u, sm);
    if (!main_first) phase_prep_main(p, l, sm);
}
__device__ void phase_prep_main(const Params& p, int l, float* sm) {
    const int tid = TIDX, lane = tid & 63, w = tid >> 6, r16 = lane & 15, q4 = lane >> 4;
    char* smc = (char*)sm;
    char* Acq = smc;
    char* Ackv = smc + 8448;
    float* R = (float*)(smc + 12800);
    float* krf = (float*)(smc + 12800 + 16 * 516 * 4);
    float* rsq = krf + 512;
    float* rskv = rsq + 16;
    for (int u = wq_next(WQ(p, l, 2), sm); u < TT / 16; u = wq_next(WQ(p, l, 2), sm)) {
        const int r0 = u * 16;
        const bool lat = r0 < NLAT;
        const int bb = lat ? (r0 >> 11) : ((r0 - NLAT) >> 8);
        const int kidx0 = lat ? (r0 & 2047) : 2048 + ((r0 - NLAT) & 255);
        const int posb = (kidx0 & ~31) + ((kidx0 >> 4) & 1) * 4;
        const bf16_t* Pb = W_P + (size_t)r0 * DIN;
        {
            for (int c = tid; c < 512; c += 256) { const int row = c >> 5, cc = c & 31; *(u32x4*)(Acq + row * 528 + cc * 16) = *(const u32x4*)(Pb + (size_t)row * DIN + C_CQ + cc * 8); }
            { const int row = tid >> 4, cc = tid & 15; *(u32x4*)(Ackv + row * 272 + cc * 16) = *(const u32x4*)(Pb + (size_t)row * DIN + C_CKV + cc * 8); }
            for (int i = tid; i < 512; i += 256) krf[i] = bf2f(Pb[(size_t)(i >> 5) * DIN + C_KR + (i & 31)]);
        }
        {
            const float4 gq = *(const float4*)&W_na_q_g[l * 64 + r16 * 4];
            const float4 gk = *(const float4*)&W_na_k_g[l * 64 + r16 * 4];
#pragma unroll 2
            for (int ps = 0; ps < 8; ps++) {
                const int item = ps * 16 + (tid >> 4);
                const int tk = item >> 3, h = (item >> 1) & 3, wh = item & 1;
                const float4 v = ld4bf(Pb + (size_t)tk * DIN + C_NA + wh * 256 + h * 64 + r16 * 4);
                float ss = v.x * v.x + v.y * v.y + v.z * v.z + v.w * v.w;
                ss += __shfl_xor(ss, 1); ss += __shfl_xor(ss, 2); ss += __shfl_xor(ss, 4); ss += __shfl_xor(ss, 8);
                const float rs = rsqrtf(ss * (1.f / 64.f) + EPSF);
                const float4 g = wh ? gk : gq;
                st4bf((wh ? W_NK : W_NQ) + (size_t)(r0 + tk) * 256 + h * 64 + r16 * 4, make_float4(v.x * rs * g.x, v.y * rs * g.y, v.z * rs * g.z, v.w * rs * g.w));
            }
            const int h = tid >> 6, d = tid & 63;
            bf16_t* dst = W_NVT + (size_t)((bb * 4 + h) * 64 + d) * 2304 + posb;
#pragma unroll
            for (int qq = 0; qq < 4; qq++) {
                const bf16_t* src = Pb + (size_t)(qq * 4) * DIN + C_NA + 512 + h * 64 + d;
                uint2 pk;
                pk.x = (unsigned)src[0] | ((unsigned)src[DIN] << 16);
                pk.y = (unsigned)src[2 * DIN] | ((unsigned)src[3 * DIN] << 16);
                *(uint2*)(dst + qq * 8) = pk;
            }
        }
        __syncthreads();
        {
            const int tk = w * 4 + q4;
            float ss = 0.f;
#pragma unroll
            for (int j = 0; j < 2; j++) { const float4 a = ld4bf((const bf16_t*)(Acq + tk * 528) + r16 * 16 + j * 8), b = ld4bf((const bf16_t*)(Acq + tk * 528) + r16 * 16 + j * 8 + 4);
                ss += a.x * a.x + a.y * a.y + a.z * a.z + a.w * a.w + b.x * b.x + b.y * b.y + b.z * b.z + b.w * b.w; }
            ss += __shfl_xor(ss, 1); ss += __shfl_xor(ss, 2); ss += __shfl_xor(ss, 4); ss += __shfl_xor(ss, 8);
            float s2 = 0.f;
            { const float4 a = ld4bf((const bf16_t*)(Ackv + tk * 272) + r16 * 8), b = ld4bf((const bf16_t*)(Ackv + tk * 272) + r16 * 8 + 4);
              s2 = a.x * a.x + a.y * a.y + a.z * a.z + a.w * a.w + b.x * b.x + b.y * b.y + b.z * b.z + b.w * b.w; }
            s2 += __shfl_xor(s2, 1); s2 += __shfl_xor(s2, 2); s2 += __shfl_xor(s2, 4); s2 += __shfl_xor(s2, 8);
            if (r16 == 0) { rsq[tk] = rsqrtf(ss * (1.f / 256.f) + EPSF); rskv[tk] = rsqrtf(s2 * (1.f / 128.f) + EPSF); }
        }
        __syncthreads();
        {
            const bf16_t* WB = W_WUQT + (size_t)l * 384 * 256;
            const float rs = rsq[r16];
#pragma unroll 2
            for (int it = 0; it < 6; it++) {
                const int nt = it * 4 + w;
                f32x4 acc = (f32x4){0.f, 0.f, 0.f, 0.f};
#pragma unroll
                for (int ks = 0; ks < 8; ks++) {
                    const bf16x8 bfr = *(const bf16x8*)(WB + (size_t)(nt * 16 + r16) * 256 + ks * 32 + q4 * 8);
                    const bf16x8 afr = *(const bf16x8*)(Acq + r16 * 528 + ks * 64 + q4 * 16);
                    acc = __builtin_amdgcn_mfma_f32_16x16x32_bf16(bfr, afr, acc, 0, 0, 0);
                }
                *(float4*)&R[r16 * 516 + nt * 16 + q4 * 4] = make_float4(acc[0] * rs, acc[1] * rs, acc[2] * rs, acc[3] * rs);
            }
        }
        __syncthreads();
        {
            const int tk = w * 4 + q4;
            const int trow = r0 + tk;
            const float* gq = W_mla_q_g + l * 96;
            const float2* rp = W_ROPE + (size_t)(trow & 2047) * 16;
#pragma unroll 1
            for (int h = 0; h < 4; h++) {
                float v[6];
                float ss = 0.f;
#pragma unroll
                for (int m = 0; m < 6; m++) { v[m] = R[tk * 516 + h * 96 + m * 16 + r16]; ss += v[m] * v[m]; }
                ss += __shfl_xor(ss, 1); ss += __shfl_xor(ss, 2); ss += __shfl_xor(ss, 4); ss += __shfl_xor(ss, 8);
                const float rs = rsqrtf(ss * (1.f / 96.f) + EPSF);
#pragma unroll
                for (int m = 0; m < 6; m++) v[m] = v[m] * rs * gq[m * 16 + r16];
                if (lat) {
#pragma unroll
                    for (int m = 4; m < 6; m++) {
                        const float other = __shfl_xor(v[m], 8);
                        const float2 cs = rp[(m - 4) * 8 + (r16 & 7)];
                        v[m] = (r16 < 8) ? (v[m] * cs.x - other * cs.y) : (other * cs.y + v[m] * cs.x);
                    }
                }
                bf16_t* dst = W_MQ + (size_t)trow * 384 + h * 96;
#pragma unroll
                for (int m = 0; m < 6; m++) dst[m * 16 + r16] = f2bf(v[m]);
            }
        }
        __syncthreads();
        {
            const bf16_t* WB = W_WUKVT + (size_t)l * 512 * 128;
            const float rs = rskv[r16];
#pragma unroll 2
            for (int it = 0; it < 8; it++) {
                const int nt = it * 4 + w;
                f32x4 acc = (f32x4){0.f, 0.f, 0.f, 0.f};
#pragma unroll
                for (int ks = 0; ks < 4; ks++) {
                    const bf16x8 bfr = *(const bf16x8*)(WB + (size_t)(nt * 16 + r16) * 128 + ks * 32 + q4 * 8);
                    const bf16x8 afr = *(const bf16x8*)(Ackv + r16 * 272 + ks * 64 + q4 * 16);
                    acc = __builtin_amdgcn_mfma_f32_16x16x32_bf16(bfr, afr, acc, 0, 0, 0);
                }
                *(float4*)&R[r16 * 516 + nt * 16 + q4 * 4] = make_float4(acc[0] * rs, acc[1] * rs, acc[2] * rs, acc[3] * rs);
            }
        }
        __syncthreads();
        {
            const int tk = w * 4 + q4;
            const int trow = r0 + tk;
            const float* gk = W_mla_k_g + l * 96;
            const float2* rp = W_ROPE + (size_t)(trow & 2047) * 16;
            const float kr0 = krf[tk * 32 + r16], kr1 = krf[tk * 32 + 16 + r16];
#pragma unroll 1
            for (int h = 0; h < 4; h++) {
                float v[6];
                float ss = 0.f;
#pragma unroll
                for (int m = 0; m < 4; m++) { v[m] = R[tk * 516 + h * 128 + m * 16 + r16]; ss += v[m] * v[m]; }
                v[4] = kr0; v[5] = kr1; ss += kr0 * kr0 + kr1 * kr1;
                ss += __shfl_xor(ss, 1); ss += __shfl_xor(ss, 2); ss += __shfl_xor(ss, 4); ss += __shfl_xor(ss, 8);
                const float rs = rsqrtf(ss * (1.f / 96.f) + EPSF);
#pragma unroll
                for (int m = 0; m < 6; m++) v[m] = v[m] * rs * gk[m * 16 + r16];
                if (lat) {
#pragma unroll
                    for (int m = 4; m < 6; m++) {
                        const float other = __shfl_xor(v[m], 8);
                        const float2 cs = rp[(m - 4) * 8 + (r16 & 7)];
                        v[m] = (r16 < 8) ? (v[m] * cs.x - other * cs.y) : (other * cs.y + v[m] * cs.x);
                    }
                }
                bf16_t* dst = W_MK + (size_t)trow * 384 + h * 96;
#pragma unroll
                for (int m = 0; m < 6; m++) dst[m * 16 + r16] = f2bf(v[m]);
            }
        }
        {
            const int h = tid >> 6, d = tid & 63;
            bf16_t* dst = W_MVT + (size_t)((bb * 4 + h) * 64 + d) * 2304 + posb;
            const float* src = R + h * 128 + 64 + d;
#pragma unroll
            for (int qq = 0; qq < 4; qq++) {
                uint2 pk;
                pk.x = pack2bf(src[(qq * 4 + 0) * 516], src[(qq * 4 + 1) * 516]);
                pk.y = pack2bf(src[(qq * 4 + 2) * 516], src[(qq * 4 + 3) * 516]);
                *(uint2*)(dst + qq * 8) = pk;
            }
        }
    }
}

template <int DQK, int QT, bool NA, class KIDX>
__device__ __forceinline__ void flash_attn(char* smc, const bf16_t* qrow0, int qstride, const bf16_t* kbuf_h, int kstride, int b,
                                           const bf16_t* vbase_bh, int nkb, KIDX kidx_of, float scale, bf16_t* orow0, int ostride,
                                           const float* rpbs, int na_r, int na_rs) {
    constexpr int KS = DQK / 32, CPR = DQK / 8, KSTR = DQK * 2 + 16, KBUF = 64 * KSTR, NKC = 64 * CPR / 256, VSTR = 144, VBUF = 64 * VSTR;
    const int tid = TIDX, lane = tid & 63, w = tid >> 6, r16 = lane & 15, q = lane >> 4;
    char* Kb = smc;
    char* Vb = smc + 2 * KBUF;
    bf16x8 qf[QT][KS];
#pragma unroll
    for (int qt = 0; qt < QT; qt++)
#pragma unroll
        for (int ks = 0; ks < KS; ks++) qf[qt][ks] = *(const bf16x8*)(qrow0 + (size_t)(w * QT * 16 + qt * 16 + r16) * qstride + ks * 32 + q * 8);
    f32x4 o[4][QT];
    float m[QT], ls[QT];
#pragma unroll
    for (int qt = 0; qt < QT; qt++) {
        m[qt] = -1e30f; ls[qt] = 0.f;
#pragma unroll
        for (int dt = 0; dt < 4; dt++) o[dt][qt] = (f32x4){0.f, 0.f, 0.f, 0.f};
    }
    u32x4 rk[NKC], rv[2];
    {
        const int kidx = kidx_of(0);
        const int trow = kidx < 2048 ? b * 2048 + kidx : NLAT + b * 256 + (kidx - 2048);
        const bf16_t* kp = kbuf_h + (size_t)trow * kstride;
        const bf16_t* vp = vbase_bh + kidx;
#pragma unroll
        for (int i = 0; i < NKC; i++) { const int c = tid + 256 * i; const int row = c / CPR, cc = c % CPR; rk[i] = *(const u32x4*)(kp + (size_t)row * kstride + cc * 8); }
#pragma unroll
        for (int i = 0; i < 2; i++) { const int c = tid + 256 * i; const int row = c >> 3, cc = c & 7; rv[i] = *(const u32x4*)(vp + (size_t)row * 2304 + cc * 8); }
    }
    __syncthreads();
#pragma unroll
    for (int i = 0; i < NKC; i++) { const int c = tid + 256 * i; const int row = c / CPR, cc = c % CPR; *(u32x4*)(Kb + row * KSTR + cc * 16) = rk[i]; }
#pragma unroll
    for (int i = 0; i < 2; i++) { const int c = tid + 256 * i; const int row = c >> 3, cc = c & 7; *(u32x4*)(Vb + row * VSTR + cc * 16) = rv[i]; }
    __syncthreads();
    for (int kb = 0; kb < nkb; kb++) {
        const bool more = kb + 1 < nkb;
        if (more) {
            const int kidx = kidx_of(kb + 1);
            const int trow = kidx < 2048 ? b * 2048 + kidx : NLAT + b * 256 + (kidx - 2048);
            const bf16_t* kp = kbuf_h + (size_t)trow * kstride;
            const bf16_t* vp = vbase_bh + kidx;
#pragma unroll
            for (int i = 0; i < NKC; i++) { const int c = tid + 256 * i; const int row = c / CPR, cc = c % CPR; rk[i] = *(const u32x4*)(kp + (size_t)row * kstride + cc * 8); }
#pragma unroll
            for (int i = 0; i < 2; i++) { const int c = tid + 256 * i; const int row = c >> 3, cc = c & 7; rv[i] = *(const u32x4*)(vp + (size_t)row * 2304 + cc * 8); }
        }
        const char* Ks_ = Kb + (kb & 1) * KBUF;
        const char* Vs_ = Vb + (kb & 1) * VBUF;
        f32x4 s[4][QT];
#pragma unroll
        for (int kt = 0; kt < 4; kt++) {
#pragma unroll
            for (int qt = 0; qt < QT; qt++) s[kt][qt] = (f32x4){0.f, 0.f, 0.f, 0.f};
#pragma unroll
            for (int ks = 0; ks < KS; ks++) {
                const bf16x8 kf = *(const bf16x8*)(Ks_ + (kt * 16 + r16) * KSTR + ks * 64 + q * 16);
#pragma unroll
                for (int qt = 0; qt < QT; qt++) s[kt][qt] = __builtin_amdgcn_mfma_f32_16x16x32_bf16(kf, qf[qt][ks], s[kt][qt], 0, 0, 0);
            }
        }
#pragma unroll
        for (int qt = 0; qt < QT; qt++) {
            float bm = -1e30f;
#pragma unroll
            for (int kt = 0; kt < 4; kt++)
#pragma unroll
                for (int e = 0; e < 4; e++) {
                    float v = s[kt][qt][e] * scale;
                    if (NA) {
                        if (kb < 8) {
                            const int kc = kt * 16 + q * 4 + e;
                            const int cq = w * 16 + r16;
                            const int dr = na_rs + kb - na_r + 7;
                            const int dc = min(max(kc - cq + 15, 0), 30);
                            const int cs = min(max(cq - 8, 0), 48);
                            const bool ok = (kc >= cs) && (kc < cs + 16);
                            v = ok ? v + rpbs[dr * 31 + dc] : -1e30f;
                        }
                    }
                    s[kt][qt][e] = v;
                    bm = fmaxf(bm, v);
                }
            bm = fmaxf(bm, __shfl_xor(bm, 16));
            bm = fmaxf(bm, __shfl_xor(bm, 32));
            const float mn = fmaxf(m[qt], bm);
            const float corr = __builtin_amdgcn_exp2f(m[qt] - mn);
            m[qt] = mn;
            float rsum = 0.f;
#pragma unroll
            for (int kt = 0; kt < 4; kt++)
#pragma unroll
                for (int e = 0; e < 4; e++) { const float pe = __builtin_amdgcn_exp2f(s[kt][qt][e] - mn); s[kt][qt][e] = pe; rsum += pe; }
            ls[qt] = ls[qt] * corr + rsum;
#pragma unroll
            for (int dt = 0; dt < 4; dt++) { o[dt][qt][0] *= corr; o[dt][qt][1] *= corr; o[dt][qt][2] *= corr; o[dt][qt][3] *= corr; }
        }
#pragma unroll
        for (int g = 0; g < 2; g++) {
            bf16x8 pf[QT];
#pragma unroll
            for (int qt = 0; qt < QT; qt++) {
                union { bf16x8 v; unsigned u[4]; } pk;
                pk.u[0] = pack2bf(s[2 * g][qt][0], s[2 * g][qt][1]); pk.u[1] = pack2bf(s[2 * g][qt][2], s[2 * g][qt][3]);
                pk.u[2] = pack2bf(s[2 * g + 1][qt][0], s[2 * g + 1][qt][1]); pk.u[3] = pack2bf(s[2 * g + 1][qt][2], s[2 * g + 1][qt][3]);
                pf[qt] = pk.v;
            }
#pragma unroll
            for (int dt = 0; dt < 4; dt++) {
                const bf16x8 vf = *(const bf16x8*)(Vs_ + (dt * 16 + r16) * VSTR + g * 64 + q * 16);
#pragma unroll
                for (int qt = 0; qt < QT; qt++) o[dt][qt] = __builtin_amdgcn_mfma_f32_16x16x32_bf16(vf, pf[qt], o[dt][qt], 0, 0, 0);
            }
        }
        if (more) {
            char* Kw = Kb + ((kb + 1) & 1) * KBUF;
            char* Vw = Vb + ((kb + 1) & 1) * VBUF;
#pragma unroll
            for (int i = 0; i < NKC; i++) { const int c = tid + 256 * i; const int row = c / CPR, cc = c % CPR; *(u32x4*)(Kw + row * KSTR + cc * 16) = rk[i]; }
#pragma unroll
            for (int i = 0; i < 2; i++) { const int c = tid + 256 * i; const int row = c >> 3, cc = c & 7; *(u32x4*)(Vw + row * VSTR + cc * 16) = rv[i]; }
        }
        __syncthreads();
    }
#pragma unroll
    for (int qt = 0; qt < QT; qt++) {
        float lt = ls[qt];
        lt += __shfl_xor(lt, 16);
        lt += __shfl_xor(lt, 32);
        const float inv = 1.f / lt;
#pragma unroll
        for (int dt = 0; dt < 4; dt++)
            st4bf(orow0 + (size_t)(w * QT * 16 + qt * 16 + r16) * ostride + dt * 16 + q * 4,
                  make_float4(o[dt][qt][0] * inv, o[dt][qt][1] * inv, o[dt][qt][2] * inv, o[dt][qt][3] * inv));
    }
}

__device__ __forceinline__ void mla_unit(const Params& p, int l, int u, bool isctx, float* sm) {
    int b, h, qb;
    if (!isctx) { b = u >> 6; h = (u >> 4) & 3; qb = u & 15; } else { b = u >> 3; h = (u >> 1) & 3; qb = u & 1; }
    const int qrow = (isctx ? NLAT + b * 256 : b * 2048) + qb * 128;
    const bf16_t* vb = W_MVT + (size_t)((b * 4 + h) * 64) * 2304;
    const float scale = 0.10206207261596577f * 1.4426950408889634f;
    if (!isctx)
        flash_attn<96, 2, false>((char*)sm, W_MQ + (size_t)qrow * 384 + h * 96, 384, W_MK + h * 96, 384, b, vb, 36, [](int kb) { return kb * 64; }, scale,
                                 W_CAT + (size_t)qrow * 1024 + 768 + h * 64, 1024, nullptr, 0, 0);
    else
        flash_attn<96, 2, false>((char*)sm, W_MQ + (size_t)qrow * 384 + h * 96, 384, W_MK + h * 96, 384, b, vb, 4, [](int kb) { return 2048 + kb * 64; }, scale,
                                 W_CAT + (size_t)qrow * 1024 + 768 + h * 64, 1024, nullptr, 0, 0);
}
__device__ __forceinline__ void na_unit(const Params& p, int l, int u, bool isctx, float* sm) {
    if (!isctx) {
        const int b = u >> 7, h = (u >> 5) & 3, r = u & 31;
        const int rs = min(max(r - 4, 0), 24);
        float* rpbs = sm + 9216;
        __syncthreads();
        for (int i = TIDX; i < 15 * 31; i += 256) rpbs[i] = W_na_rpb[(size_t)(l * 4 + h) * 465 + i] * 1.4426950408889634f;
        const int qrow = b * 2048 + r * 64;
        flash_attn<64, 1, true>((char*)sm, W_NQ + (size_t)qrow * 256 + h * 64, 256, W_NK + h * 64, 256, b, W_NVT + (size_t)((b * 4 + h) * 64) * 2304, 12,
                                [rs](int kb) { return kb < 8 ? (rs + kb) * 64 : 2048 + (kb - 8) * 64; }, 0.125f * 1.4426950408889634f,
                                W_CAT + (size_t)qrow * 1024 + 512 + h * 64, 1024, rpbs, r, rs);
    } else {
        const int b = u >> 4, h = (u >> 2) & 3, qb = u & 3;
        const int qrow = NLAT + b * 256 + qb * 64;
        flash_attn<64, 1, false>((char*)sm, W_NQ + (size_t)qrow * 256 + h * 64, 256, W_NK + h * 64, 256, b, W_NVT + (size_t)((b * 4 + h) * 64) * 2304, 4,
                                 [](int kb) { return 2048 + kb * 64; }, 0.125f * 1.4426950408889634f, W_CAT + (size_t)qrow * 1024 + 512 + h * 64, 1024, nullptr, 0, 0);
    }
}

__device__ __forceinline__ void hgrn_local_unit(const Params& p, int l, int u, float* sm) {
    const int tid = TIDX;
    const int b = u / 144, h = (u / 36) & 3, cid = u % 36;
    const int row0 = cid < 4 ? NLAT + b * 256 + cid * 64 : b * 2048 + (cid - 4) * 64;
    float* B0 = sm;
    char* VT = (char*)(sm + 4352);
    char* KB = (char*)(sm + 6656);
    float* B2 = sm + 8960;
    float* B3 = sm + 13312;
    float* SC = sm + 17408;
    const int lane_ = tid & 63, w_ = tid >> 6, r16 = lane_ & 15, q4 = lane_ >> 4;
    const int k = tid & 63, seg = tid >> 6;
    const int ti = tid >> 4, ts = tid & 15;
    float acc[4][4];
#pragma unroll
    for (int a = 0; a < 4; a++)
#pragma unroll
        for (int c = 0; c < 4; c++) acc[a][c] = 0.f;
    __syncthreads();
    {
        const int s_ = tid >> 2, c0 = (tid & 3) * 16;
        const bf16_t* src = W_P + (size_t)(row0 + s_) * DIN + C_HI + h * 64 + c0;
        const u32x4 v0 = *(const u32x4*)src, v1 = *(const u32x4*)(src + 8);
#pragma unroll
        for (int j = 0; j < 4; j++) {
            *(bf16_t*)(VT + (c0 + 2 * j) * 144 + s_ * 2) = (bf16_t)(v0[j] & 0xFFFFu);
            *(bf16_t*)(VT + (c0 + 2 * j + 1) * 144 + s_ * 2) = (bf16_t)(v0[j] >> 16);
            *(bf16_t*)(VT + (c0 + 8 + 2 * j) * 144 + s_ * 2) = (bf16_t)(v1[j] & 0xFFFFu);
            *(bf16_t*)(VT + (c0 + 8 + 2 * j + 1) * 144 + s_ * 2) = (bf16_t)(v1[j] >> 16);
        }
    }
    float qv[16];
#pragma unroll
    for (int j = 0; j < 16; j++) qv[j] = bf2f(W_P[(size_t)(row0 + seg * 16 + j) * DIN + C_HQ + h * 64 + k]);
#pragma unroll
    for (int j = 0; j < 4; j++) *(float4*)&B0[k * 68 + seg * 16 + 4 * j] = make_float4(qv[4 * j], qv[4 * j + 1], qv[4 * j + 2], qv[4 * j + 3]);
#pragma unroll 1
    for (int dir = 0; dir < 2; dir++) {
        const int zoff = dir ? C_ZB : C_ZF;
        const float lbv = W_LB[(l * 2 + dir) * 256 + h * 64 + k];
        const size_t ud = (size_t)u * 2 + dir;
        float bl[16], kkv[16];
#pragma unroll
        for (int j = 0; j < 16; j++) {
            float z = bf2f(W_P[(size_t)(row0 + seg * 16 + j) * DIN + zoff + h * 64 + k]);
            z = fminf(fmaxf(z, -20.f), 20.f);
            const float e_ = __expf(-z);
            const float sg = 1.f / (1.f + e_);
            const float f = lbv + (1.f - lbv) * sg;
            bl[j] = __log2f(f);
            kkv[j] = (1.f - lbv) * (e_ * sg);
        }
        float tot;
        if (dir == 0) {
#pragma unroll
            for (int j = 1; j < 16; j++) bl[j] += bl[j - 1];
            tot = bl[15];
        } else {
#pragma unroll
            for (int j = 14; j >= 0; j--) bl[j] += bl[j + 1];
            tot = bl[0];
        }
        SC[seg * 64 + k] = tot;
        __syncthreads();
        float off = 0.f;
#pragma unroll
        for (int s2 = 0; s2 < 4; s2++) if (dir ? (s2 > seg) : (s2 < seg)) off += SC[s2 * 64 + k];
        const float btot = SC[k] + SC[64 + k] + SC[128 + k] + SC[192 + k];
#pragma unroll
        for (int j = 0; j < 16; j++) bl[j] += off;
#pragma unroll
        for (int j = 0; j < 4; j++) {
            const float Rj = dir ? bl[4 * j] : bl[4 * j + 3];
            *(float4*)&B2[k * 68 + seg * 16 + 4 * j] = make_float4(kkv[4 * j] * __builtin_amdgcn_exp2f(Rj - bl[4 * j]), kkv[4 * j + 1] * __builtin_amdgcn_exp2f(Rj - bl[4 * j + 1]),
                                                                   kkv[4 * j + 2] * __builtin_amdgcn_exp2f(Rj - bl[4 * j + 2]), kkv[4 * j + 3] * __builtin_amdgcn_exp2f(Rj - bl[4 * j + 3]));
            *(float4*)&B3[k * 64 + seg * 16 + 4 * j] = make_float4(bl[4 * j], bl[4 * j + 1], bl[4 * j + 2], bl[4 * j + 3]);
#pragma unroll
            for (int jj = 0; jj < 4; jj++)
                ((bf16_t*)W_HQ)[(ud * 64 + seg * 16 + 4 * j + jj) * 64 + k] = f2bf(qv[4 * j + jj] * __builtin_amdgcn_exp2f(bl[4 * j + jj]));
        }
        if (seg == 0) W_HD[ud * 64 + k] = __builtin_amdgcn_exp2f(btot);
        {
            u32x4 k0, k1;
#pragma unroll
            for (int j = 0; j < 4; j++) {
                k0[j] = pack2bf(kkv[2 * j] * __builtin_amdgcn_exp2f(btot - bl[2 * j]), kkv[2 * j + 1] * __builtin_amdgcn_exp2f(btot - bl[2 * j + 1]));
                k1[j] = pack2bf(kkv[8 + 2 * j] * __builtin_amdgcn_exp2f(btot - bl[8 + 2 * j]), kkv[8 + 2 * j + 1] * __builtin_amdgcn_exp2f(btot - bl[8 + 2 * j + 1]));
            }
            *(u32x4*)(KB + k * 144 + seg * 32) = k0;
            *(u32x4*)(KB + k * 144 + seg * 32 + 16) = k1;
        }
        __syncthreads();
        const bool active = dir ? (ts >= ti) : (ts <= ti);
        if (active) {
            float a2[4][4];
#pragma unroll
            for (int a = 0; a < 4; a++)
#pragma unroll
                for (int c = 0; c < 4; c++) a2[a][c] = 0.f;
#pragma unroll 2
            for (int kk_ = 0; kk_ < 64; kk_++) {
                const float4 q4 = *(const float4*)&B0[kk_ * 68 + ti * 4];
                const float4 bq4 = *(const float4*)&B3[kk_ * 64 + ti * 4];
                const float4 k4 = *(const float4*)&B2[kk_ * 68 + ts * 4];
                const float4 bk4 = *(const float4*)&B3[kk_ * 64 + ts * 4];
                const float R = dir ? bk4.x : bk4.w;
                const float qr[4] = {q4.x * __builtin_amdgcn_exp2f(bq4.x - R), q4.y * __builtin_amdgcn_exp2f(bq4.y - R), q4.z * __builtin_amdgcn_exp2f(bq4.z - R), q4.w * __builtin_amdgcn_exp2f(bq4.w - R)};
                const float ka[4] = {k4.x, k4.y, k4.z, k4.w};
#pragma unroll
                for (int a = 0; a < 4; a++)
#pragma unroll
                    for (int c = 0; c < 4; c++) a2[a][c] += qr[a] * ka[c];
            }
#pragma unroll
            for (int a = 0; a < 4; a++)
#pragma unroll
                for (int c = 0; c < 4; c++) {
                    const int i_ = ti * 4 + a, s_ = ts * 4 + c;
                    const bool valid = dir ? (s_ >= i_) : (s_ <= i_);
                    acc[a][c] += valid ? a2[a][c] : 0.f;
                }
        }
        {
            f32x4 ua[4];
#pragma unroll
            for (int vt = 0; vt < 4; vt++) ua[vt] = (f32x4){0.f, 0.f, 0.f, 0.f};
#pragma unroll
            for (int ss_ = 0; ss_ < 2; ss_++) {
                const bf16x8 kbf = *(const bf16x8*)(KB + (w_ * 16 + r16) * 144 + ss_ * 64 + q4 * 16);
#pragma unroll
                for (int vt = 0; vt < 4; vt++) {
                    const bf16x8 vtf = *(const bf16x8*)(VT + (vt * 16 + r16) * 144 + ss_ * 64 + q4 * 16);
                    ua[vt] = __builtin_amdgcn_mfma_f32_16x16x32_bf16(vtf, kbf, ua[vt], 0, 0, 0);
                }
            }
#pragma unroll
            for (int vt = 0; vt < 4; vt++) st4bf((bf16_t*)W_HU + ud * 4096 + (w_ * 16 + r16) * 64 + vt * 16 + q4 * 4, make_float4(ua[vt][0], ua[vt][1], ua[vt][2], ua[vt][3]));
        }
    }
    __syncthreads();
    {
        char* AB = (char*)B2;
#pragma unroll
        for (int a2_ = 0; a2_ < 4; a2_++) {
            uint2 pk; pk.x = pack2bf(acc[a2_][0], acc[a2_][1]); pk.y = pack2bf(acc[a2_][2], acc[a2_][3]);
            *(uint2*)(AB + (ti * 4 + a2_) * 144 + ts * 8) = pk;
        }
        __syncthreads();
        f32x4 oa[4];
#pragma unroll
        for (int vt = 0; vt < 4; vt++) oa[vt] = (f32x4){0.f, 0.f, 0.f, 0.f};
#pragma unroll
        for (int ss_ = 0; ss_ < 2; ss_++) {
            const bf16x8 abf = *(const bf16x8*)(AB + (w_ * 16 + r16) * 144 + ss_ * 64 + q4 * 16);
#pragma unroll
            for (int vt = 0; vt < 4; vt++) {
                const bf16x8 vtf = *(const bf16x8*)(VT + (vt * 16 + r16) * 144 + ss_ * 64 + q4 * 16);
                oa[vt] = __builtin_amdgcn_mfma_f32_16x16x32_bf16(vtf, abf, oa[vt], 0, 0, 0);
            }
        }
#pragma unroll
        for (int vt = 0; vt < 4; vt++) *(f32x4*)&W_OF[(size_t)(row0 + w_ * 16 + r16) * 256 + h * 64 + vt * 16 + q4 * 4] = oa[vt];
    }
}

__device__ __forceinline__ void hgrn_scan_unit(const Params& p, int l, int u) {
    const int tid = TIDX;
    const int bh = u >> 5, dir = (u >> 4) & 1, sl = u & 15;
    const int ubase = bh * 36;
    const int e = sl * 256 + tid;
    const int kq = e >> 6;
    const bf16_t* HUb = (const bf16_t*)W_HU; const float* HDb = W_HD; bf16_t* SPb = (bf16_t*)W_SP;
    float S = 0.f;
#pragma unroll 6
    for (int n = 0; n < 36; n++) {
        const int cn = dir == 0 ? n : (n < 4 ? 3 - n : 39 - n);
        const size_t ud = (size_t)(ubase + cn) * 2 + dir;
        SPb[ud * 4096 + e] = f2bf(S);
        S = S * HDb[ud * 64 + kq] + bf2f(HUb[ud * 4096 + e]);
    }
}
__device__ __forceinline__ void hgrn_final_unit(const Params& p, int l, int u, float* sm) {
    const int tid = TIDX, lane = tid & 63, w = tid >> 6, r16 = lane & 15, q4 = lane >> 4;
    const int b = u / 144, h = (u / 36) & 3, cid = u % 36;
    const int row0 = cid < 4 ? NLAT + b * 256 + cid * 64 : b * 2048 + (cid - 4) * 64;
    char* ST = (char*)sm;
    __syncthreads();
#pragma unroll
    for (int dir = 0; dir < 2; dir++) {
        const bf16_t* sp = (const bf16_t*)W_SP + ((size_t)u * 2 + dir) * 4096;
#pragma unroll
        for (int j = 0; j < 2; j++) {
            const int e8 = tid + 256 * j, kk_ = e8 >> 3, v0 = (e8 & 7) * 8;
            const u32x4 sv = *(const u32x4*)&sp[e8 * 8];
            char* dst = ST + dir * 9216 + kk_ * 2;
#pragma unroll
            for (int t = 0; t < 4; t++) {
                *(bf16_t*)(dst + (v0 + 2 * t) * 144) = (bf16_t)(sv[t] & 0xFFFFu);
                *(bf16_t*)(dst + (v0 + 2 * t + 1) * 144) = (bf16_t)(sv[t] >> 16);
            }
        }
    }
    const int row = row0 + w * 16 + r16;
    f32x4 oa[4];
#pragma unroll
    for (int vt = 0; vt < 4; vt++) oa[vt] = *(const f32x4*)&W_OF[(size_t)row * 256 + h * 64 + vt * 16 + q4 * 4];
    bf16x8 qd[2][2];
#pragma unroll
    for (int dir = 0; dir < 2; dir++)
#pragma unroll
        for (int ks = 0; ks < 2; ks++) qd[dir][ks] = *(const bf16x8*)((const bf16_t*)W_HQ + (((size_t)u * 2 + dir) * 64 + w * 16 + r16) * 64 + ks * 32 + q4 * 8);
    __syncthreads();
#pragma unroll
    for (int dir = 0; dir < 2; dir++)
#pragma unroll
        for (int ks = 0; ks < 2; ks++)
#pragma unroll
            for (int vt = 0; vt < 4; vt++) {
                const bf16x8 stf = *(const bf16x8*)(ST + dir * 9216 + (vt * 16 + r16) * 144 + ks * 64 + q4 * 16);
                oa[vt] = __builtin_amdgcn_mfma_f32_16x16x32_bf16(stf, qd[dir][ks], oa[vt], 0, 0, 0);
            }
    float ss = 0.f;
#pragma unroll
    for (int vt = 0; vt < 4; vt++) ss += oa[vt][0] * oa[vt][0] + oa[vt][1] * oa[vt][1] + oa[vt][2] * oa[vt][2] + oa[vt][3] * oa[vt][3];
    ss += __shfl_xor(ss, 16); ss += __shfl_xor(ss, 32);
    const float rs = rsqrtf(ss * (1.f / 64.f) + EPSF);
#pragma unroll
    for (int vt = 0; vt < 4; vt++) {
        const int v0 = vt * 16 + q4 * 4;
        const float4 g = *(const float4*)&W_hgrn_norm_g[l * 64 + v0];
        const float4 gt = ld4bf(&W_P[(size_t)row * DIN + C_HG + h * 64 + v0]);
        st4bf(&W_CAT[(size_t)row * 1024 + h * 64 + v0],
              make_float4(oa[vt][0] * rs * g.x * siluf_(gt.x), oa[vt][1] * rs * g.y * siluf_(gt.y), oa[vt][2] * rs * g.z * siluf_(gt.z), oa[vt][3] * rs * g.w * siluf_(gt.w)));
    }
}

template <int LL>
__device__ __forceinline__ void hyena_unit(const Params& p, int l, int b, int cp, float* sm) {
    constexpr int NT = LL / 256;
    float zprev[NT];
#pragma unroll 1
    for (int chh = 0; chh < 2; chh++) {
    const int c = cp * 2 + chh;
    constexpr bool isctx = (LL == 256);
    const int tid = TIDX;
    float* zs = sm;
    float* kc = sm + LL;
    const int rowbase = isctx ? NLAT + b * 256 : b * 2048;
    float z[NT], x1[NT], x2[NT];
#pragma unroll
    for (int i = 0; i < NT; i++) {
        const int t = tid + 256 * i;
        float val[3];
#pragma unroll
        for (int q = 0; q < 3; q++) {
            const int chn = q * 256 + c;
            const int col = C_HY + chn;
            const float um = t > 0 ? bf2f(W_P[(size_t)(rowbase + t - 1) * DIN + col]) : 0.f;
            const float u0 = bf2f(W_P[(size_t)(rowbase + t) * DIN + col]);
            const float up = t < LL - 1 ? bf2f(W_P[(size_t)(rowbase + t + 1) * DIN + col]) : 0.f;
            val[q] = W_hy_short_w[(l * 3 + 0) * 768 + chn] * um + W_hy_short_w[(l * 3 + 1) * 768 + chn] * u0 + W_hy_short_w[(l * 3 + 2) * 768 + chn] * up +
                     W_hy_short_b[l * 768 + chn];
        }
        z[i] = val[0]; x1[i] = val[1]; x2[i] = val[2];
    }
#pragma unroll
    for (int o = 0; o < 2; o++) {
        const float* kbase = W_HYKC + (size_t)((l * 2 + o) * 256 + c) * 2 * LL;
        __syncthreads();
        for (int i = tid; i < 2 * LL - 1; i += 256) { const int d = i - (LL - 1); kc[i] = d >= 0 ? kbase[d] : kbase[LL - d]; }
#pragma unroll
        for (int i = 0; i < NT; i++) zs[tid + 256 * i] = z[i];
        __syncthreads();
        float acc[NT];
#pragma unroll
        for (int i = 0; i < NT; i++) acc[i] = 0.f;
        for (int s = 0; s < LL; s++) {
            const float zv = zs[s];
#pragma unroll
            for (int i = 0; i < NT; i++) acc[i] += kc[(tid + 256 * i) - s + (LL - 1)] * zv;
        }
        const float dbv = W_hy_bias[(l * 2 + o) * 256 + c];
#pragma unroll
        for (int i = 0; i < NT; i++) z[i] = (o == 0 ? x1[i] : x2[i]) * (acc[i] + dbv * z[i]);
    }
    if (chh == 0) {
#pragma unroll
        for (int i = 0; i < NT; i++) zprev[i] = z[i];
    } else {
#pragma unroll
        for (int i = 0; i < NT; i++) *(unsigned*)&W_CAT[(size_t)(rowbase + tid + 256 * i) * 1024 + 256 + cp * 2] = pack2bf(zprev[i], z[i]);
    }
    }
}

__device__ __forceinline__ void hyena_fft_unit(const Params& p, int l, int bp, int cp, float* sm) {
    const int tid = TIDX;
    float2* fb = (float2*)sm;
    float* raw = sm + 8704;
    bf16_t* zp = (bf16_t*)(sm + 12808);
    float2* twl = (float2*)(sm + 14856);
    __syncthreads();
    { const float2* twg = W_TW;
#pragma unroll
      for (int i = 0; i < 4; i++) twl[tid + 256 * i] = twg[tid + 256 * i]; }
    if (tid < 2) { raw[tid * 2050] = 0.f; raw[tid * 2050 + 2049] = 0.f; }
#pragma unroll 1
    for (int chh = 0; chh < 2; chh++) {
        const int c = cp * 2 + chh;
        float z[2][8];
#pragma unroll 1
        for (int st = 0; st < 3; st++) {
            if (st > 0) {
                const int o = st - 1;
                float2 v[4][4];
#pragma unroll
                for (int r1 = 0; r1 < 4; r1++)
#pragma unroll
                    for (int r2 = 0; r2 < 4; r2++) v[r1][r2] = r1 < 2 ? make_float2(z[0][(r1 & 1) * 4 + r2], z[1][(r1 & 1) * 4 + r2]) : make_float2(0.f, 0.f);
                fft_fwd_pass<0>(v, tid, twl);
                fft_lds_write<0>(v, tid, fb);
                __syncthreads();
                const float2* ks = W_KSPEC + (size_t)((l * 2 + o) * 256 + c) * 4096 + tid * 16;
                float2 kv[16];
#pragma unroll
                for (int j = 0; j < 16; j++) kv[j] = ks[j];
                fft_lds_read<2>(v, tid, fb);
                fft_fwd_pass<2>(v, tid, twl);
                fft_lds_write<2>(v, tid, fb);
                __syncthreads();
                fft_lds_read<4>(v, tid, fb);
                fft_fwd_pass<4>(v, tid, twl);
#pragma unroll
                for (int r1 = 0; r1 < 4; r1++)
#pragma unroll
                    for (int r2 = 0; r2 < 4; r2++) v[r1][r2] = cmul(v[r1][r2], kv[r1 * 4 + r2]);
                fft_inv_pass<4>(v, tid, twl);
                fft_lds_write<4>(v, tid, fb);
                __syncthreads();
                fft_lds_read<2>(v, tid, fb);
                fft_inv_pass<2>(v, tid, twl);
                fft_lds_write<2>(v, tid, fb);
                __syncthreads();
                fft_lds_read<0>(v, tid, fb);
                fft_inv_pass<0>(v, tid, twl);
                const float dbv = W_hy_bias[(l * 2 + o) * 256 + c];
#pragma unroll
                for (int r1 = 0; r1 < 2; r1++)
#pragma unroll
                    for (int r2 = 0; r2 < 4; r2++) {
                        const int i = r1 * 4 + r2;
                        z[0][i] = v[r1][r2].x + dbv * z[0][i];
                        z[1][i] = v[r1][r2].y + dbv * z[1][i];
                    }
            }
            const int chn = st * 256 + c;
#pragma unroll 1
            for (int b2 = 0; b2 < 2; b2++)
#pragma unroll 4
                for (int i = 0; i < 8; i++) {
                    const int t = tid + 256 * i;
                    raw[b2 * 2050 + 1 + t] = bf2f(W_P[(size_t)((bp * 2 + b2) * 2048 + t) * DIN + C_HY + chn]);
                }
            __syncthreads();
            const float w0 = W_hy_short_w[(l * 3 + 0) * 768 + chn], w1 = W_hy_short_w[(l * 3 + 1) * 768 + chn], w2 = W_hy_short_w[(l * 3 + 2) * 768 + chn];
            const float sb = W_hy_short_b[l * 768 + chn];
#pragma unroll
            for (int b2 = 0; b2 < 2; b2++)
#pragma unroll
                for (int i = 0; i < 8; i++) {
                    const int t = tid + 256 * i;
                    const float val = w0 * raw[b2 * 2050 + t] + w1 * raw[b2 * 2050 + t + 1] + w2 * raw[b2 * 2050 + t + 2] + sb;
                    z[b2][i] = st == 0 ? val : val * z[b2][i];
                }
            __syncthreads();
        }
        if (chh == 0) {
#pragma unroll
            for (int b2 = 0; b2 < 2; b2++)
#pragma unroll
                for (int i = 0; i < 8; i++) zp[(b2 * 8 + i) * 256 + tid] = f2bf(z[b2][i]);
        } else {
#pragma unroll
            for (int b2 = 0; b2 < 2; b2++)
#pragma unroll
                for (int i = 0; i < 8; i++)
                    *(unsigned*)&W_CAT[(size_t)((bp * 2 + b2) * 2048 + tid + 256 * i) * 1024 + 256 + cp * 2] = ((unsigned)zp[(b2 * 8 + i) * 256 + tid] | ((unsigned)f2bf(z[b2][i]) << 16));
        }
    }
}

__device__ void phase_mix(const Params& p, int l, float* sm) {
    const bool need_ctx = l < DEPTH - 1;
    const int G = gridDim.x, bid = BIDX;
    for (int u = wq_next(WQ(p, l, 3), sm); u < 512; u = wq_next(WQ(p, l, 3), sm)) hyena_fft_unit(p, l, u >> 7, u & 127, sm);
    for (int u = wq_next(WQ(p, l, 13), sm); u < 1024; u = wq_next(WQ(p, l, 13), sm)) hgrn_scan_unit(p, l, u);
    for (int u = wq_next(WQ(p, l, 4), sm); u < 1024; u = wq_next(WQ(p, l, 4), sm)) na_unit(p, l, u, false, sm);
    if (need_ctx) {
        for (int u = wq_next(WQ(p, l, 5), sm); u < 128; u = wq_next(WQ(p, l, 5), sm)) na_unit(p, l, u, true, sm);
        for (int u = wq_next(WQ(p, l, 6), sm); u < 1024; u = wq_next(WQ(p, l, 6), sm)) hyena_unit<256>(p, l, u >> 7, u & 127, sm);
    }
}
__device__ void phase_mix2(const Params& p, int l, float* sm) {
    const bool need_ctx = l < DEPTH - 1;
    const int G = gridDim.x, bid = BIDX;
    for (int u = wq_next(WQ(p, l, 7), sm); u < 512; u = wq_next(WQ(p, l, 7), sm)) mla_unit(p, l, u, false, sm);
    for (int u = wq_next(WQ(p, l, 8), sm); u < 1152; u = wq_next(WQ(p, l, 8), sm)) { if (need_ctx || (u % 36) >= 4) hgrn_final_unit(p, l, u, sm); }
    if (need_ctx) for (int u = wq_next(WQ(p, l, 9), sm); u < 64; u = wq_next(WQ(p, l, 9), sm)) mla_unit(p, l, u, true, sm);
}

__device__ void phase_gemm2(const Params& p, int l, float* sm) {
    const int nrows = (l < DEPTH - 1) ? TT : NLAT;
    const float* W = p.w_out + (size_t)l * 1024 * 1024;
    const int tid = TIDX, lane = tid & 63, w = tid >> 6, wm = w >> 1, wn = w & 1, r16 = lane & 15, q = lane >> 4;
    for (int u = wq_next(WQ(p, l, 10), sm); u < (nrows / 128) * 8; u = wq_next(WQ(p, l, 10), sm)) {
        const int rb = u >> 3, cb = u & 7;
        const int r0 = rb * 128, n0 = cb * 128;
        const float* g1 = W_MOD + (size_t)(l * 9 + bidx_of(r0)) * 6144 + 2048;
        f32x4 acc[4][4];
        const bf16_t* cb_ = W_CAT + (size_t)r0 * 1024;
        const bf16_t* wb = W_WOUTT + (size_t)l * 1024 * 1024 + (size_t)n0 * 1024;
        gemm128_bt<true>(1024, (char*)sm, [&](int r) { return cb_ + (size_t)r * 1024; }, [&](int r) { return wb + (size_t)r * 1024; }, acc);
#pragma unroll
        for (int i = 0; i < 4; i++)
#pragma unroll
            for (int j = 0; j < 4; j++) {
                const int m = r0 + wm * 64 + i * 16 + r16, n = n0 + wn * 64 + j * 16 + q * 4;
                const float* xsrc = l > 0 ? &W_X[(size_t)m * 1024 + n] : (m < NLAT ? &p.x[(size_t)m * 1024 + n] : &p.ctx[(size_t)(m - NLAT) * 1024 + n]);
                float4 xv = *(const float4*)xsrc;
                const float4 g = *(const float4*)&g1[n];
                xv.x += g.x * acc[i][j][0]; xv.y += g.y * acc[i][j][1]; xv.z += g.z * acc[i][j][2]; xv.w += g.w * acc[i][j][3];
                *(float4*)&W_X[(size_t)m * 1024 + n] = xv;
            }
    }
}

__device__ void phase_norm2(const Params& p, int l, float* sm) {
    const int tid = TIDX, wave = tid >> 6, lane = tid & 63, r16 = lane & 15, kq = lane >> 4;
    const int nrows = (l < DEPTH - 1) ? TT : NLAT;
    float* red = sm;
    float* lg = sm + 64;
    for (int t16 = wq_next(WQ(p, l, 14), sm); t16 < nrows / 16; t16 = wq_next(WQ(p, l, 14), sm)) {
        const int row = t16 * 16 + r16;
        const int bi = bidx_of(t16 * 16);
        const int kb = wave * 256 + kq * 64;
        const float* xr = W_X + (size_t)row * 1024 + kb;
        float ss = 0.f;
#pragma unroll
        for (int i = 0; i < 16; i++) { const float4 v = *(const float4*)&xr[i * 4]; ss += v.x * v.x + v.y * v.y + v.z * v.z + v.w * v.w; }
        ss += __shfl_xor(ss, 16); ss += __shfl_xor(ss, 32);
        if (kq == 0) red[wave * 16 + r16] = ss;
        __syncthreads();
        const float rstd = rsqrtf((red[r16] + red[16 + r16] + red[32 + r16] + red[48 + r16]) * (1.f / 1024.f) + EPSF);
        const float* md = W_MOD + (size_t)(l * 9 + bi) * 6144 + kb;
        const float* gn = W_norm2_g + l * 1024 + kb;
        const float* we = W_moe_we + (size_t)(l * 1024 + kb) * 32 + r16;
        const float* wg = W_moe_wg + (size_t)(l * 1024 + kb) * 4 + (r16 & 3);
        bf16_t* hr = W_H + (size_t)row * 1024 + kb;
        f32x4 a0 = (f32x4){0.f, 0.f, 0.f, 0.f}, a1 = a0, a2 = a0;
#pragma unroll 2
        for (int i = 0; i < 16; i++) {
            const float4 xq = *(const float4*)&xr[i * 4];
            const float4 g = *(const float4*)&gn[i * 4];
            const float4 sh = *(const float4*)&md[3072 + i * 4];
            const float4 sc = *(const float4*)&md[4096 + i * 4];
            float h[4];
            h[0] = xq.x * rstd * g.x * (1.f + sc.x) + sh.x; h[1] = xq.y * rstd * g.y * (1.f + sc.y) + sh.y;
            h[2] = xq.z * rstd * g.z * (1.f + sc.z) + sh.z; h[3] = xq.w * rstd * g.w * (1.f + sc.w) + sh.w;
            st4bf(hr + i * 4, make_float4(h[0], h[1], h[2], h[3]));
#pragma unroll
            for (int e = 0; e < 4; e++) {
                const int k = i * 4 + e;
                const float b0 = we[k * 32], b1 = we[k * 32 + 16];
                const float b2 = r16 < 4 ? wg[k * 4] : 0.f;
                a0 = __builtin_amdgcn_mfma_f32_16x16x4f32(h[e], b0, a0, 0, 0, 0);
                a1 = __builtin_amdgcn_mfma_f32_16x16x4f32(h[e], b1, a1, 0, 0, 0);
                a2 = __builtin_amdgcn_mfma_f32_16x16x4f32(h[e], b2, a2, 0, 0, 0);
            }
        }
        float* lw = lg + wave * 768;
#pragma unroll
        for (int e = 0; e < 4; e++) {
            lw[(kq * 4 + e) * 48 + r16] = a0[e];
            lw[(kq * 4 + e) * 48 + 16 + r16] = a1[e];
            lw[(kq * 4 + e) * 48 + 32 + r16] = a2[e];
        }
        __syncthreads();
        if (tid < 16) {
            const float* L0 = lg + tid * 48;
            const int rrow = t16 * 16 + tid;
            float gl[4];
#pragma unroll
            for (int c = 0; c < 4; c++) gl[c] = L0[32 + c] + L0[768 + 32 + c] + L0[1536 + 32 + c] + L0[2304 + 32 + c] + W_moe_bg[l * 4 + c];
            int gs = 0; float best = gl[0];
#pragma unroll
            for (int c = 1; c < 4; c++) if (gl[c] > best) { best = gl[c]; gs = c; }
            float den = 0.f;
#pragma unroll
            for (int c = 0; c < 4; c++) den += expf(gl[c] - best);
            const float psel = 1.f / den;
            float le[8];
#pragma unroll
            for (int i = 0; i < 8; i++) { const int c = gs * 8 + i; le[i] = L0[c] + L0[768 + c] + L0[1536 + c] + L0[2304 + c] + W_moe_be[l * 32 + c]; }
            int i1 = 0; float v1 = le[0];
#pragma unroll
            for (int i = 1; i < 8; i++) if (le[i] > v1) { v1 = le[i]; i1 = i; }
            int i2 = -1; float v2 = -3.0e38f;
#pragma unroll
            for (int i = 0; i < 8; i++) if (i != i1 && le[i] > v2) { v2 = le[i]; i2 = i; }
            const float e2 = expf(v2 - v1);
            const float w1 = psel / (1.f + e2), w2 = psel * e2 / (1.f + e2);
            const int ea = gs * 8 + i1, eb = gs * 8 + i2;
            const int n0 = rrow * 2, n1 = rrow * 2 + 1;
            W_EW[n0] = w1; W_EW[n1] = w2;
            const int pa = atomicAdd(&W_cnt[l * 32 + ea], 1);
            W_LIST[(size_t)ea * TT + pa] = n0;
            const int pb = atomicAdd(&W_cnt[l * 32 + eb], 1);
            W_LIST[(size_t)eb * TT + pb] = n1;
        }
    }
}

__device__ void phase_moe1(const Params& p, int l, float* sm) {
    int* offs = (int*)(sm + 16384);
    int* ns = (int*)(sm + 16384 + 64);
    const int tid = TIDX, lane = tid & 63, w = tid >> 6, wm = w >> 1, wn = w & 1, r16 = lane & 15, q = lane >> 4;
    __syncthreads();
    if (tid == 0) { int a = 0; for (int e = 0; e < 32; e++) { offs[e] = a; a += (W_cnt[l * 32 + e] + 127) >> 7; } offs[32] = a; }
    __syncthreads();
    const int total = offs[32] * 8;
    for (int u = wq_next(WQ(p, l, 11), sm); u < total; u = wq_next(WQ(p, l, 11), sm)) {
        const int rbg = u >> 3, cb = u & 7;
        int e = 0;
        while (offs[e + 1] <= rbg) e++;
        const int rbi = rbg - offs[e];
        const int ce = W_cnt[l * 32 + e];
        __syncthreads();
        if (tid < 128) { const int idx = rbi * 128 + tid; ns[tid] = idx < ce ? W_LIST[(size_t)e * TT + idx] : -1; }
        __syncthreads();
        const int j0 = cb * 64;
        const bf16_t* hb = W_H;
        const int c = tid & 127;
        const int hid = j0 + (c >> 6) * 32 + ((c >> 4) & 1) * 16 + (c & 15);
        const float* wp = (((c >> 4) & 3) >= 2 ? p.moe_w_up : p.moe_w_gate) + (size_t)(l * 32 + e) * 1024 * 512 + hid;
        f32x4 acc[4][4];
        gemm128_main<true>(1024, (char*)sm, [&](int r) { return hb + (size_t)(max(ns[r], 0) >> 1) * 1024; },
                           [&](int k, int n) { return wp[(size_t)k * 512]; }, acc);
#pragma unroll
        for (int i = 0; i < 4; i++) {
            const int n = ns[wm * 64 + i * 16 + r16];
            if (n >= 0) {
#pragma unroll
                for (int j = 0; j < 2; j++) {
                    const int hh = j0 + wn * 32 + j * 16 + q * 4;
                    float4 a;
                    a.x = siluf_(acc[i][j][0]) * acc[i][j + 2][0]; a.y = siluf_(acc[i][j][1]) * acc[i][j + 2][1];
                    a.z = siluf_(acc[i][j][2]) * acc[i][j + 2][2]; a.w = siluf_(acc[i][j][3]) * acc[i][j + 2][3];
                    st4bf(&W_ACT[(size_t)n * 512 + hh], a);
                }
            }
        }
    }
}
__device__ void phase_moe2(const Params& p, int l, float* sm) {
    int* offs = (int*)(sm + 16384);
    int* ns = (int*)(sm + 16384 + 64);
    const int tid = TIDX, lane = tid & 63, w = tid >> 6, wm = w >> 1, wn = w & 1, r16 = lane & 15, q = lane >> 4;
    __syncthreads();
    if (tid == 0) { int a = 0; for (int e = 0; e < 32; e++) { offs[e] = a; a += (W_cnt[l * 32 + e] + 127) >> 7; } offs[32] = a; }
    __syncthreads();
    const int total = offs[32] * 8;
    for (int u = wq_next(WQ(p, l, 12), sm); u < total; u = wq_next(WQ(p, l, 12), sm)) {
        const int rbg = u >> 3, cb = u & 7;
        int e = 0;
        while (offs[e + 1] <= rbg) e++;
        const int rbi = rbg - offs[e];
        const int ce = W_cnt[l * 32 + e];
        __syncthreads();
        if (tid < 128) { const int idx = rbi * 128 + tid; ns[tid] = idx < ce ? W_LIST[(size_t)e * TT + idx] : -1; }
        __syncthreads();
        const int n0 = cb * 128;
        const bf16_t* ab_ = W_ACT;
        const float* wp = p.moe_w_down + (size_t)(l * 32 + e) * 512 * 1024 + n0 + (tid & 127);
        f32x4 acc[4][4];
        gemm128_main<true>(512, (char*)sm, [&](int r) { return ab_ + (size_t)max(ns[r], 0) * 512; }, [&](int k, int n) { return wp[(size_t)k * 1024]; }, acc);
#pragma unroll
        for (int i = 0; i < 4; i++) {
            const int n = ns[wm * 64 + i * 16 + r16];
            if (n >= 0) {
                const float wt = W_EW[n];
#pragma unroll
                for (int j = 0; j < 4; j++) {
                    const int col = n0 + wn * 64 + j * 16 + q * 4;
                    st4bf(&W_YEXP[(size_t)n * 1024 + col], make_float4(acc[i][j][0] * wt, acc[i][j][1] * wt, acc[i][j][2] * wt, acc[i][j][3] * wt));
                }
            }
        }
    }
}

enum { PH_PRO1 = 0, PH_PRO2, PH_NORM1, PH_GEMM1, PH_PREP, PH_MIX, PH_HGOUT, PH_GEMM2, PH_NORM2, PH_MOE1, PH_MOE2, PH_FINAL };

template <int PH>
__device__ __forceinline__ void run_phase(const Params& p, int l, float* sm) {
    if (PH == PH_PRO1) phase_pro1(p, sm);
    else if (PH == PH_PRO2) phase_pro2(p, sm);
    else if (PH == PH_NORM1) phase_norm1(p, l, sm);
    else if (PH == PH_GEMM1) phase_gemm1(p, l, sm);
    else if (PH == PH_PREP) phase_prep(p, l, sm);
    else if (PH == PH_MIX) phase_mix(p, l, sm);
    else if (PH == PH_HGOUT) phase_mix2(p, l, sm);
    else if (PH == PH_GEMM2) phase_gemm2(p, l, sm);
    else if (PH == PH_NORM2) phase_norm2(p, l, sm);
    else if (PH == PH_MOE1) phase_moe1(p, l, sm);
    else if (PH == PH_MOE2) phase_moe2(p, l, sm);
    else if (PH == PH_FINAL) phase_final(p, sm);
}

#if !MEGA
template <int PH>
__global__ void __launch_bounds__(256, 2) k_phase(Params p, int l) {
    __shared__ float sm[SMF];
    run_phase<PH>(p, l, sm);
}
#else
__global__ void __launch_bounds__(256, 2) k_mega(Params p) {
    __shared__ float sm[SMF];
    __shared__ uint4 xb_words;
    if (TIDX == 0) xb_words = make_uint4(0u, 0u, 0u, 0u);
    __syncthreads();
    if (threadIdx.x == 0) ((int*)sm)[SMF - 2] = 0;
    __syncthreads();
    XcdBarrier bar = xcd_barrier_post(W_bar, (volatile LAS unsigned*)&xb_words);
#if USE_CG
#define xcd_barrier(b) cooperative_groups::this_grid().sync()
#endif
    for (int r = 0; r < p.rep[PH_PRO1]; r++) { if (threadIdx.x == 0) ((int*)sm)[SMF - 2] = r; __syncthreads(); run_phase<PH_PRO1>(p, 0, sm); xcd_barrier(bar); }
    for (int r = 0; r < p.rep[PH_PRO2]; r++) { if (threadIdx.x == 0) ((int*)sm)[SMF - 2] = r; __syncthreads(); run_phase<PH_PRO2>(p, 0, sm); xcd_barrier(bar); }
    for (int l = 0; l < DEPTH; l++) {
        if (threadIdx.x == 0) ((int*)sm)[SMF - 2] = 0; __syncthreads(); run_phase<PH_NORM1>(p, l, sm); xcd_barrier(bar);
        for (int r = 0; r < p.rep[PH_GEMM1]; r++) { if (threadIdx.x == 0) ((int*)sm)[SMF - 2] = r; __syncthreads(); run_phase<PH_GEMM1>(p, l, sm); xcd_barrier(bar); }
        for (int r = 0; r < p.rep[PH_PREP]; r++) { if (threadIdx.x == 0) ((int*)sm)[SMF - 2] = r; __syncthreads(); run_phase<PH_PREP>(p, l, sm); xcd_barrier(bar); }
        for (int r = 0; r < p.rep[PH_MIX]; r++) { if (threadIdx.x == 0) ((int*)sm)[SMF - 2] = r; __syncthreads(); run_phase<PH_MIX>(p, l, sm); xcd_barrier(bar); }
        for (int r = 0; r < p.rep[PH_HGOUT]; r++) { if (threadIdx.x == 0) ((int*)sm)[SMF - 2] = r; __syncthreads(); run_phase<PH_HGOUT>(p, l, sm); xcd_barrier(bar); }
        if (threadIdx.x == 0) ((int*)sm)[SMF - 2] = 0; __syncthreads(); run_phase<PH_GEMM2>(p, l, sm); xcd_barrier(bar);
        run_phase<PH_NORM2>(p, l, sm); xcd_barrier(bar);
        for (int r = 0; r < p.rep[PH_MOE1]; r++) { if (threadIdx.x == 0) ((int*)sm)[SMF - 2] = r; __syncthreads(); run_phase<PH_MOE1>(p, l, sm); xcd_barrier(bar); }
        for (int r = 0; r < p.rep[PH_MOE2]; r++) { if (threadIdx.x == 0) ((int*)sm)[SMF - 2] = r; __syncthreads(); run_phase<PH_MOE2>(p, l, sm); xcd_barrier(bar); }
    }
    run_phase<PH_FINAL>(p, 0, sm);
}
#endif

static inline size_t align_up(size_t v, size_t a) { return (v + a - 1) / a * a; }

extern "C" void kernel_launch(void* const* d_in, const int* in_sizes, int n_in, void* d_out, int out_size, void* d_ws, size_t ws_size,
                              hipStream_t stream) {
    Params p{};
    const float* const* in = (const float* const*)d_in;
    p.x = in[0]; p.c = in[1]; p.ctx = in[2]; p.c_ctx = in[3]; p.w_ada = in[4]; p.b_ada = in[5]; p.norm1_g = in[6]; p.norm2_g = in[7];
    p.w_in = in[8]; p.w_out = in[9]; p.lb_logits = in[10]; p.hgrn_norm_g = in[11];
    p.hy_short_w = in[12]; p.hy_short_b = in[13]; p.hy_w1 = in[14]; p.hy_b1 = in[15]; p.hy_freq = in[16]; p.hy_w2 = in[17]; p.hy_b2 = in[18];
    p.hy_w3 = in[19]; p.hy_b3 = in[20]; p.hy_decay = in[21]; p.hy_bias = in[22];
    p.na_rpb = in[23]; p.na_q_g = in[24]; p.na_k_g = in[25];
    p.mla_q_a_g = in[26]; p.mla_kv_a_g = in[27]; p.mla_w_uq = in[28]; p.mla_w_ukv = in[29]; p.mla_q_g = in[30]; p.mla_k_g = in[31];
    p.moe_wg = in[32]; p.moe_bg = in[33]; p.moe_we = in[34]; p.moe_be = in[35]; p.moe_w_gate = in[36]; p.moe_w_up = in[37]; p.moe_w_down = in[38];
    p.out = (float*)d_out;
    for (int i = 0; i < 16; i++) p.rep[i] = 1;
#ifdef PROBE_PH
    p.rep[PROBE_PH] = 2;
#endif
#ifdef PROBE_PH2
    p.rep[PROBE_PH2] = 2;
#endif

    p.ws = (char*)d_ws;
    const size_t off = WS_TOTAL;
    if (off > ws_size) { fprintf(stderr, "workspace too small: need %zu have %zu\n", off, ws_size); return; }

#if !MEGA
#ifndef BIGMASK
#define BIGMASK 0xFFF
#endif
#define GR(ph) (((BIGMASK >> (ph)) & 1) ? 1024 : 256)
    k_phase<PH_PRO1><<<GR(PH_PRO1), 256, 0, stream>>>(p, 0);
    k_phase<PH_PRO2><<<GR(PH_PRO2), 256, 0, stream>>>(p, 0);
    for (int l = 0; l < DEPTH; l++) {
        k_phase<PH_NORM1><<<GR(PH_NORM1), 256, 0, stream>>>(p, l);
        k_phase<PH_GEMM1><<<GR(PH_GEMM1), 256, 0, stream>>>(p, l);
        k_phase<PH_PREP><<<GR(PH_PREP), 256, 0, stream>>>(p, l);
        k_phase<PH_MIX><<<GR(PH_MIX), 256, 0, stream>>>(p, l);
        k_phase<PH_HGOUT><<<GR(PH_HGOUT), 256, 0, stream>>>(p, l);
        k_phase<PH_GEMM2><<<GR(PH_GEMM2), 256, 0, stream>>>(p, l);
        k_phase<PH_NORM2><<<GR(PH_NORM2), 256, 0, stream>>>(p, l);
        k_phase<PH_MOE1><<<GR(PH_MOE1), 256, 0, stream>>>(p, l);
        k_phase<PH_MOE2><<<GR(PH_MOE2), 256, 0, stream>>>(p, l);
    }
    k_phase<PH_FINAL><<<GR(PH_FINAL), 256, 0, stream>>>(p, 0);
#else
    static int grid = 0;
    if (!grid) {
        int dev = 0, cus = 0, per_cu = 0;
        hipGetDevice(&dev);
        hipDeviceGetAttribute(&cus, hipDeviceAttributeMultiprocessorCount, dev);
        hipOccupancyMaxActiveBlocksPerMultiprocessor(&per_cu, k_mega, 256, 0);
        if (per_cu > 2) per_cu = 2;
        if (per_cu < 1) per_cu = 1;
        grid = cus * per_cu;
    }
    hipMemsetAsync(p.ws + OFF_bar, 0, (XCD_BAR_WORDS + WQ_WORDS) * sizeof(unsigned), stream);
#if USE_CG
    { void* args[] = {&p}; hipLaunchCooperativeKernel((void*)k_mega, dim3(grid), dim3(256), args, 0, stream); }
#else
    k_mega<<<grid, 256, 0, stream>>>(p);
#endif
#endif
}
```

```cpp
#include <hip/hip_runtime.h>
#include <stdint.h>
#include <stdio.h>
#include <hip/hip_cooperative_groups.h>
#define USE_CG 0

#ifndef MEGA
#define MEGA 1
#endif

#define DM 1024
#define NB 8
#define SEQ 2048
#define CTXL 256
#define NLAT (NB * SEQ)
#define NCTX (NB * CTXL)
#define TT (NLAT + NCTX)
#define DIN 3232
#define DEPTH 4
#define EPSF 1e-6f
#define C_HQ 0
#define C_ZF 256
#define C_ZB 512
#define C_HI 768
#define C_HG 1024
#define C_HY 1280
#define C_NA 2048
#define C_CQ 2816
#define C_CKV 3072
#define C_KR 3200

#define SMF 17920

typedef unsigned short bf16_t;

struct Params {
    const float *x, *c, *ctx, *c_ctx, *w_ada, *b_ada, *norm1_g, *norm2_g, *w_in, *w_out, *lb_logits, *hgrn_norm_g;
    const float *hy_short_w, *hy_short_b, *hy_w1, *hy_b1, *hy_freq, *hy_w2, *hy_b2, *hy_w3, *hy_b3, *hy_decay, *hy_bias;
    const float *na_rpb, *na_q_g, *na_k_g, *mla_q_a_g, *mla_kv_a_g, *mla_w_uq, *mla_w_ukv, *mla_q_g, *mla_k_g;
    const float *moe_wg, *moe_bg, *moe_we, *moe_be, *moe_w_gate, *moe_w_up, *moe_w_down;
    float* out;
    char* ws;
    int rep[16];
};

#define XB_TMO      128
#define XB_XCNT(j)  (256  + 64 * (j))
#define XB_XSUB(j)  (1280 + 64 * (j))
#define XB_XGEN(j)  (2304 + 64 * (j))
#define XB_TOP      3328
#define XB_TOPGEN   3392
#define XCD_BAR_WORDS 3456
#define XB_SPIN_CAP (1u << 22)
#define LAS __attribute__((address_space(3)))

__device__ __forceinline__ unsigned xb_ld(unsigned* p)              { return __hip_atomic_load(p, __ATOMIC_RELAXED, __HIP_MEMORY_SCOPE_AGENT); }
__device__ __forceinline__ unsigned xb_add(unsigned* p, unsigned v) { return __hip_atomic_fetch_add(p, v, __ATOMIC_RELAXED, __HIP_MEMORY_SCOPE_AGENT); }
__device__ __forceinline__ unsigned xb_xcc_id() { return (unsigned)__builtin_amdgcn_s_getreg((3 << 11) | 20) & 0xFu; }
#define XB_SPIN(cond, bar) do { unsigned _sp = 0; while (cond) { __builtin_amdgcn_s_sleep(1); \
    if ((++_sp & 255u) == 0u) { if (xb_ld(&(bar)[XB_TMO])) break; if (_sp > XB_SPIN_CAP) { atomicAdd(&(bar)[XB_TMO], 1u); break; } } } } while (0)

struct XcdBarrier { unsigned* bar; unsigned x; volatile LAS unsigned* st; };

__device__ __forceinline__ XcdBarrier xcd_barrier_post(unsigned* bar, volatile LAS unsigned* st) {
    XcdBarrier b; b.bar = bar; b.x = xb_xcc_id(); b.st = st;
    if (threadIdx.x == 0) (void)xb_add(&bar[XB_XCNT(b.x)], 1u);
    return b;
}
__device__ __forceinline__ void xcd_barrier_complete(unsigned* bar, unsigned x, unsigned& nloc, unsigned& nx) {
    const unsigned G = gridDim.x * gridDim.y * gridDim.z;
    unsigned sum, cnt, mine, sp = 0u;
    for (;;) {
        sum = 0u; cnt = 0u; mine = 0u;
#pragma unroll
        for (unsigned j = 0; j < 16; ++j) { const unsigned c = xb_ld(&bar[XB_XCNT(j)]); sum += c; cnt += (c > 0u) ? 1u : 0u; mine = (j == x) ? c : mine; }
        if (sum == G) break;
        __builtin_amdgcn_s_sleep(1);
        if ((++sp & 255u) == 0u) { if (xb_ld(&bar[XB_TMO])) break; if (sp > XB_SPIN_CAP) { atomicAdd(&bar[XB_TMO], 1u); break; } }
    }
    nloc = mine > 0u ? mine : 1u; nx = cnt > 0u ? cnt : 1u;
}
__device__ __forceinline__ void xcd_barrier(const XcdBarrier& b) {
    asm volatile("s_waitcnt vmcnt(0)" ::: "memory");
    __syncthreads();
    if (threadIdx.x == 0) {
        unsigned* bar = b.bar;
        __builtin_amdgcn_s_waitcnt(0);
        unsigned nloc = b.st[0], nx = b.st[1];
        if (nloc == 0u) { xcd_barrier_complete(bar, b.x, nloc, nx); b.st[0] = nloc; b.st[1] = nx; }
        const unsigned old = xb_add(&bar[XB_XSUB(b.x)], 1u);
        const unsigned gen = old / nloc;
        if (old + 1u == (gen + 1u) * nloc) {
            __builtin_amdgcn_fence(__ATOMIC_RELEASE, "agent");
            asm volatile("s_waitcnt vmcnt(0)" ::: "memory");
            const unsigned og = xb_add(&bar[XB_TOP], 1u);
            const unsigned tg = og / nx;
            if (og + 1u == (tg + 1u) * nx) xb_add(&bar[XB_TOPGEN], 1u);
            else XB_SPIN(xb_ld(&bar[XB_TOPGEN]) == tg, bar);
            __builtin_amdgcn_fence(__ATOMIC_ACQUIRE, "agent");
            xb_add(&bar[XB_XGEN(b.x)], 1u);
            asm volatile("s_waitcnt vmcnt(0)" ::: "memory");
        } else {
            XB_SPIN(xb_ld(&bar[XB_XGEN(b.x)]) == gen, bar);
            __builtin_amdgcn_fence(__ATOMIC_ACQUIRE, "agent");
            asm volatile("s_waitcnt vmcnt(0)" ::: "memory");
        }
    }
    __syncthreads();
}

__device__ __forceinline__ int tid_opaque() { int t = threadIdx.x; asm volatile("" : "+v"(t)); return t; }
__device__ __forceinline__ int bid_opaque() { int t = blockIdx.x; asm volatile("" : "+s"(t)); return t; }
#define TIDX tid_opaque()
#define BIDX bid_opaque()
typedef __attribute__((ext_vector_type(8))) short bf16x8;
typedef __attribute__((ext_vector_type(4))) float f32x4;
typedef __attribute__((ext_vector_type(4))) unsigned u32x4;
typedef __attribute__((ext_vector_type(2))) __bf16 bf16x2_t;
__device__ __forceinline__ bf16_t f2bf(float f) { return __builtin_bit_cast(bf16_t, (__bf16)f); }
__device__ __forceinline__ float bf2f(bf16_t h) { return __uint_as_float(((unsigned)h) << 16); }
__device__ __forceinline__ unsigned pack2bf(float a, float b) { bf16x2_t v; v[0] = (__bf16)a; v[1] = (__bf16)b; return __builtin_bit_cast(unsigned, v); }
__device__ __forceinline__ float4 ld4bf(const bf16_t* p) { const uint2 u = *(const uint2*)p; float4 r; r.x = __uint_as_float(u.x << 16); r.y = __uint_as_float(u.x & 0xFFFF0000u); r.z = __uint_as_float(u.y << 16); r.w = __uint_as_float(u.y & 0xFFFF0000u); return r; }
__device__ __forceinline__ void st4bf(bf16_t* p, float4 v) { uint2 u; u.x = pack2bf(v.x, v.y); u.y = pack2bf(v.z, v.w); *(uint2*)p = u; }
__device__ __forceinline__ float wave_sum(float v) {
#pragma unroll
    for (int o = 32; o > 0; o >>= 1) v += __shfl_xor(v, o);
    return v;
}
__device__ __forceinline__ float sigmoidf_(float z) { return 1.f / (1.f + __expf(-z)); }
__device__ __forceinline__ float siluf_(float z) { return z / (1.f + __expf(-z)); }
__device__ __forceinline__ int bidx_of(int row) { return row < NLAT ? (row >> 11) : 8; }
__device__ __forceinline__ int kv_pos(int kidx) { const int w = kidx & 31; return (kidx & ~31) | (((w >> 2) & 3) * 8 + (w >> 4) * 4 + (w & 3)); }

__device__ __forceinline__ float block_sum(float v, float* red) {
    v = wave_sum(v);
    __syncthreads();
    if ((TIDX & 63) == 0) red[TIDX >> 6] = v;
    __syncthreads();
    float r = red[0] + red[1] + red[2] + red[3];
    __syncthreads();
    return r;
}

typedef __attribute__((address_space(1))) char gchar_t;
__device__ __forceinline__ gchar_t* ws_opaque(char* w) { gchar_t* g = (gchar_t*)w; asm volatile("" : "+s"(g)); return g; }
#define WQ_SLOTS 32
#define WQ_WORDS ((DEPTH + 1) * WQ_SLOTS * 16)
constexpr size_t ws_al(size_t v) { return (v + 255) / 256 * 256; }
#define WSB(p) ws_opaque((p).ws)
constexpr size_t OFF_bar = 0;
constexpr size_t OFF_cnt = ws_al(OFF_bar + ((XCD_BAR_WORDS + WQ_WORDS) * 4));
constexpr size_t OFF_X = ws_al(OFF_cnt + (DEPTH * 32 * 4));
constexpr size_t OFF_MOD = ws_al(OFF_X + ((size_t)TT * 1024 * 4));
constexpr size_t OFF_LB = ws_al(OFF_MOD + ((size_t)DEPTH * 9 * 6144 * 4));
constexpr size_t OFF_HDN = ws_al(OFF_LB + (DEPTH * 512 * 4));
constexpr size_t OFF_TW = ws_al(OFF_HDN + ((size_t)DEPTH * 2 * 2048 * 64 * 4));
constexpr size_t OFF_KSPEC = ws_al(OFF_TW + (4096 * 8));
constexpr size_t OFF_HYKC = ws_al(OFF_KSPEC + ((size_t)DEPTH * 2 * 256 * 4096 * 8));
constexpr size_t OFF_H = ws_al(OFF_HYKC + ((size_t)DEPTH * 2 * 256 * 2 * 256 * 4));
constexpr size_t OFF_P = ws_al(OFF_H + ((size_t)TT * 1024 * 2));
constexpr size_t OFF_OF = ws_al(OFF_P + ((size_t)TT * DIN * 2));
constexpr size_t OFF_HU = ws_al(OFF_OF + ((size_t)TT * 256 * 4));
constexpr size_t OFF_HQ = ws_al(OFF_HU + ((size_t)1152 * 2 * 4096 * 4));
constexpr size_t OFF_HD = ws_al(OFF_HQ + ((size_t)1152 * 2 * 4096 * 4));
constexpr size_t OFF_NQ = ws_al(OFF_HD + ((size_t)1152 * 2 * 64 * 4));
constexpr size_t OFF_NK = ws_al(OFF_NQ + ((size_t)TT * 256 * 2));
constexpr size_t OFF_NVT = ws_al(OFF_NK + ((size_t)TT * 256 * 2));
constexpr size_t OFF_MQ = ws_al(OFF_NVT + ((size_t)NB * 4 * 64 * 2304 * 2));
constexpr size_t OFF_MK = ws_al(OFF_MQ + ((size_t)TT * 384 * 2));
constexpr size_t OFF_MVT = ws_al(OFF_MK + ((size_t)TT * 384 * 2));
constexpr size_t OFF_CAT = ws_al(OFF_MVT + ((size_t)NB * 4 * 64 * 2304 * 2));
constexpr size_t OFF_EW = ws_al(OFF_CAT + ((size_t)TT * 1024 * 2));
constexpr size_t OFF_LIST = ws_al(OFF_EW + ((size_t)TT * 2 * 4));
constexpr size_t OFF_ACT = ws_al(OFF_LIST + ((size_t)32 * TT * 4));
constexpr size_t OFF_YEXP = ws_al(OFF_ACT + ((size_t)TT * 2 * 512 * 2));
constexpr size_t OFF_norm1_g = ws_al(OFF_YEXP + ((size_t)TT * 2 * 1024 * 4));
constexpr size_t OFF_norm2_g = ws_al(OFF_norm1_g + ((size_t)(DEPTH * 1024) * 4));
constexpr size_t OFF_hgrn_norm_g = ws_al(OFF_norm2_g + ((size_t)(DEPTH * 1024) * 4));
constexpr size_t OFF_hy_short_w = ws_al(OFF_hgrn_norm_g + ((size_t)(DEPTH * 64) * 4));
constexpr size_t OFF_hy_short_b = ws_al(OFF_hy_short_w + ((size_t)(DEPTH * 3 * 768) * 4));
constexpr size_t OFF_hy_bias = ws_al(OFF_hy_short_b + ((size_t)(DEPTH * 768) * 4));
constexpr size_t OFF_na_rpb = ws_al(OFF_hy_bias + ((size_t)(DEPTH * 2 * 256) * 4));
constexpr size_t OFF_na_q_g = ws_al(OFF_na_rpb + ((size_t)(DEPTH * 4 * 15 * 31) * 4));
constexpr size_t OFF_na_k_g = ws_al(OFF_na_q_g + ((size_t)(DEPTH * 64) * 4));
constexpr size_t OFF_mla_q_a_g = ws_al(OFF_na_k_g + ((size_t)(DEPTH * 64) * 4));
constexpr size_t OFF_mla_kv_a_g = ws_al(OFF_mla_q_a_g + ((size_t)(DEPTH * 256) * 4));
constexpr size_t OFF_mla_w_uq = ws_al(OFF_mla_kv_a_g + ((size_t)(DEPTH * 128) * 4));
constexpr size_t OFF_mla_w_ukv = ws_al(OFF_mla_w_uq + ((size_t)(DEPTH * 256 * 384) * 4));
constexpr size_t OFF_mla_q_g = ws_al(OFF_mla_w_ukv + ((size_t)(DEPTH * 128 * 512) * 4));
constexpr size_t OFF_mla_k_g = ws_al(OFF_mla_q_g + ((size_t)(DEPTH * 96) * 4));
constexpr size_t OFF_moe_wg = ws_al(OFF_mla_k_g + ((size_t)(DEPTH * 96) * 4));
constexpr size_t OFF_moe_bg = ws_al(OFF_moe_wg + ((size_t)(DEPTH * 1024 * 4) * 4));
constexpr size_t OFF_moe_we = ws_al(OFF_moe_bg + ((size_t)(DEPTH * 4) * 4));
constexpr size_t OFF_moe_be = ws_al(OFF_moe_we + ((size_t)(DEPTH * 1024 * 32) * 4));
constexpr size_t OFF_WUQT = ws_al(OFF_moe_be + ((size_t)(DEPTH * 32) * 4));
constexpr size_t OFF_WUKVT = ws_al(OFF_WUQT + (size_t)DEPTH * 384 * 256 * 2);
constexpr size_t OFF_ROPE = ws_al(OFF_WUKVT + (size_t)DEPTH * 512 * 128 * 2);
constexpr size_t OFF_SP = ws_al(OFF_ROPE + (size_t)2048 * 16 * 8);
constexpr size_t OFF_WINT = ws_al(OFF_SP + (size_t)1152 * 2 * 4096 * 4);
constexpr size_t OFF_WOUTT = ws_al(OFF_WINT + (size_t)DEPTH * DIN * 1024 * 2);
constexpr size_t WS_TOTAL = ws_al(OFF_WOUTT + (size_t)DEPTH * 1024 * 1024 * 2);
#define W_WINT ((bf16_t*)(WSB(p) + OFF_WINT))
#define W_WOUTT ((bf16_t*)(WSB(p) + OFF_WOUTT))
#define W_SP ((float*)(WSB(p) + OFF_SP))
#define W_WUQT ((bf16_t*)(WSB(p) + OFF_WUQT))
#define W_WUKVT ((bf16_t*)(WSB(p) + OFF_WUKVT))
#define W_ROPE ((float2*)(WSB(p) + OFF_ROPE))
#define W_bar ((unsigned*)(WSB(p) + OFF_bar))
#define W_cnt ((int*)(WSB(p) + OFF_cnt))
#define W_X ((float*)(WSB(p) + OFF_X))
#define W_MOD ((float*)(WSB(p) + OFF_MOD))
#define W_LB ((float*)(WSB(p) + OFF_LB))
#define W_HDN ((float*)(WSB(p) + OFF_HDN))
#define W_TW ((float2*)(WSB(p) + OFF_TW))
#define W_KSPEC ((float2*)(WSB(p) + OFF_KSPEC))
#define W_HYKC ((float*)(WSB(p) + OFF_HYKC))
#define W_H ((bf16_t*)(WSB(p) + OFF_H))
#define W_P ((bf16_t*)(WSB(p) + OFF_P))
#define W_OF ((float*)(WSB(p) + OFF_OF))
#define W_HU ((float*)(WSB(p) + OFF_HU))
#define W_HQ ((float*)(WSB(p) + OFF_HQ))
#define W_HD ((float*)(WSB(p) + OFF_HD))
#define W_NQ ((bf16_t*)(WSB(p) + OFF_NQ))
#define W_NK ((bf16_t*)(WSB(p) + OFF_NK))
#define W_NVT ((bf16_t*)(WSB(p) + OFF_NVT))
#define W_MQ ((bf16_t*)(WSB(p) + OFF_MQ))
#define W_MK ((bf16_t*)(WSB(p) + OFF_MK))
#define W_MVT ((bf16_t*)(WSB(p) + OFF_MVT))
#define W_CAT ((bf16_t*)(WSB(p) + OFF_CAT))
#define W_EW ((float*)(WSB(p) + OFF_EW))
#define W_LIST ((int*)(WSB(p) + OFF_LIST))
#define W_ACT ((bf16_t*)(WSB(p) + OFF_ACT))
#define W_YEXP ((bf16_t*)(WSB(p) + OFF_YEXP))
#define W_wq (W_bar + XCD_BAR_WORDS)
#define W_norm1_g ((const float*)(WSB(p) + OFF_norm1_g))
#define W_norm2_g ((const float*)(WSB(p) + OFF_norm2_g))
#define W_hgrn_norm_g ((const float*)(WSB(p) + OFF_hgrn_norm_g))
#define W_hy_short_w ((const float*)(WSB(p) + OFF_hy_short_w))
#define W_hy_short_b ((const float*)(WSB(p) + OFF_hy_short_b))
#define W_hy_bias ((const float*)(WSB(p) + OFF_hy_bias))
#define W_na_rpb ((const float*)(WSB(p) + OFF_na_rpb))
#define W_na_q_g ((const float*)(WSB(p) + OFF_na_q_g))
#define W_na_k_g ((const float*)(WSB(p) + OFF_na_k_g))
#define W_mla_q_a_g ((const float*)(WSB(p) + OFF_mla_q_a_g))
#define W_mla_kv_a_g ((const float*)(WSB(p) + OFF_mla_kv_a_g))
#define W_mla_w_uq ((const float*)(WSB(p) + OFF_mla_w_uq))
#define W_mla_w_ukv ((const float*)(WSB(p) + OFF_mla_w_ukv))
#define W_mla_q_g ((const float*)(WSB(p) + OFF_mla_q_g))
#define W_mla_k_g ((const float*)(WSB(p) + OFF_mla_k_g))
#define W_moe_wg ((const float*)(WSB(p) + OFF_moe_wg))
#define W_moe_bg ((const float*)(WSB(p) + OFF_moe_bg))
#define W_moe_we ((const float*)(WSB(p) + OFF_moe_we))
#define W_moe_be ((const float*)(WSB(p) + OFF_moe_be))

__device__ __forceinline__ int wq_next(unsigned* ctr, float* sm) {
    int* slot = (int*)(sm + SMF - 1);
    __syncthreads();
    if (TIDX == 0) *slot = (int)__hip_atomic_fetch_add(ctr, 1u, __ATOMIC_RELAXED, __HIP_MEMORY_SCOPE_AGENT);
    __syncthreads();
    return *slot;
}
#define WQ(p, l, site) (W_wq + (((l) + 1) * WQ_SLOTS + (site) + 16 * ((const int*)sm)[SMF - 2]) * 16)
template <class FA, class FB, class FE>
__device__ __forceinline__ void gemm_tile_f32(int K, float* sm, FA fa, FB fb, FE fe) {
    float* As = sm;
    float* Bs = sm + 16 * 68;
    const int tid = TIDX, tx = tid & 15, ty = tid >> 4;
    float acc[4][4];
#pragma unroll
    for (int a = 0; a < 4; a++)
#pragma unroll
        for (int b = 0; b < 4; b++) acc[a][b] = 0.f;
    for (int k0 = 0; k0 < K; k0 += 16) {
#pragma unroll
        for (int q = 0; q < 4; q++) { int e = tid + 256 * q; int i = e >> 4, kk = e & 15; As[kk * 68 + i] = fa(i, k0 + kk); }
#pragma unroll
        for (int q = 0; q < 4; q++) { int e = tid + 256 * q; int kk = e >> 6, j = e & 63; Bs[kk * 68 + j] = fb(k0 + kk, j); }
        __syncthreads();
#pragma unroll
        for (int kk = 0; kk < 16; kk++) {
            float4 a4 = *(const float4*)&As[kk * 68 + ty * 4];
            float4 b4 = *(const float4*)&Bs[kk * 68 + tx * 4];
            float av[4] = {a4.x, a4.y, a4.z, a4.w}, bv[4] = {b4.x, b4.y, b4.z, b4.w};
#pragma unroll
            for (int a = 0; a < 4; a++)
#pragma unroll
                for (int b = 0; b < 4; b++) acc[a][b] += av[a] * bv[b];
        }
        __syncthreads();
    }
#pragma unroll
    for (int a = 0; a < 4; a++)
#pragma unroll
        for (int b = 0; b < 4; b++) fe(ty * 4 + a, tx * 4 + b, acc[a][b]);
}


#define GEMM_LOAD(k0) { _Pragma("unroll") for (int i_ = 0; i_ < 4; i_++) ra[i_] = *(const u32x4*)(ap[i_] + (k0)); \
    _Pragma("unroll") for (int i_ = 0; i_ < 4; i_++) _Pragma("unroll") for (int j_ = 0; j_ < 8; j_++) rb[i_][j_] = bload((k0) + (bkg + 2 * i_) * 8 + j_, bn); }
#define GEMM_WRITE(buf) { char* As_ = smc + (buf) * 16384; char* Bs_ = smc + 32768 + (buf) * 16384; \
    _Pragma("unroll") for (int i_ = 0; i_ < 4; i_++) *(u32x4*)(As_ + (arow + 32 * i_) * 128 + ((ac ^ (arow & 7)) * 16)) = ra[i_]; \
    _Pragma("unroll") for (int i_ = 0; i_ < 4; i_++) { u32x4 b_; b_[0] = pack2bf(rb[i_][0], rb[i_][1]); b_[1] = pack2bf(rb[i_][2], rb[i_][3]); \
        b_[2] = pack2bf(rb[i_][4], rb[i_][5]); b_[3] = pack2bf(rb[i_][6], rb[i_][7]); \
        *(u32x4*)(Bs_ + bn * 128 + (((bkg + 2 * i_) ^ (bn & 7)) * 16)) = b_; } }
template <bool SWAP, class FA, class FB>
__device__ __forceinline__ void gemm128_main(int K, char* smc, FA arowp, FB bload, f32x4 (&acc)[4][4]) {
    const int tid = TIDX, lane = tid & 63, w = tid >> 6;
    const int wm = w >> 1, wn = w & 1, r16 = lane & 15, q = lane >> 4;
#pragma unroll
    for (int i = 0; i < 4; i++)
#pragma unroll
        for (int j = 0; j < 4; j++) acc[i][j] = (f32x4){0.f, 0.f, 0.f, 0.f};
    const int arow = tid >> 3, ac = tid & 7;
    const int bn = tid & 127, bkg = tid >> 7;
    const bf16_t* ap[4];
#pragma unroll
    for (int i = 0; i < 4; i++) ap[i] = arowp(arow + 32 * i) + ac * 8;
    u32x4 ra[4];
    float rb[4][8];
    GEMM_LOAD(0)
    __syncthreads();
    GEMM_WRITE(0)
    __syncthreads();
    const int KT = K >> 6;
    for (int kt = 0; kt < KT; kt++) {
        const bool more = (kt + 1 < KT);
        if (more) GEMM_LOAD((kt + 1) * 64)
        const char* As = smc + (kt & 1) * 16384;
        const char* Bs = smc + 32768 + (kt & 1) * 16384;
#pragma unroll
        for (int ks = 0; ks < 2; ks++) {
            bf16x8 af[4], bfr[4];
            const int sw = ((ks * 4 + q) ^ (r16 & 7)) * 16;
#pragma unroll
            for (int i = 0; i < 4; i++) af[i] = *(const bf16x8*)(As + (wm * 64 + i * 16 + r16) * 128 + sw);
#pragma unroll
            for (int j = 0; j < 4; j++) bfr[j] = *(const bf16x8*)(Bs + (wn * 64 + j * 16 + r16) * 128 + sw);
            __builtin_amdgcn_s_setprio(1);
#pragma unroll
            for (int i = 0; i < 4; i++)
#pragma unroll
                for (int j = 0; j < 4; j++)
                    acc[i][j] = SWAP ? __builtin_amdgcn_mfma_f32_16x16x32_bf16(bfr[j], af[i], acc[i][j], 0, 0, 0)
                                     : __builtin_amdgcn_mfma_f32_16x16x32_bf16(af[i], bfr[j], acc[i][j], 0, 0, 0);
            __builtin_amdgcn_s_setprio(0);
        }
        if (more) GEMM_WRITE((kt + 1) & 1)
        __syncthreads();
    }
}

#define GEMMBT_LOAD(k0) { _Pragma("unroll") for (int i_ = 0; i_ < 4; i_++) { ra[i_] = *(const u32x4*)(ap[i_] + (k0)); rbv[i_] = *(const u32x4*)(bp[i_] + (k0)); } }
#define GEMMBT_WRITE(buf) { char* As_ = smc + (buf) * 16384; char* Bs_ = smc + 32768 + (buf) * 16384; \
    _Pragma("unroll") for (int i_ = 0; i_ < 4; i_++) { *(u32x4*)(As_ + (arow + 32 * i_) * 128 + ((ac ^ (arow & 7)) * 16)) = ra[i_]; \
                                                      *(u32x4*)(Bs_ + (arow + 32 * i_) * 128 + ((ac ^ (arow & 7)) * 16)) = rbv[i_]; } }
#define GEMMBT_LOADS(k0, RA, RB) { _Pragma("unroll") for (int i_ = 0; i_ < 4; i_++) { RA[i_] = *(const u32x4*)(ap[i_] + (k0)); RB[i_] = *(const u32x4*)(bp[i_] + (k0)); } }
#define GEMMBT_WRITES(buf, RA, RB) { char* As_ = smc + (buf) * 16384; char* Bs_ = smc + 32768 + (buf) * 16384; \
    _Pragma("unroll") for (int i_ = 0; i_ < 4; i_++) { *(u32x4*)(As_ + (arow + 32 * i_) * 128 + ((ac ^ (arow & 7)) * 16)) = RA[i_]; \
                                                      *(u32x4*)(Bs_ + (arow + 32 * i_) * 128 + ((ac ^ (arow & 7)) * 16)) = RB[i_]; } }
#define GEMMBT_COMPUTE(buf) { const char* As = smc + (buf) * 16384; const char* Bs = smc + 32768 + (buf) * 16384; \
    _Pragma("unroll") for (int ks = 0; ks < 2; ks++) { bf16x8 af[4], bfr[4]; const int sw = ((ks * 4 + q) ^ (r16 & 7)) * 16; \
        _Pragma("unroll") for (int i = 0; i < 4; i++) af[i] = *(const bf16x8*)(As + (wm * 64 + i * 16 + r16) * 128 + sw); \
        _Pragma("unroll") for (int j = 0; j < 4; j++) bfr[j] = *(const bf16x8*)(Bs + (wn * 64 + j * 16 + r16) * 128 + sw); \
        __builtin_amdgcn_s_setprio(1); \
        _Pragma("unroll") for (int i = 0; i < 4; i++) _Pragma("unroll") for (int j = 0; j < 4; j++) \
            acc[i][j] = SWAP ? __builtin_amdgcn_mfma_f32_16x16x32_bf16(bfr[j], af[i], acc[i][j], 0, 0, 0) \
                             : __builtin_amdgcn_mfma_f32_16x16x32_bf16(af[i], bfr[j], acc[i][j], 0, 0, 0); \
        __builtin_amdgcn_s_setprio(0); } }
template <bool SWAP, class FA, class FBR>
__device__ __forceinline__ void gemm128_bt(int K, char* smc, FA arowp, FBR browp, f32x4 (&acc)[4][4]) {
    const int tid = TIDX, lane = tid & 63, w = tid >> 6;
    const int wm = w >> 1, wn = w & 1, r16 = lane & 15, q = lane >> 4;
#pragma unroll
    for (int i = 0; i < 4; i++)
#pragma unroll
        for (int j = 0; j < 4; j++) acc[i][j] = (f32x4){0.f, 0.f, 0.f, 0.f};
    const int arow = tid >> 3, ac = tid & 7;
    const bf16_t* ap[4];
    const bf16_t* bp[4];
#pragma unroll
    for (int i = 0; i < 4; i++) { ap[i] = arowp(arow + 32 * i) + ac * 8; bp[i] = browp(arow + 32 * i) + ac * 8; }
    u32x4 ra0[4], rb0[4], ra1[4], rb1[4];
    GEMMBT_LOADS(0, ra0, rb0)
    GEMMBT_LOADS(64, ra1, rb1)
    __syncthreads();
    GEMMBT_WRITES(0, ra0, rb0)
    __syncthreads();
    const int KT = K >> 6;
    for (int kt = 0; kt < KT; kt += 2) {
        if (kt + 2 < KT) GEMMBT_LOADS((kt + 2) * 64, ra0, rb0)
        GEMMBT_COMPUTE(0)
        GEMMBT_WRITES(1, ra1, rb1)
        __syncthreads();
        if (kt + 3 < KT) GEMMBT_LOADS((kt + 3) * 64, ra1, rb1)
        GEMMBT_COMPUTE(1)
        if (kt + 2 < KT) GEMMBT_WRITES(0, ra0, rb0)
        __syncthreads();
    }
}

#define FFT_PHYS(pos) ((pos) + ((pos) >> 4))
__device__ __forceinline__ float2 cmul(float2 a, float2 b) { return make_float2(a.x * b.x - a.y * b.y, a.x * b.y + a.y * b.x); }
__device__ __forceinline__ float2 cmulc(float2 a, float2 b) { return make_float2(a.x * b.x + a.y * b.y, a.y * b.x - a.x * b.y); }
__device__ __forceinline__ void dft4f(float2& a0, float2& a1, float2& a2, float2& a3) {
    const float2 t0 = make_float2(a0.x + a2.x, a0.y + a2.y), t1 = make_float2(a0.x - a2.x, a0.y - a2.y);
    const float2 t2 = make_float2(a1.x + a3.x, a1.y + a3.y), t3 = make_float2(a1.x - a3.x, a1.y - a3.y);
    a0 = make_float2(t0.x + t2.x, t0.y + t2.y);
    a1 = make_float2(t1.x + t3.y, t1.y - t3.x);
    a2 = make_float2(t0.x - t2.x, t0.y - t2.y);
    a3 = make_float2(t1.x - t3.y, t1.y + t3.x);
}
__device__ __forceinline__ void dft4i(float2& a0, float2& a1, float2& a2, float2& a3) {
    const float2 t0 = make_float2(a0.x + a2.x, a0.y + a2.y), t1 = make_float2(a0.x - a2.x, a0.y - a2.y);
    const float2 t2 = make_float2(a1.x + a3.x, a1.y + a3.y), t3 = make_float2(a1.x - a3.x, a1.y - a3.y);
    a0 = make_float2(t0.x + t2.x, t0.y + t2.y);
    a1 = make_float2(t1.x - t3.y, t1.y + t3.x);
    a2 = make_float2(t0.x - t2.x, t0.y - t2.y);
    a3 = make_float2(t1.x + t3.y, t1.y - t3.x);
}
template <int S> struct FftGeo { static constexpr int Ns = 4096 >> (2 * S), Ms = Ns / 4, Ms1 = Ms / 4; };
template <int S>
__device__ __forceinline__ int fft_phys_base(int tid) {
    if (S == 0) return tid + (tid >> 4);
    if (S == 2) return (tid >> 4) * 272 + (tid & 15);
    return tid * 17;
}
template <int S>
__device__ __forceinline__ constexpr int fft_phys_off(int r1, int r2) {
    return S == 0 ? 272 * (r1 * 4 + r2) : (S == 2 ? 68 * r1 + 17 * r2 : 4 * r1 + r2);
}
template <int S>
__device__ __forceinline__ void fft_fwd_pass(float2 (&v)[4][4], int tid, const float2* __restrict__ TW) {
    const int jp = tid % FftGeo<S>::Ms1;
#pragma unroll
    for (int r2 = 0; r2 < 4; r2++) {
        dft4f(v[0][r2], v[1][r2], v[2][r2], v[3][r2]);
        const float2 w = TW[((jp + r2 * FftGeo<S>::Ms1) << (2 * S)) & 4095];
        const float2 w2 = cmul(w, w), w3 = cmul(w2, w);
        v[1][r2] = cmul(v[1][r2], w); v[2][r2] = cmul(v[2][r2], w2); v[3][r2] = cmul(v[3][r2], w3);
    }
    if (S < 4) {
        const float2 w = TW[(jp << (2 * S + 2)) & 4095];
        const float2 w2 = cmul(w, w), w3 = cmul(w2, w);
#pragma unroll
        for (int q1 = 0; q1 < 4; q1++) {
            dft4f(v[q1][0], v[q1][1], v[q1][2], v[q1][3]);
            v[q1][1] = cmul(v[q1][1], w); v[q1][2] = cmul(v[q1][2], w2); v[q1][3] = cmul(v[q1][3], w3);
        }
    } else {
#pragma unroll
        for (int q1 = 0; q1 < 4; q1++) dft4f(v[q1][0], v[q1][1], v[q1][2], v[q1][3]);
    }
}
template <int S>
__device__ __forceinline__ void fft_inv_pass(float2 (&v)[4][4], int tid, const float2* __restrict__ TW) {
    const int jp = tid % FftGeo<S>::Ms1;
    if (S < 4) {
        const float2 w = TW[(jp << (2 * S + 2)) & 4095];
        const float2 w2 = cmul(w, w), w3 = cmul(w2, w);
#pragma unroll
        for (int q1 = 0; q1 < 4; q1++) {
            v[q1][1] = cmulc(v[q1][1], w); v[q1][2] = cmulc(v[q1][2], w2); v[q1][3] = cmulc(v[q1][3], w3);
            dft4i(v[q1][0], v[q1][1], v[q1][2], v[q1][3]);
        }
    } else {
#pragma unroll
        for (int q1 = 0; q1 < 4; q1++) dft4i(v[q1][0], v[q1][1], v[q1][2], v[q1][3]);
    }
#pragma unroll
    for (int r2 = 0; r2 < 4; r2++) {
        const float2 w = TW[((jp + r2 * FftGeo<S>::Ms1) << (2 * S)) & 4095];
        const float2 w2 = cmul(w, w), w3 = cmul(w2, w);
        v[1][r2] = cmulc(v[1][r2], w); v[2][r2] = cmulc(v[2][r2], w2); v[3][r2] = cmulc(v[3][r2], w3);
        dft4i(v[0][r2], v[1][r2], v[2][r2], v[3][r2]);
    }
}
template <int S>
__device__ __forceinline__ void fft_lds_read(float2 (&v)[4][4], int tid, const float2* fb) {
    const float2* fbb = fb + fft_phys_base<S>(tid);
#pragma unroll
    for (int r1 = 0; r1 < 4; r1++)
#pragma unroll
        for (int r2 = 0; r2 < 4; r2++) v[r1][r2] = fbb[fft_phys_off<S>(r1, r2)];
}
template <int S>
__device__ __forceinline__ void fft_lds_write(const float2 (&v)[4][4], int tid, float2* fb) {
    float2* fbb = fb + fft_phys_base<S>(tid);
#pragma unroll
    for (int r1 = 0; r1 < 4; r1++)
#pragma unroll
        for (int r2 = 0; r2 < 4; r2++) fbb[fft_phys_off<S>(r1, r2)] = v[r1][r2];
}

__device__ void phase_pro1(const Params& p, float* sm) {
    const int tid = TIDX, nth = blockDim.x * gridDim.x, gtid = BIDX * blockDim.x + tid;
    for (int i = gtid; i < DEPTH * 32; i += nth) W_cnt[i] = 0;
    for (int i = gtid; i < 4096; i += nth) { float sn, cs; sincospif((float)i * (1.f / 2048.f), &sn, &cs); W_TW[i] = make_float2(cs, -sn); }
    for (int i = gtid; i < 512; i += nth) {
        float z0 = p.lb_logits[i], z1 = p.lb_logits[512 + i], z2 = p.lb_logits[1024 + i], z3 = p.lb_logits[1536 + i];
        float m = fmaxf(fmaxf(z0, z1), fmaxf(z2, z3));
        float e0 = expf(z0 - m), e1 = expf(z1 - m), e2 = expf(z2 - m), e3 = expf(z3 - m);
        float inv = 1.f / (e0 + e1 + e2 + e3);
        W_LB[i] = 0.f; W_LB[512 + i] = e1 * inv; W_LB[1024 + i] = (e1 + e2) * inv; W_LB[1536 + i] = (e1 + e2 + e3) * inv;
    }
    for (int i = gtid; i < DEPTH * 384 * 256; i += nth) {
        const int k = i & 255, n = (i >> 8) % 384, ll = i / (384 * 256);
        ((bf16_t*)(p.ws + OFF_WUQT))[i] = f2bf(p.mla_q_a_g[ll * 256 + k] * p.mla_w_uq[(size_t)(ll * 256 + k) * 384 + n]);
    }
    for (int i = gtid; i < DEPTH * 512 * 128; i += nth) {
        const int k = i & 127, n = (i >> 7) & 511, ll = i >> 16;
        ((bf16_t*)(p.ws + OFF_WUKVT))[i] = f2bf(p.mla_kv_a_g[ll * 128 + k] * p.mla_w_ukv[(size_t)(ll * 128 + k) * 512 + n]);
    }
    for (int i = gtid; i < 2048 * 16; i += nth) {
        const int t = i >> 4, j = i & 15;
        const float pos = j < 8 ? (float)(t >> 6) : (float)(t & 63);
        const float inv = expf(-9.210340371976184f * (float)(j & 7) * 0.125f);
        float sn, cs;
        sincosf(pos * inv, &sn, &cs);
        ((float2*)(p.ws + OFF_ROPE))[i] = make_float2(cs, sn);
    }
    {
        const int NT_IN = DEPTH * 16 * 51, NT_OUT = DEPTH * 16 * 16;
        for (int u = wq_next(WQ(p, -1, 2), sm); u < NT_IN + NT_OUT; u = wq_next(WQ(p, -1, 2), sm)) {
            const float* src; bf16_t* dst; int N, kt, nt;
            if (u < NT_IN) { const int ll = u / (16 * 51), r = u % (16 * 51); kt = r / 51; nt = r % 51; N = DIN; src = p.w_in + (size_t)ll * 1024 * DIN; dst = (bf16_t*)(p.ws + OFF_WINT) + (size_t)ll * DIN * 1024; }
            else { const int v = u - NT_IN; const int ll = v >> 8, r = v & 255; kt = r >> 4; nt = r & 15; N = 1024; src = p.w_out + (size_t)ll * 1024 * 1024; dst = (bf16_t*)(p.ws + OFF_WOUTT) + (size_t)ll * 1024 * 1024; }
#pragma unroll
            for (int i = 0; i < 4; i++) {
                const int idx = tid + 256 * i, kr = idx >> 4, c4 = idx & 15;
                const int n = nt * 64 + c4 * 4;
                float4 v = make_float4(0.f, 0.f, 0.f, 0.f);
                if (n < N) v = *(const float4*)&src[(size_t)(kt * 64 + kr) * N + n];
                sm[kr * 68 + c4 * 4 + 0] = v.x; sm[kr * 68 + c4 * 4 + 1] = v.y; sm[kr * 68 + c4 * 4 + 2] = v.z; sm[kr * 68 + c4 * 4 + 3] = v.w;
            }
            __syncthreads();
#pragma unroll
            for (int i = 0; i < 2; i++) {
                const int idx = tid + 256 * i, nr = idx >> 3, c8 = idx & 7;
                const int n = nt * 64 + nr;
                if (n < N) {
                    u32x4 o;
                    o[0] = pack2bf(sm[(c8 * 8 + 0) * 68 + nr], sm[(c8 * 8 + 1) * 68 + nr]); o[1] = pack2bf(sm[(c8 * 8 + 2) * 68 + nr], sm[(c8 * 8 + 3) * 68 + nr]);
                    o[2] = pack2bf(sm[(c8 * 8 + 4) * 68 + nr], sm[(c8 * 8 + 5) * 68 + nr]); o[3] = pack2bf(sm[(c8 * 8 + 6) * 68 + nr], sm[(c8 * 8 + 7) * 68 + nr]);
                    *(u32x4*)&dst[(size_t)n * 1024 + kt * 64 + c8 * 8] = o;
                }
            }
        }
    }
    for (int i = gtid; i < (DEPTH * 1024); i += nth) ((float*)(WSB(p) + OFF_norm1_g))[i] = p.norm1_g[i];
    for (int i = gtid; i < (DEPTH * 1024); i += nth) ((float*)(WSB(p) + OFF_norm2_g))[i] = p.norm2_g[i];
    for (int i = gtid; i < (DEPTH * 64); i += nth) ((float*)(WSB(p) + OFF_hgrn_norm_g))[i] = p.hgrn_norm_g[i];
    for (int i = gtid; i < (DEPTH * 3 * 768); i += nth) ((float*)(WSB(p) + OFF_hy_short_w))[i] = p.hy_short_w[i];
    for (int i = gtid; i < (DEPTH * 768); i += nth) ((float*)(WSB(p) + OFF_hy_short_b))[i] = p.hy_short_b[i];
    for (int i = gtid; i < (DEPTH * 2 * 256); i += nth) ((float*)(WSB(p) + OFF_hy_bias))[i] = p.hy_bias[i];
    for (int i = gtid; i < (DEPTH * 4 * 15 * 31); i += nth) ((float*)(WSB(p) + OFF_na_rpb))[i] = p.na_rpb[i];
    for (int i = gtid; i < (DEPTH * 64); i += nth) ((float*)(WSB(p) + OFF_na_q_g))[i] = p.na_q_g[i];
    for (int i = gtid; i < (DEPTH * 64); i += nth) ((float*)(WSB(p) + OFF_na_k_g))[i] = p.na_k_g[i];
    for (int i = gtid; i < (DEPTH * 256); i += nth) ((float*)(WSB(p) + OFF_mla_q_a_g))[i] = p.mla_q_a_g[i];
    for (int i = gtid; i < (DEPTH * 128); i += nth) ((float*)(WSB(p) + OFF_mla_kv_a_g))[i] = p.mla_kv_a_g[i];
    for (int i = gtid; i < (DEPTH * 256 * 384); i += nth) ((float*)(WSB(p) + OFF_mla_w_uq))[i] = p.mla_w_uq[i];
    for (int i = gtid; i < (DEPTH * 128 * 512); i += nth) ((float*)(WSB(p) + OFF_mla_w_ukv))[i] = p.mla_w_ukv[i];
    for (int i = gtid; i < (DEPTH * 96); i += nth) ((float*)(WSB(p) + OFF_mla_q_g))[i] = p.mla_q_g[i];
    for (int i = gtid; i < (DEPTH * 96); i += nth) ((float*)(WSB(p) + OFF_mla_k_g))[i] = p.mla_k_g[i];
    for (int i = gtid; i < (DEPTH * 1024 * 4); i += nth) ((float*)(WSB(p) + OFF_moe_wg))[i] = p.moe_wg[i];
    for (int i = gtid; i < (DEPTH * 4); i += nth) ((float*)(WSB(p) + OFF_moe_bg))[i] = p.moe_bg[i];
    for (int i = gtid; i < (DEPTH * 1024 * 32); i += nth) ((float*)(WSB(p) + OFF_moe_we))[i] = p.moe_we[i];
    for (int i = gtid; i < (DEPTH * 32); i += nth) ((float*)(WSB(p) + OFF_moe_be))[i] = p.moe_be[i];
    for (int u = wq_next(WQ(p, -1, 0), sm); u < DEPTH * 96; u = wq_next(WQ(p, -1, 0), sm)) {
        const int l = u / 96, cg = u % 96;
        for (int i = tid; i < 9 * 1024; i += 256) { float v = i < 8192 ? p.c[i] : p.c_ctx[i - 8192]; sm[i] = siluf_(v); }
        __syncthreads();
        const int col = cg * 64 + (tid & 63), kq = tid >> 6;
        float acc[9];
#pragma unroll
        for (int r = 0; r < 9; r++) acc[r] = 0.f;
        const float* w = p.w_ada + (size_t)l * 1024 * 6144 + col;
        for (int k = kq * 256; k < kq * 256 + 256; k++) {
            float wv = w[(size_t)k * 6144];
#pragma unroll
            for (int r = 0; r < 9; r++) acc[r] += sm[r * 1024 + k] * wv;
        }
        float* red = sm + 9 * 1024;
#pragma unroll
        for (int r = 0; r < 9; r++) red[(kq * 9 + r) * 64 + (tid & 63)] = acc[r];
        __syncthreads();
        if (tid < 64) {
#pragma unroll
            for (int r = 0; r < 9; r++)
                W_MOD[(size_t)(l * 9 + r) * 6144 + col] = red[(0 * 9 + r) * 64 + tid] + red[(1 * 9 + r) * 64 + tid] + red[(2 * 9 + r) * 64 + tid] +
                                                          red[(3 * 9 + r) * 64 + tid] + p.b_ada[l * 6144 + col];
        }
        __syncthreads();
    }
    {
        const int wave = tid >> 6, lane = tid & 63;
        for (int wu = BIDX * 4 + wave; wu < DEPTH * 2304; wu += gridDim.x * 4) {
            const int l = wu / 2304, rem = wu % 2304;
            const int which = rem >= 2048 ? 1 : 0;
            const int t = which ? rem - 2048 : rem;
            const int L = which ? 256 : 2048;
            const float tu = (float)t / (float)(L - 1);
            float feat = 0.f;
            if (lane == 0) feat = tu;
            else if (lane <= 32) {
                const int bi = (lane - 1) & 15;
                const float band = 1e-4f + (float)bi * ((15.f - 1e-4f) / 15.f);
                float uu = (float)t * band / (float)L;
                uu -= floorf(uu);
                float s_, c_;
                sincospif(2.f * uu, &s_, &c_);
                feat = lane <= 16 ? c_ : -s_;
            }
            const float fr = p.hy_freq[l * 64 + lane];
            float a = p.hy_b1[l * 64 + lane];
            for (int e = 0; e < 33; e++) a += __shfl(feat, e) * p.hy_w1[(l * 33 + e) * 64 + lane];
            const float h1 = sinf(fr * a);
            float a2 = p.hy_b2[l * 64 + lane];
            for (int i = 0; i < 64; i++) a2 += __shfl(h1, i) * p.hy_w2[(l * 64 + i) * 64 + lane];
            const float h2 = sinf(fr * a2);
            W_HDN[((size_t)(l * 2 + which) * 2048 + t) * 64 + lane] = h2;
        }
    }
}

template <int LL>
__device__ __forceinline__ void hyk_unit(const Params& p, int l, int o, int c, float* sm) {
    constexpr int NT = LL / 256;
    constexpr int which = (LL == 256) ? 1 : 0;
    const int tid = TIDX;
    const int colf = o * 512 + c, colb = o * 512 + 256 + c;
    __syncthreads();
    if (tid < 64) { sm[tid] = p.hy_w3[(size_t)(l * 64 + tid) * 1024 + colf]; sm[64 + tid] = p.hy_w3[(size_t)(l * 64 + tid) * 1024 + colb]; }
    __syncthreads();
    const float bf = p.hy_b3[l * 1024 + colf], bb = p.hy_b3[l * 1024 + colb];
    const float df = p.hy_decay[((l * 2 + o) * 2 + 0) * 256 + c], dbw = p.hy_decay[((l * 2 + o) * 2 + 1) * 256 + c];
    float vf[NT], vb[NT];
    float ss = 0.f;
#pragma unroll
    for (int i = 0; i < NT; i++) {
        const int t = tid + 256 * i;
        const float* h = W_HDN + ((size_t)(l * 2 + which) * 2048 + t) * 64;
        float af = bf, ab = bb;
#pragma unroll 4
        for (int k = 0; k < 64; k++) { float hv = h[k]; af += hv * sm[k]; ab += hv * sm[64 + k]; }
        const float tu = (float)t / (float)(LL - 1);
        af *= expf(-tu * df); ab *= expf(-tu * dbw);
        vf[i] = af; vb[i] = ab;
        ss += af * af + (t > 0 ? ab * ab : 0.f);
    }
    const float tot = block_sum(ss, sm + 128);
    const float scale = rsqrtf(tot + EPSF);
    if (which) {
        float* outp = W_HYKC + (size_t)((l * 2 + o) * 256 + c) * 2 * LL;
#pragma unroll
        for (int i = 0; i < NT; i++) { const int t = tid + 256 * i; outp[t] = vf[i] * scale; outp[LL + t] = vb[i] * scale; }
    } else {
        float* kl = sm + 256;
        float2* fb = (float2*)(sm + 256 + 4096);
#pragma unroll
        for (int i = 0; i < NT; i++) {
            const int t = tid + 256 * i;
            kl[t] = vf[i] * scale;
            if (t > 0) kl[4096 - t] = vb[i] * scale;
        }
        if (tid == 0) kl[2048] = 0.f;
        __syncthreads();
        float2 v[4][4];
#pragma unroll
        for (int r1 = 0; r1 < 4; r1++)
#pragma unroll
            for (int r2 = 0; r2 < 4; r2++) v[r1][r2] = make_float2(kl[tid + 256 * (r1 * 4 + r2)], 0.f);
        fft_fwd_pass<0>(v, tid, W_TW);
        fft_lds_write<0>(v, tid, fb);
        __syncthreads();
        fft_lds_read<2>(v, tid, fb);
        fft_fwd_pass<2>(v, tid, W_TW);
        fft_lds_write<2>(v, tid, fb);
        __syncthreads();
        fft_lds_read<4>(v, tid, fb);
        fft_fwd_pass<4>(v, tid, W_TW);
        float2* outp = W_KSPEC + (size_t)((l * 2 + o) * 256 + c) * 4096 + tid * 16;
#pragma unroll
        for (int r1 = 0; r1 < 4; r1++)
#pragma unroll
            for (int r2 = 0; r2 < 4; r2++) outp[r1 * 4 + r2] = make_float2(v[r1][r2].x * (1.f / 4096.f), v[r1][r2].y * (1.f / 4096.f));
    }
}
__device__ void phase_pro2(const Params& p, float* sm) {
    for (int u = wq_next(WQ(p, -1, 1), sm); u < DEPTH * 512 + (DEPTH - 1) * 512; u = wq_next(WQ(p, -1, 1), sm)) {
        const int which = u / (DEPTH * 512), r = u % (DEPTH * 512);
        const int l = r / 512, o = (r / 256) & 1, c = r & 255;
        if (which == 0) hyk_unit<2048>(p, l, o, c, sm); else hyk_unit<256>(p, l, o, c, sm);
    }
}

__device__ void phase_norm1(const Params& p, int l, float* sm) {
    const int wave = TIDX >> 6, lane = TIDX & 63;
    for (int row = BIDX * 4 + wave; row < TT; row += gridDim.x * 4) {
        const int bi = bidx_of(row);
        float4 xv[4];
        float ss = 0.f;
#pragma unroll
        for (int i = 0; i < 4; i++) {
            const int k = i * 256 + lane * 4;
            const float* xsrc = l > 0 ? &W_X[(size_t)row * 1024 + k] : (row < NLAT ? &p.x[(size_t)row * 1024 + k] : &p.ctx[(size_t)(row - NLAT) * 1024 + k]);
            float4 v = *(const float4*)xsrc;
            if (l > 0) {
                const float4 g2 = *(const float4*)&W_MOD[(size_t)((l - 1) * 9 + bi) * 6144 + 5120 + k];
                const float4 y0 = ld4bf(&W_YEXP[((size_t)row * 2 + 0) * 1024 + k]);
                const float4 y1 = ld4bf(&W_YEXP[((size_t)row * 2 + 1) * 1024 + k]);
                v.x += g2.x * (y0.x + y1.x); v.y += g2.y * (y0.y + y1.y); v.z += g2.z * (y0.z + y1.z); v.w += g2.w * (y0.w + y1.w);
                *(float4*)&W_X[(size_t)row * 1024 + k] = v;
            }
            xv[i] = v;
            ss += v.x * v.x + v.y * v.y + v.z * v.z + v.w * v.w;
        }
        ss = wave_sum(ss);
        const float rstd = rsqrtf(ss * (1.f / 1024.f) + EPSF);
        const float* md = W_MOD + (size_t)(l * 9 + bi) * 6144;
#pragma unroll
        for (int i = 0; i < 4; i++) {
            const int k = i * 256 + lane * 4;
            const float4 g = *(const float4*)&W_norm1_g[l * 1024 + k];
            const float4 sh = *(const float4*)&md[k];
            const float4 sc = *(const float4*)&md[1024 + k];
            float4 o;
            o.x = xv[i].x * rstd * g.x * (1.f + sc.x) + sh.x;
            o.y = xv[i].y * rstd * g.y * (1.f + sc.y) + sh.y;
            o.z = xv[i].z * rstd * g.z * (1.f + sc.z) + sh.z;
            o.w = xv[i].w * rstd * g.w * (1.f + sc.w) + sh.w;
            st4bf(&W_H[(size_t)row * 1024 + k], o);
        }
    }
}

__device__ void phase_final(const Params& p, float* sm) {
    const int nth = blockDim.x * gridDim.x, gtid = BIDX * blockDim.x + TIDX;
    for (int i = gtid; i < NLAT * 256; i += nth) {
        const int row = i >> 8, k = (i & 255) * 4;
        const int bi = row >> 11;
        float4 v = *(const float4*)&W_X[(size_t)row * 1024 + k];
        const float4 g2 = *(const float4*)&W_MOD[(size_t)(3 * 9 + bi) * 6144 + 5120 + k];
        const float4 y0 = ld4bf(&W_YEXP[((size_t)row * 2 + 0) * 1024 + k]);
        const float4 y1 = ld4bf(&W_YEXP[((size_t)row * 2 + 1) * 1024 + k]);
        v.x += g2.x * (y0.x + y1.x); v.y += g2.y * (y0.y + y1.y); v.z += g2.z * (y0.z + y1.z); v.w += g2.w * (y0.w + y1.w);
        *(float4*)&p.out[(size_t)row * 1024 + k] = v;
    }
}

__device__ void phase_gemm1(const Params& p, int l, float* sm) {
    const int NTN = (DIN + 127) / 128;
    const float* W = p.w_in + (size_t)l * 1024 * DIN;
    const int tid = TIDX, lane = tid & 63, w = tid >> 6, wm = w >> 1, wn = w & 1, r16 = lane & 15, q = lane >> 4;
    for (int u = wq_next(WQ(p, l, 0), sm); u < 144 * 4 * 7; u = wq_next(WQ(p, l, 0), sm)) {
        const int band = u / (144 * 4), rem = u % (144 * 4);
        const int bw = min(4, NTN - band * 4);
        const int rb = rem / bw, cb = band * 4 + rem % bw;
        if (rb >= 144) continue;
        const int r0 = rb * 128, n0 = cb * 128;
        f32x4 acc[4][4];
        const bf16_t* hb = W_H + (size_t)r0 * 1024;
        const bf16_t* wb = W_WINT + (size_t)l * DIN * 1024;
        gemm128_bt<true>(1024, (char*)sm, [&](int r) { return hb + (size_t)r * 1024; },
                         [&](int r) { return wb + (size_t)min(n0 + r, DIN - 1) * 1024; }, acc);
#pragma unroll
        for (int i = 0; i < 4; i++)
#pragma unroll
            for (int j = 0; j < 4; j++) {
                const int m = r0 + wm * 64 + i * 16 + r16, n = n0 + wn * 64 + j * 16 + q * 4;
                if (n < DIN) st4bf(&W_P[(size_t)m * DIN + n], make_float4(acc[i][j][0], acc[i][j][1], acc[i][j][2], acc[i][j][3]));
            }
    }
}

__device__ void phase_prep_main(const Params& p, int l, float* sm);
__device__ __forceinline__ void hgrn_local_unit(const Params& p, int l, int u, float* sm);
__device__ void phase_prep(const Params& p, int l, float* sm) {
    const bool main_first = (BIDX >> 8) & 1;
    if (main_first) phase_prep_main(p, l, sm);
    for (int u = wq_next(WQ(p, l, 1), sm); u < 1152; u = wq_next(WQ(p, l, 1), sm)) hgrn_local_unit(p, l, u, sm);
    if (!main_first) phase_prep_main(p, l, sm);
}
__device__ void phase_prep_main(const Params& p, int l, float* sm) {
    const int tid = TIDX, lane = tid & 63, w = tid >> 6, r16 = lane & 15, q4 = lane >> 4;
    char* smc = (char*)sm;
    char* Acq = smc;
    char* Ackv = smc + 8448;
    float* R = (float*)(smc + 12800);
    float* krf = (float*)(smc + 12800 + 16 * 516 * 4);
    float* rsq = krf + 512;
    float* rskv = rsq + 16;
    for (int u = wq_next(WQ(p, l, 2), sm); u < TT / 16; u = wq_next(WQ(p, l, 2), sm)) {
        const int r0 = u * 16;
        const bool lat = r0 < NLAT;
        const int bb = lat ? (r0 >> 11) : ((r0 - NLAT) >> 8);
        const int kidx0 = lat ? (r0 & 2047) : 2048 + ((r0 - NLAT) & 255);
        const int posb = (kidx0 & ~31) + ((kidx0 >> 4) & 1) * 4;
        const bf16_t* Pb = W_P + (size_t)r0 * DIN;
        {
            for (int c = tid; c < 512; c += 256) { const int row = c >> 5, cc = c & 31; *(u32x4*)(Acq + row * 528 + cc * 16) = *(const u32x4*)(Pb + (size_t)row * DIN + C_CQ + cc * 8); }
            { const int row = tid >> 4, cc = tid & 15; *(u32x4*)(Ackv + row * 272 + cc * 16) = *(const u32x4*)(Pb + (size_t)row * DIN + C_CKV + cc * 8); }
            for (int i = tid; i < 512; i += 256) krf[i] = bf2f(Pb[(size_t)(i >> 5) * DIN + C_KR + (i & 31)]);
        }
        {
            const float4 gq = *(const float4*)&W_na_q_g[l * 64 + r16 * 4];
            const float4 gk = *(const float4*)&W_na_k_g[l * 64 + r16 * 4];
#pragma unroll 2
            for (int ps = 0; ps < 8; ps++) {
                const int item = ps * 16 + (tid >> 4);
                const int tk = item >> 3, h = (item >> 1) & 3, wh = item & 1;
                const float4 v = ld4bf(Pb + (size_t)tk * DIN + C_NA + wh * 256 + h * 64 + r16 * 4);
                float ss = v.x * v.x + v.y * v.y + v.z * v.z + v.w * v.w;
                ss += __shfl_xor(ss, 1); ss += __shfl_xor(ss, 2); ss += __shfl_xor(ss, 4); ss += __shfl_xor(ss, 8);
                const float rs = rsqrtf(ss * (1.f / 64.f) + EPSF);
                const float4 g = wh ? gk : gq;
                st4bf((wh ? W_NK : W_NQ) + (size_t)(r0 + tk) * 256 + h * 64 + r16 * 4, make_float4(v.x * rs * g.x, v.y * rs * g.y, v.z * rs * g.z, v.w * rs * g.w));
            }
            const int h = tid >> 6, d = tid & 63;
            bf16_t* dst = W_NVT + (size_t)((bb * 4 + h) * 64 + d) * 2304 + posb;
#pragma unroll
            for (int qq = 0; qq < 4; qq++) {
                const bf16_t* src = Pb + (size_t)(qq * 4) * DIN + C_NA + 512 + h * 64 + d;
                uint2 pk;
                pk.x = (unsigned)src[0] | ((unsigned)src[DIN] << 16);
                pk.y = (unsigned)src[2 * DIN] | ((unsigned)src[3 * DIN] << 16);
                *(uint2*)(dst + qq * 8) = pk;
            }
        }
        __syncthreads();
        {
            const int tk = w * 4 + q4;
            float ss = 0.f;
#pragma unroll
            for (int j = 0; j < 2; j++) { const float4 a = ld4bf((const bf16_t*)(Acq + tk * 528) + r16 * 16 + j * 8), b = ld4bf((const bf16_t*)(Acq + tk * 528) + r16 * 16 + j * 8 + 4);
                ss += a.x * a.x + a.y * a.y + a.z * a.z + a.w * a.w + b.x * b.x + b.y * b.y + b.z * b.z + b.w * b.w; }
            ss += __shfl_xor(ss, 1); ss += __shfl_xor(ss, 2); ss += __shfl_xor(ss, 4); ss += __shfl_xor(ss, 8);
            float s2 = 0.f;
            { const float4 a = ld4bf((const bf16_t*)(Ackv + tk * 272) + r16 * 8), b = ld4bf((const bf16_t*)(Ackv + tk * 272) + r16 * 8 + 4);
              s2 = a.x * a.x + a.y * a.y + a.z * a.z + a.w * a.w + b.x * b.x + b.y * b.y + b.z * b.z + b.w * b.w; }
            s2 += __shfl_xor(s2, 1); s2 += __shfl_xor(s2, 2); s2 += __shfl_xor(s2, 4); s2 += __shfl_xor(s2, 8);
            if (r16 == 0) { rsq[tk] = rsqrtf(ss * (1.f / 256.f) + EPSF); rskv[tk] = rsqrtf(s2 * (1.f / 128.f) + EPSF); }
        }
        __syncthreads();
        {
            const bf16_t* WB = W_WUQT + (size_t)l * 384 * 256;
            const float rs = rsq[r16];
#pragma unroll 2
            for (int it = 0; it < 6; it++) {
                const int nt = it * 4 + w;
                f32x4 acc = (f32x4){0.f, 0.f, 0.f, 0.f};
#pragma unroll
                for (int ks = 0; ks < 8; ks++) {
                    const bf16x8 bfr = *(const bf16x8*)(WB + (size_t)(nt * 16 + r16) * 256 + ks * 32 + q4 * 8);
                    const bf16x8 afr = *(const bf16x8*)(Acq + r16 * 528 + ks * 64 + q4 * 16);
                    acc = __builtin_amdgcn_mfma_f32_16x16x32_bf16(bfr, afr, acc, 0, 0, 0);
                }
                *(float4*)&R[r16 * 516 + nt * 16 + q4 * 4] = make_float4(acc[0] * rs, acc[1] * rs, acc[2] * rs, acc[3] * rs);
            }
        }
        __syncthreads();
        {
            const int tk = w * 4 + q4;
            const int trow = r0 + tk;
            const float* gq = W_mla_q_g + l * 96;
            const float2* rp = W_ROPE + (size_t)(trow & 2047) * 16;
#pragma unroll 1
            for (int h = 0; h < 4; h++) {
                float v[6];
                float ss = 0.f;
#pragma unroll
                for (int m = 0; m < 6; m++) { v[m] = R[tk * 516 + h * 96 + m * 16 + r16]; ss += v[m] * v[m]; }
                ss += __shfl_xor(ss, 1); ss += __shfl_xor(ss, 2); ss += __shfl_xor(ss, 4); ss += __shfl_xor(ss, 8);
                const float rs = rsqrtf(ss * (1.f / 96.f) + EPSF);
#pragma unroll
                for (int m = 0; m < 6; m++) v[m] = v[m] * rs * gq[m * 16 + r16];
                if (lat) {
#pragma unroll
                    for (int m = 4; m < 6; m++) {
                        const float other = __shfl_xor(v[m], 8);
                        const float2 cs = rp[(m - 4) * 8 + (r16 & 7)];
                        v[m] = (r16 < 8) ? (v[m] * cs.x - other * cs.y) : (other * cs.y + v[m] * cs.x);
                    }
                }
                bf16_t* dst = W_MQ + (size_t)trow * 384 + h * 96;
#pragma unroll
                for (int m = 0; m < 6; m++) dst[m * 16 + r16] = f2bf(v[m]);
            }
        }
        __syncthreads();
        {
            const bf16_t* WB = W_WUKVT + (size_t)l * 512 * 128;
            const float rs = rskv[r16];
#pragma unroll 2
            for (int it = 0; it < 8; it++) {
                const int nt = it * 4 + w;
                f32x4 acc = (f32x4){0.f, 0.f, 0.f, 0.f};
#pragma unroll
                for (int ks = 0; ks < 4; ks++) {
                    const bf16x8 bfr = *(const bf16x8*)(WB + (size_t)(nt * 16 + r16) * 128 + ks * 32 + q4 * 8);
                    const bf16x8 afr = *(const bf16x8*)(Ackv + r16 * 272 + ks * 64 + q4 * 16);
                    acc = __builtin_amdgcn_mfma_f32_16x16x32_bf16(bfr, afr, acc, 0, 0, 0);
                }
                *(float4*)&R[r16 * 516 + nt * 16 + q4 * 4] = make_float4(acc[0] * rs, acc[1] * rs, acc[2] * rs, acc[3] * rs);
            }
        }
        __syncthreads();
        {
            const int tk = w * 4 + q4;
            const int trow = r0 + tk;
            const float* gk = W_mla_k_g + l * 96;
            const float2* rp = W_ROPE + (size_t)(trow & 2047) * 16;
            const float kr0 = krf[tk * 32 + r16], kr1 = krf[tk * 32 + 16 + r16];
#pragma unroll 1
            for (int h = 0; h < 4; h++) {
                float v[6];
                float ss = 0.f;
#pragma unroll
                for (int m = 0; m < 4; m++) { v[m] = R[tk * 516 + h * 128 + m * 16 + r16]; ss += v[m] * v[m]; }
                v[4] = kr0; v[5] = kr1; ss += kr0 * kr0 + kr1 * kr1;
                ss += __shfl_xor(ss, 1); ss += __shfl_xor(ss, 2); ss += __shfl_xor(ss, 4); ss += __shfl_xor(ss, 8);
                const float rs = rsqrtf(ss * (1.f / 96.f) + EPSF);
#pragma unroll
                for (int m = 0; m < 6; m++) v[m] = v[m] * rs * gk[m * 16 + r16];
                if (lat) {
#pragma unroll
                    for (int m = 4; m < 6; m++) {
                        const float other = __shfl_xor(v[m], 8);
                        const float2 cs = rp[(m - 4) * 8 + (r16 & 7)];
                        v[m] = (r16 < 8) ? (v[m] * cs.x - other * cs.y) : (other * cs.y + v[m] * cs.x);
                    }
                }
                bf16_t* dst = W_MK + (size_t)trow * 384 + h * 96;
#pragma unroll
                for (int m = 0; m < 6; m++) dst[m * 16 + r16] = f2bf(v[m]);
            }
        }
        {
            const int h = tid >> 6, d = tid & 63;
            bf16_t* dst = W_MVT + (size_t)((bb * 4 + h) * 64 + d) * 2304 + posb;
            const float* src = R + h * 128 + 64 + d;
#pragma unroll
            for (int qq = 0; qq < 4; qq++) {
                uint2 pk;
                pk.x = pack2bf(src[(qq * 4 + 0) * 516], src[(qq * 4 + 1) * 516]);
                pk.y = pack2bf(src[(qq * 4 + 2) * 516], src[(qq * 4 + 3) * 516]);
                *(uint2*)(dst + qq * 8) = pk;
            }
        }
    }
}

template <int DQK, int QT, bool NA, class KIDX>
__device__ __forceinline__ void flash_attn(char* smc, const bf16_t* qrow0, int qstride, const bf16_t* kbuf_h, int kstride, int b,
                                           const bf16_t* vbase_bh, int nkb, KIDX kidx_of, float scale, bf16_t* orow0, int ostride,
                                           const float* rpbs, int na_r, int na_rs) {
    constexpr int KS = DQK / 32, CPR = DQK / 8, KSTR = DQK * 2 + 16, KBUF = 64 * KSTR, NKC = 64 * CPR / 256, VSTR = 144, VBUF = 64 * VSTR;
    const int tid = TIDX, lane = tid & 63, w = tid >> 6, r16 = lane & 15, q = lane >> 4;
    char* Kb = smc;
    char* Vb = smc + 2 * KBUF;
    bf16x8 qf[QT][KS];
#pragma unroll
    for (int qt = 0; qt < QT; qt++)
#pragma unroll
        for (int ks = 0; ks < KS; ks++) qf[qt][ks] = *(const bf16x8*)(qrow0 + (size_t)(w * QT * 16 + qt * 16 + r16) * qstride + ks * 32 + q * 8);
    f32x4 o[4][QT];
    float m[QT], ls[QT];
#pragma unroll
    for (int qt = 0; qt < QT; qt++) {
        m[qt] = -1e30f; ls[qt] = 0.f;
#pragma unroll
        for (int dt = 0; dt < 4; dt++) o[dt][qt] = (f32x4){0.f, 0.f, 0.f, 0.f};
    }
    u32x4 rk[NKC], rv[2];
    {
        const int kidx = kidx_of(0);
        const int trow = kidx < 2048 ? b * 2048 + kidx : NLAT + b * 256 + (kidx - 2048);
        const bf16_t* kp = kbuf_h + (size_t)trow * kstride;
        const bf16_t* vp = vbase_bh + kidx;
#pragma unroll
        for (int i = 0; i < NKC; i++) { const int c = tid + 256 * i; const int row = c / CPR, cc = c % CPR; rk[i] = *(const u32x4*)(kp + (size_t)row * kstride + cc * 8); }
#pragma unroll
        for (int i = 0; i < 2; i++) { const int c = tid + 256 * i; const int row = c >> 3, cc = c & 7; rv[i] = *(const u32x4*)(vp + (size_t)row * 2304 + cc * 8); }
    }
    __syncthreads();
#pragma unroll
    for (int i = 0; i < NKC; i++) { const int c = tid + 256 * i; const int row = c / CPR, cc = c % CPR; *(u32x4*)(Kb + row * KSTR + cc * 16) = rk[i]; }
#pragma unroll
    for (int i = 0; i < 2; i++) { const int c = tid + 256 * i; const int row = c >> 3, cc = c & 7; *(u32x4*)(Vb + row * VSTR + cc * 16) = rv[i]; }
    __syncthreads();
    for (int kb = 0; kb < nkb; kb++) {
        const bool more = kb + 1 < nkb;
        if (more) {
            const int kidx = kidx_of(kb + 1);
            const int trow = kidx < 2048 ? b * 2048 + kidx : NLAT + b * 256 + (kidx - 2048);
            const bf16_t* kp = kbuf_h + (size_t)trow * kstride;
            const bf16_t* vp = vbase_bh + kidx;
#pragma unroll
            for (int i = 0; i < NKC; i++) { const int c = tid + 256 * i; const int row = c / CPR, cc = c % CPR; rk[i] = *(const u32x4*)(kp + (size_t)row * kstride + cc * 8); }
#pragma unroll
            for (int i = 0; i < 2; i++) { const int c = tid + 256 * i; const int row = c >> 3, cc = c & 7; rv[i] = *(const u32x4*)(vp + (size_t)row * 2304 + cc * 8); }
        }
        const char* Ks_ = Kb + (kb & 1) * KBUF;
        const char* Vs_ = Vb + (kb & 1) * VBUF;
        f32x4 s[4][QT];
#pragma unroll
        for (int kt = 0; kt < 4; kt++) {
#pragma unroll
            for (int qt = 0; qt < QT; qt++) s[kt][qt] = (f32x4){0.f, 0.f, 0.f, 0.f};
#pragma unroll
            for (int ks = 0; ks < KS; ks++) {
                const bf16x8 kf = *(const bf16x8*)(Ks_ + (kt * 16 + r16) * KSTR + ks * 64 + q * 16);
#pragma unroll
                for (int qt = 0; qt < QT; qt++) s[kt][qt] = __builtin_amdgcn_mfma_f32_16x16x32_bf16(kf, qf[qt][ks], s[kt][qt], 0, 0, 0);
            }
        }
#pragma unroll
        for (int qt = 0; qt < QT; qt++) {
            float bm = -1e30f;
#pragma unroll
            for (int kt = 0; kt < 4; kt++)
#pragma unroll
                for (int e = 0; e < 4; e++) {
                    float v = s[kt][qt][e] * scale;
                    if (NA) {
                        if (kb < 8) {
                            const int kc = kt * 16 + q * 4 + e;
                            const int cq = w * 16 + r16;
                            const int dr = na_rs + kb - na_r + 7;
                            const int dc = min(max(kc - cq + 15, 0), 30);
                            const int cs = min(max(cq - 8, 0), 48);
                            const bool ok = (kc >= cs) && (kc < cs + 16);
                            v = ok ? v + rpbs[dr * 31 + dc] : -1e30f;
                        }
                    }
                    s[kt][qt][e] = v;
                    bm = fmaxf(bm, v);
                }
            bm = fmaxf(bm, __shfl_xor(bm, 16));
            bm = fmaxf(bm, __shfl_xor(bm, 32));
            const float mn = fmaxf(m[qt], bm);
            const float corr = __builtin_amdgcn_exp2f(m[qt] - mn);
            m[qt] = mn;
            float rsum = 0.f;
#pragma unroll
            for (int kt = 0; kt < 4; kt++)
#pragma unroll
                for (int e = 0; e < 4; e++) { const float pe = __builtin_amdgcn_exp2f(s[kt][qt][e] - mn); s[kt][qt][e] = pe; rsum += pe; }
            ls[qt] = ls[qt] * corr + rsum;
#pragma unroll
            for (int dt = 0; dt < 4; dt++) { o[dt][qt][0] *= corr; o[dt][qt][1] *= corr; o[dt][qt][2] *= corr; o[dt][qt][3] *= corr; }
        }
#pragma unroll
        for (int g = 0; g < 2; g++) {
            bf16x8 pf[QT];
#pragma unroll
            for (int qt = 0; qt < QT; qt++) {
                union { bf16x8 v; unsigned u[4]; } pk;
                pk.u[0] = pack2bf(s[2 * g][qt][0], s[2 * g][qt][1]); pk.u[1] = pack2bf(s[2 * g][qt][2], s[2 * g][qt][3]);
                pk.u[2] = pack2bf(s[2 * g + 1][qt][0], s[2 * g + 1][qt][1]); pk.u[3] = pack2bf(s[2 * g + 1][qt][2], s[2 * g + 1][qt][3]);
                pf[qt] = pk.v;
            }
#pragma unroll
            for (int dt = 0; dt < 4; dt++) {
                const bf16x8 vf = *(const bf16x8*)(Vs_ + (dt * 16 + r16) * VSTR + g * 64 + q * 16);
#pragma unroll
                for (int qt = 0; qt < QT; qt++) o[dt][qt] = __builtin_amdgcn_mfma_f32_16x16x32_bf16(vf, pf[qt], o[dt][qt], 0, 0, 0);
            }
        }
        if (more) {
            char* Kw = Kb + ((kb + 1) & 1) * KBUF;
            char* Vw = Vb + ((kb + 1) & 1) * VBUF;
#pragma unroll
            for (int i = 0; i < NKC; i++) { const int c = tid + 256 * i; const int row = c / CPR, cc = c % CPR; *(u32x4*)(Kw + row * KSTR + cc * 16) = rk[i]; }
#pragma unroll
            for (int i = 0; i < 2; i++) { const int c = tid + 256 * i; const int row = c >> 3, cc = c & 7; *(u32x4*)(Vw + row * VSTR + cc * 16) = rv[i]; }
        }
        __syncthreads();
    }
#pragma unroll
    for (int qt = 0; qt < QT; qt++) {
        float lt = ls[qt];
        lt += __shfl_xor(lt, 16);
        lt += __shfl_xor(lt, 32);
        const float inv = 1.f / lt;
#pragma unroll
        for (int dt = 0; dt < 4; dt++)
            st4bf(orow0 + (size_t)(w * QT * 16 + qt * 16 + r16) * ostride + dt * 16 + q * 4,
                  make_float4(o[dt][qt][0] * inv, o[dt][qt][1] * inv, o[dt][qt][2] * inv, o[dt][qt][3] * inv));
    }
}

__device__ __forceinline__ void mla_unit(const Params& p, int l, int u, bool isctx, float* sm) {
    int b, h, qb;
    if (!isctx) { b = u >> 6; h = (u >> 4) & 3; qb = u & 15; } else { b = u >> 3; h = (u >> 1) & 3; qb = u & 1; }
    const int qrow = (isctx ? NLAT + b * 256 : b * 2048) + qb * 128;
    const bf16_t* vb = W_MVT + (size_t)((b * 4 + h) * 64) * 2304;
    const float scale = 0.10206207261596577f * 1.4426950408889634f;
    if (!isctx)
        flash_attn<96, 2, false>((char*)sm, W_MQ + (size_t)qrow * 384 + h * 96, 384, W_MK + h * 96, 384, b, vb, 36, [](int kb) { return kb * 64; }, scale,
                                 W_CAT + (size_t)qrow * 1024 + 768 + h * 64, 1024, nullptr, 0, 0);
    else
        flash_attn<96, 2, false>((char*)sm, W_MQ + (size_t)qrow * 384 + h * 96, 384, W_MK + h * 96, 384, b, vb, 4, [](int kb) { return 2048 + kb * 64; }, scale,
                                 W_CAT + (size_t)qrow * 1024 + 768 + h * 64, 1024, nullptr, 0, 0);
}
__device__ __forceinline__ void na_unit(const Params& p, int l, int u, bool isctx, float* sm) {
    if (!isctx) {
        const int b = u >> 7, h = (u >> 5) & 3, r = u & 31;
        const int rs = min(max(r - 4, 0), 24);
        float* rpbs = sm + 9216;
        __syncthreads();
        for (int i = TIDX; i < 15 * 31; i += 256) rpbs[i] = W_na_rpb[(size_t)(l * 4 + h) * 465 + i] * 1.4426950408889634f;
        const int qrow = b * 2048 + r * 64;
        flash_attn<64, 1, true>((char*)sm, W_NQ + (size_t)qrow * 256 + h * 64, 256, W_NK + h * 64, 256, b, W_NVT + (size_t)((b * 4 + h) * 64) * 2304, 12,
                                [rs](int kb) { return kb < 8 ? (rs + kb) * 64 : 2048 + (kb - 8) * 64; }, 0.125f * 1.4426950408889634f,
                                W_CAT + (size_t)qrow * 1024 + 512 + h * 64, 1024, rpbs, r, rs);
    } else {
        const int b = u >> 4, h = (u >> 2) & 3, qb = u & 3;
        const int qrow = NLAT + b * 256 + qb * 64;
        flash_attn<64, 1, false>((char*)sm, W_NQ + (size_t)qrow * 256 + h * 64, 256, W_NK + h * 64, 256, b, W_NVT + (size_t)((b * 4 + h) * 64) * 2304, 4,
                                 [](int kb) { return 2048 + kb * 64; }, 0.125f * 1.4426950408889634f, W_CAT + (size_t)qrow * 1024 + 512 + h * 64, 1024, nullptr, 0, 0);
    }
}

__device__ __forceinline__ void hgrn_local_unit(const Params& p, int l, int u, float* sm) {
    const int tid = TIDX;
    const int b = u / 144, h = (u / 36) & 3, cid = u % 36;
    const int row0 = cid < 4 ? NLAT + b * 256 + cid * 64 : b * 2048 + (cid - 4) * 64;
    float* B0 = sm;
    char* VT = (char*)(sm + 4352);
    char* KB = (char*)(sm + 6656);
    float* B2 = sm + 8960;
    float* B3 = sm + 13312;
    float* SC = sm + 17408;
    const int lane_ = tid & 63, w_ = tid >> 6, r16 = lane_ & 15, q4 = lane_ >> 4;
    const int k = tid & 63, seg = tid >> 6;
    const int ti = tid >> 4, ts = tid & 15;
    float acc[4][4];
#pragma unroll
    for (int a = 0; a < 4; a++)
#pragma unroll
        for (int c = 0; c < 4; c++) acc[a][c] = 0.f;
    __syncthreads();
    {
        const int s_ = tid >> 2, c0 = (tid & 3) * 16;
        const bf16_t* src = W_P + (size_t)(row0 + s_) * DIN + C_HI + h * 64 + c0;
        const u32x4 v0 = *(const u32x4*)src, v1 = *(const u32x4*)(src + 8);
#pragma unroll
        for (int j = 0; j < 4; j++) {
            *(bf16_t*)(VT + (c0 + 2 * j) * 144 + s_ * 2) = (bf16_t)(v0[j] & 0xFFFFu);
            *(bf16_t*)(VT + (c0 + 2 * j + 1) * 144 + s_ * 2) = (bf16_t)(v0[j] >> 16);
            *(bf16_t*)(VT + (c0 + 8 + 2 * j) * 144 + s_ * 2) = (bf16_t)(v1[j] & 0xFFFFu);
            *(bf16_t*)(VT + (c0 + 8 + 2 * j + 1) * 144 + s_ * 2) = (bf16_t)(v1[j] >> 16);
        }
    }
    float qv[16];
#pragma unroll
    for (int j = 0; j < 16; j++) qv[j] = bf2f(W_P[(size_t)(row0 + seg * 16 + j) * DIN + C_HQ + h * 64 + k]);
#pragma unroll
    for (int j = 0; j < 4; j++) *(float4*)&B0[k * 68 + seg * 16 + 4 * j] = make_float4(qv[4 * j], qv[4 * j + 1], qv[4 * j + 2], qv[4 * j + 3]);
#pragma unroll 1
    for (int dir = 0; dir < 2; dir++) {
        const int zoff = dir ? C_ZB : C_ZF;
        const float lbv = W_LB[(l * 2 + dir) * 256 + h * 64 + k];
        const size_t ud = (size_t)u * 2 + dir;
        float bl[16], kkv[16];
#pragma unroll
        for (int j = 0; j < 16; j++) {
            float z = bf2f(W_P[(size_t)(row0 + seg * 16 + j) * DIN + zoff + h * 64 + k]);
            z = fminf(fmaxf(z, -20.f), 20.f);
            const float e_ = __expf(-z);
            const float sg = 1.f / (1.f + e_);
            const float f = lbv + (1.f - lbv) * sg;
            bl[j] = __log2f(f);
            kkv[j] = (1.f - lbv) * (e_ * sg);
        }
        float tot;
        if (dir == 0) {
#pragma unroll
            for (int j = 1; j < 16; j++) bl[j] += bl[j - 1];
            tot = bl[15];
        } else {
#pragma unroll
            for (int j = 14; j >= 0; j--) bl[j] += bl[j + 1];
            tot = bl[0];
        }
        SC[seg * 64 + k] = tot;
        __syncthreads();
        float off = 0.f;
#pragma unroll
        for (int s2 = 0; s2 < 4; s2++) if (dir ? (s2 > seg) : (s2 < seg)) off += SC[s2 * 64 + k];
        const float btot = SC[k] + SC[64 + k] + SC[128 + k] + SC[192 + k];
#pragma unroll
        for (int j = 0; j < 16; j++) bl[j] += off;
#pragma unroll
        for (int j = 0; j < 4; j++) {
            const float Rj = dir ? bl[4 * j] : bl[4 * j + 3];
            *(float4*)&B2[k * 68 + seg * 16 + 4 * j] = make_float4(kkv[4 * j] * __builtin_amdgcn_exp2f(Rj - bl[4 * j]), kkv[4 * j + 1] * __builtin_amdgcn_exp2f(Rj - bl[4 * j + 1]),
                                                                   kkv[4 * j + 2] * __builtin_amdgcn_exp2f(Rj - bl[4 * j + 2]), kkv[4 * j + 3] * __builtin_amdgcn_exp2f(Rj - bl[4 * j + 3]));
            *(float4*)&B3[k * 64 + seg * 16 + 4 * j] = make_float4(bl[4 * j], bl[4 * j + 1], bl[4 * j + 2], bl[4 * j + 3]);
#pragma unroll
            for (int jj = 0; jj < 4; jj++)
                ((bf16_t*)W_HQ)[(ud * 64 + seg * 16 + 4 * j + jj) * 64 + k] = f2bf(qv[4 * j + jj] * __builtin_amdgcn_exp2f(bl[4 * j + jj]));
        }
        if (seg == 0) W_HD[ud * 64 + k] = __builtin_amdgcn_exp2f(btot);
        {
            u32x4 k0, k1;
#pragma unroll
            for (int j = 0; j < 4; j++) {
                k0[j] = pack2bf(kkv[2 * j] * __builtin_amdgcn_exp2f(btot - bl[2 * j]), kkv[2 * j + 1] * __builtin_amdgcn_exp2f(btot - bl[2 * j + 1]));
                k1[j] = pack2bf(kkv[8 + 2 * j] * __builtin_amdgcn_exp2f(btot - bl[8 + 2 * j]), kkv[8 + 2 * j + 1] * __builtin_amdgcn_exp2f(btot - bl[8 + 2 * j + 1]));
            }
            *(u32x4*)(KB + k * 144 + seg * 32) = k0;
            *(u32x4*)(KB + k * 144 + seg * 32 + 16) = k1;
        }
        __syncthreads();
        const bool active = dir ? (ts >= ti) : (ts <= ti);
        if (active) {
            float a2[4][4];
#pragma unroll
            for (int a = 0; a < 4; a++)
#pragma unroll
                for (int c = 0; c < 4; c++) a2[a][c] = 0.f;
#pragma unroll 2
            for (int kk_ = 0; kk_ < 64; kk_++) {
                const float4 q4 = *(const float4*)&B0[kk_ * 68 + ti * 4];
                const float4 bq4 = *(const float4*)&B3[kk_ * 64 + ti * 4];
                const float4 k4 = *(const float4*)&B2[kk_ * 68 + ts * 4];
                const float4 bk4 = *(const float4*)&B3[kk_ * 64 + ts * 4];
                const float R = dir ? bk4.x : bk4.w;
                const float qr[4] = {q4.x * __builtin_amdgcn_exp2f(bq4.x - R), q4.y * __builtin_amdgcn_exp2f(bq4.y - R), q4.z * __builtin_amdgcn_exp2f(bq4.z - R), q4.w * __builtin_amdgcn_exp2f(bq4.w - R)};
                const float ka[4] = {k4.x, k4.y, k4.z, k4.w};
#pragma unroll
                for (int a = 0; a < 4; a++)
#pragma unroll
                    for (int c = 0; c < 4; c++) a2[a][c] += qr[a] * ka[c];
            }
#pragma unroll
            for (int a = 0; a < 4; a++)
#pragma unroll
                for (int c = 0; c < 4; c++) {
                    const int i_ = ti * 4 + a, s_ = ts * 4 + c;
                    const bool valid = dir ? (s_ >= i_) : (s_ <= i_);
                    acc[a][c] += valid ? a2[a][c] : 0.f;
                }
        }
        {
            f32x4 ua[4];
#pragma unroll
            for (int vt = 0; vt < 4; vt++) ua[vt] = (f32x4){0.f, 0.f, 0.f, 0.f};
#pragma unroll
            for (int ss_ = 0; ss_ < 2; ss_++) {
                const bf16x8 kbf = *(const bf16x8*)(KB + (w_ * 16 + r16) * 144 + ss_ * 64 + q4 * 16);
#pragma unroll
                for (int vt = 0; vt < 4; vt++) {
                    const bf16x8 vtf = *(const bf16x8*)(VT + (vt * 16 + r16) * 144 + ss_ * 64 + q4 * 16);
                    ua[vt] = __builtin_amdgcn_mfma_f32_16x16x32_bf16(vtf, kbf, ua[vt], 0, 0, 0);
                }
            }
#pragma unroll
            for (int vt = 0; vt < 4; vt++) st4bf((bf16_t*)W_HU + ud * 4096 + (w_ * 16 + r16) * 64 + vt * 16 + q4 * 4, make_float4(ua[vt][0], ua[vt][1], ua[vt][2], ua[vt][3]));
        }
    }
    __syncthreads();
    {
        char* AB = (char*)B2;
#pragma unroll
        for (int a2_ = 0; a2_ < 4; a2_++) {
            uint2 pk; pk.x = pack2bf(acc[a2_][0], acc[a2_][1]); pk.y = pack2bf(acc[a2_][2], acc[a2_][3]);
            *(uint2*)(AB + (ti * 4 + a2_) * 144 + ts * 8) = pk;
        }
        __syncthreads();
        f32x4 oa[4];
#pragma unroll
        for (int vt = 0; vt < 4; vt++) oa[vt] = (f32x4){0.f, 0.f, 0.f, 0.f};
#pragma unroll
        for (int ss_ = 0; ss_ < 2; ss_++) {
            const bf16x8 abf = *(const bf16x8*)(AB + (w_ * 16 + r16) * 144 + ss_ * 64 + q4 * 16);
#pragma unroll
            for (int vt = 0; vt < 4; vt++) {
                const bf16x8 vtf = *(const bf16x8*)(VT + (vt * 16 + r16) * 144 + ss_ * 64 + q4 * 16);
                oa[vt] = __builtin_amdgcn_mfma_f32_16x16x32_bf16(vtf, abf, oa[vt], 0, 0, 0);
            }
        }
#pragma unroll
        for (int vt = 0; vt < 4; vt++) *(f32x4*)&W_OF[(size_t)(row0 + w_ * 16 + r16) * 256 + h * 64 + vt * 16 + q4 * 4] = oa[vt];
    }
}

__device__ __forceinline__ void hgrn_scan_unit(const Params& p, int l, int u) {
    const int tid = TIDX;
    const int bh = u >> 5, dir = (u >> 4) & 1, sl = u & 15;
    const int ubase = bh * 36;
    const int e = sl * 256 + tid;
    const int kq = e >> 6;
    const bf16_t* HUb = (const bf16_t*)W_HU; const float* HDb = W_HD; bf16_t* SPb = (bf16_t*)W_SP;
    float S = 0.f;
#pragma unroll 6
    for (int n = 0; n < 36; n++) {
        const int cn = dir == 0 ? n : (n < 4 ? 3 - n : 39 - n);
        const size_t ud = (size_t)(ubase + cn) * 2 + dir;
        SPb[ud * 4096 + e] = f2bf(S);
        S = S * HDb[ud * 64 + kq] + bf2f(HUb[ud * 4096 + e]);
    }
}
__device__ __forceinline__ void hgrn_final_unit(const Params& p, int l, int u, float* sm) {
    const int tid = TIDX, lane = tid & 63, w = tid >> 6, r16 = lane & 15, q4 = lane >> 4;
    const int b = u / 144, h = (u / 36) & 3, cid = u % 36;
    const int row0 = cid < 4 ? NLAT + b * 256 + cid * 64 : b * 2048 + (cid - 4) * 64;
    char* ST = (char*)sm;
    __syncthreads();
#pragma unroll
    for (int dir = 0; dir < 2; dir++) {
        const bf16_t* sp = (const bf16_t*)W_SP + ((size_t)u * 2 + dir) * 4096;
#pragma unroll
        for (int j = 0; j < 2; j++) {
            const int e8 = tid + 256 * j, kk_ = e8 >> 3, v0 = (e8 & 7) * 8;
            const u32x4 sv = *(const u32x4*)&sp[e8 * 8];
            char* dst = ST + dir * 9216 + kk_ * 2;
#pragma unroll
            for (int t = 0; t < 4; t++) {
                *(bf16_t*)(dst + (v0 + 2 * t) * 144) = (bf16_t)(sv[t] & 0xFFFFu);
                *(bf16_t*)(dst + (v0 + 2 * t + 1) * 144) = (bf16_t)(sv[t] >> 16);
            }
        }
    }
    const int row = row0 + w * 16 + r16;
    f32x4 oa[4];
#pragma unroll
    for (int vt = 0; vt < 4; vt++) oa[vt] = *(const f32x4*)&W_OF[(size_t)row * 256 + h * 64 + vt * 16 + q4 * 4];
    bf16x8 qd[2][2];
#pragma unroll
    for (int dir = 0; dir < 2; dir++)
#pragma unroll
        for (int ks = 0; ks < 2; ks++) qd[dir][ks] = *(const bf16x8*)((const bf16_t*)W_HQ + (((size_t)u * 2 + dir) * 64 + w * 16 + r16) * 64 + ks * 32 + q4 * 8);
    __syncthreads();
#pragma unroll
    for (int dir = 0; dir < 2; dir++)
#pragma unroll
        for (int ks = 0; ks < 2; ks++)
#pragma unroll
            for (int vt = 0; vt < 4; vt++) {
                const bf16x8 stf = *(const bf16x8*)(ST + dir * 9216 + (vt * 16 + r16) * 144 + ks * 64 + q4 * 16);
                oa[vt] = __builtin_amdgcn_mfma_f32_16x16x32_bf16(stf, qd[dir][ks], oa[vt], 0, 0, 0);
            }
    float ss = 0.f;
#pragma unroll
    for (int vt = 0; vt < 4; vt++) ss += oa[vt][0] * oa[vt][0] + oa[vt][1] * oa[vt][1] + oa[vt][2] * oa[vt][2] + oa[vt][3] * oa[vt][3];
    ss += __shfl_xor(ss, 16); ss += __shfl_xor(ss, 32);
    const float rs = rsqrtf(ss * (1.f / 64.f) + EPSF);
#pragma unroll
    for (int vt = 0; vt < 4; vt++) {
        const int v0 = vt * 16 + q4 * 4;
        const float4 g = *(const float4*)&W_hgrn_norm_g[l * 64 + v0];
        const float4 gt = ld4bf(&W_P[(size_t)row * DIN + C_HG + h * 64 + v0]);
        st4bf(&W_CAT[(size_t)row * 1024 + h * 64 + v0],
              make_float4(oa[vt][0] * rs * g.x * siluf_(gt.x), oa[vt][1] * rs * g.y * siluf_(gt.y), oa[vt][2] * rs * g.z * siluf_(gt.z), oa[vt][3] * rs * g.w * siluf_(gt.w)));
    }
}

template <int LL>
__device__ __forceinline__ void hyena_unit(const Params& p, int l, int b, int cp, float* sm) {
    constexpr int NT = LL / 256;
    float zprev[NT];
#pragma unroll 1
    for (int chh = 0; chh < 2; chh++) {
    const int c = cp * 2 + chh;
    constexpr bool isctx = (LL == 256);
    const int tid = TIDX;
    float* zs = sm;
    float* kc = sm + LL;
    const int rowbase = isctx ? NLAT + b * 256 : b * 2048;
    float z[NT], x1[NT], x2[NT];
#pragma unroll
    for (int i = 0; i < NT; i++) {
        const int t = tid + 256 * i;
        float val[3];
#pragma unroll
        for (int q = 0; q < 3; q++) {
            const int chn = q * 256 + c;
            const int col = C_HY + chn;
            const float um = t > 0 ? bf2f(W_P[(size_t)(rowbase + t - 1) * DIN + col]) : 0.f;
            const float u0 = bf2f(W_P[(size_t)(rowbase + t) * DIN + col]);
            const float up = t < LL - 1 ? bf2f(W_P[(size_t)(rowbase + t + 1) * DIN + col]) : 0.f;
            val[q] = W_hy_short_w[(l * 3 + 0) * 768 + chn] * um + W_hy_short_w[(l * 3 + 1) * 768 + chn] * u0 + W_hy_short_w[(l * 3 + 2) * 768 + chn] * up +
                     W_hy_short_b[l * 768 + chn];
        }
        z[i] = val[0]; x1[i] = val[1]; x2[i] = val[2];
    }
#pragma unroll
    for (int o = 0; o < 2; o++) {
        const float* kbase = W_HYKC + (size_t)((l * 2 + o) * 256 + c) * 2 * LL;
        __syncthreads();
        for (int i = tid; i < 2 * LL - 1; i += 256) { const int d = i - (LL - 1); kc[i] = d >= 0 ? kbase[d] : kbase[LL - d]; }
#pragma unroll
        for (int i = 0; i < NT; i++) zs[tid + 256 * i] = z[i];
        __syncthreads();
        float acc[NT];
#pragma unroll
        for (int i = 0; i < NT; i++) acc[i] = 0.f;
        for (int s = 0; s < LL; s++) {
            const float zv = zs[s];
#pragma unroll
            for (int i = 0; i < NT; i++) acc[i] += kc[(tid + 256 * i) - s + (LL - 1)] * zv;
        }
        const float dbv = W_hy_bias[(l * 2 + o) * 256 + c];
#pragma unroll
        for (int i = 0; i < NT; i++) z[i] = (o == 0 ? x1[i] : x2[i]) * (acc[i] + dbv * z[i]);
    }
    if (chh == 0) {
#pragma unroll
        for (int i = 0; i < NT; i++) zprev[i] = z[i];
    } else {
#pragma unroll
        for (int i = 0; i < NT; i++) *(unsigned*)&W_CAT[(size_t)(rowbase + tid + 256 * i) * 1024 + 256 + cp * 2] = pack2bf(zprev[i], z[i]);
    }
    }
}

__device__ __forceinline__ void hyena_fft_unit(const Params& p, int l, int bp, int cp, float* sm) {
    const int tid = TIDX;
    float2* fb = (float2*)sm;
    float* raw = sm + 8704;
    bf16_t* zp = (bf16_t*)(sm + 12808);
    float2* twl = (float2*)(sm + 14856);
    __syncthreads();
    { const float2* twg = W_TW;
#pragma unroll
      for (int i = 0; i < 4; i++) twl[tid + 256 * i] = twg[tid + 256 * i]; }
    if (tid < 2) { raw[tid * 2050] = 0.f; raw[tid * 2050 + 2049] = 0.f; }
#pragma unroll 1
    for (int chh = 0; chh < 2; chh++) {
        const int c = cp * 2 + chh;
        float z[2][8];
#pragma unroll 1
        for (int st = 0; st < 3; st++) {
            if (st > 0) {
                const int o = st - 1;
                float2 v[4][4];
#pragma unroll
                for (int r1 = 0; r1 < 4; r1++)
#pragma unroll
                    for (int r2 = 0; r2 < 4; r2++) v[r1][r2] = r1 < 2 ? make_float2(z[0][(r1 & 1) * 4 + r2], z[1][(r1 & 1) * 4 + r2]) : make_float2(0.f, 0.f);
                fft_fwd_pass<0>(v, tid, twl);
                fft_lds_write<0>(v, tid, fb);
                __syncthreads();
                const float2* ks = W_KSPEC + (size_t)((l * 2 + o) * 256 + c) * 4096 + tid * 16;
                float2 kv[16];
#pragma unroll
                for (int j = 0; j < 16; j++) kv[j] = ks[j];
                fft_lds_read<2>(v, tid, fb);
                fft_fwd_pass<2>(v, tid, twl);
                fft_lds_write<2>(v, tid, fb);
                __syncthreads();
                fft_lds_read<4>(v, tid, fb);
                fft_fwd_pass<4>(v, tid, twl);
#pragma unroll
                for (int r1 = 0; r1 < 4; r1++)
#pragma unroll
                    for (int r2 = 0; r2 < 4; r2++) v[r1][r2] = cmul(v[r1][r2], kv[r1 * 4 + r2]);
                fft_inv_pass<4>(v, tid, twl);
                fft_lds_write<4>(v, tid, fb);
                __syncthreads();
                fft_lds_read<2>(v, tid, fb);
                fft_inv_pass<2>(v, tid, twl);
                fft_lds_write<2>(v, tid, fb);
                __syncthreads();
                fft_lds_read<0>(v, tid, fb);
                fft_inv_pass<0>(v, tid, twl);
                const float dbv = W_hy_bias[(l * 2 + o) * 256 + c];
#pragma unroll
                for (int r1 = 0; r1 < 2; r1++)
#pragma unroll
                    for (int r2 = 0; r2 < 4; r2++) {
                        const int i = r1 * 4 + r2;
                        z[0][i] = v[r1][r2].x + dbv * z[0][i];
                        z[1][i] = v[r1][r2].y + dbv * z[1][i];
                    }
            }
            const int chn = st * 256 + c;
#pragma unroll 1
            for (int b2 = 0; b2 < 2; b2++)
#pragma unroll 4
                for (int i = 0; i < 8; i++) {
                    const int t = tid + 256 * i;
                    raw[b2 * 2050 + 1 + t] = bf2f(W_P[(size_t)((bp * 2 + b2) * 2048 + t) * DIN + C_HY + chn]);
                }
            __syncthreads();
            const float w0 = W_hy_short_w[(l * 3 + 0) * 768 + chn], w1 = W_hy_short_w[(l * 3 + 1) * 768 + chn], w2 = W_hy_short_w[(l * 3 + 2) * 768 + chn];
            const float sb = W_hy_short_b[l * 768 + chn];
#pragma unroll
            for (int b2 = 0; b2 < 2; b2++)
#pragma unroll
                for (int i = 0; i < 8; i++) {
                    const int t = tid + 256 * i;
                    const float val = w0 * raw[b2 * 2050 + t] + w1 * raw[b2 * 2050 + t + 1] + w2 * raw[b2 * 2050 + t + 2] + sb;
                    z[b2][i] = st == 0 ? val : val * z[b2][i];
                }
            __syncthreads();
        }
        if (chh == 0) {
#pragma unroll
            for (int b2 = 0; b2 < 2; b2++)
#pragma unroll
                for (int i = 0; i < 8; i++) zp[(b2 * 8 + i) * 256 + tid] = f2bf(z[b2][i]);
        } else {
#pragma unroll
            for (int b2 = 0; b2 < 2; b2++)
#pragma unroll
                for (int i = 0; i < 8; i++)
                    *(unsigned*)&W_CAT[(size_t)((bp * 2 + b2) * 2048 + tid + 256 * i) * 1024 + 256 + cp * 2] = ((unsigned)zp[(b2 * 8 + i) * 256 + tid] | ((unsigned)f2bf(z[b2][i]) << 16));
        }
    }
}

__device__ void phase_mix(const Params& p, int l, float* sm) {
    const bool need_ctx = l < DEPTH - 1;
    const int G = gridDim.x, bid = BIDX;
    for (int u = wq_next(WQ(p, l, 3), sm); u < 512; u = wq_next(WQ(p, l, 3), sm)) hyena_fft_unit(p, l, u >> 7, u & 127, sm);
    for (int u = wq_next(WQ(p, l, 13), sm); u < 1024; u = wq_next(WQ(p, l, 13), sm)) hgrn_scan_unit(p, l, u);
    for (int u = wq_next(WQ(p, l, 4), sm); u < 1024; u = wq_next(WQ(p, l, 4), sm)) na_unit(p, l, u, false, sm);
    if (need_ctx) {
        for (int u = wq_next(WQ(p, l, 5), sm); u < 128; u = wq_next(WQ(p, l, 5), sm)) na_unit(p, l, u, true, sm);
        for (int u = wq_next(WQ(p, l, 6), sm); u < 1024; u = wq_next(WQ(p, l, 6), sm)) hyena_unit<256>(p, l, u >> 7, u & 127, sm);
    }
}
__device__ void phase_mix2(const Params& p, int l, float* sm) {
    const bool need_ctx = l < DEPTH - 1;
    const int G = gridDim.x, bid = BIDX;
    for (int u = wq_next(WQ(p, l, 7), sm); u < 512; u = wq_next(WQ(p, l, 7), sm)) mla_unit(p, l, u, false, sm);
    for (int u = wq_next(WQ(p, l, 8), sm); u < 1152; u = wq_next(WQ(p, l, 8), sm)) { if (need_ctx || (u % 36) >= 4) hgrn_final_unit(p, l, u, sm); }
    if (need_ctx) for (int u = wq_next(WQ(p, l, 9), sm); u < 64; u = wq_next(WQ(p, l, 9), sm)) mla_unit(p, l, u, true, sm);
}

__device__ void phase_gemm2(const Params& p, int l, float* sm) {
    const int nrows = (l < DEPTH - 1) ? TT : NLAT;
    const float* W = p.w_out + (size_t)l * 1024 * 1024;
    const int tid = TIDX, lane = tid & 63, w = tid >> 6, wm = w >> 1, wn = w & 1, r16 = lane & 15, q = lane >> 4;
    for (int u = wq_next(WQ(p, l, 10), sm); u < (nrows / 128) * 8; u = wq_next(WQ(p, l, 10), sm)) {
        const int rb = u >> 3, cb = u & 7;
        const int r0 = rb * 128, n0 = cb * 128;
        const float* g1 = W_MOD + (size_t)(l * 9 + bidx_of(r0)) * 6144 + 2048;
        f32x4 acc[4][4];
        const bf16_t* cb_ = W_CAT + (size_t)r0 * 1024;
        const bf16_t* wb = W_WOUTT + (size_t)l * 1024 * 1024 + (size_t)n0 * 1024;
        gemm128_bt<true>(1024, (char*)sm, [&](int r) { return cb_ + (size_t)r * 1024; }, [&](int r) { return wb + (size_t)r * 1024; }, acc);
#pragma unroll
        for (int i = 0; i < 4; i++)
#pragma unroll
            for (int j = 0; j < 4; j++) {
                const int m = r0 + wm * 64 + i * 16 + r16, n = n0 + wn * 64 + j * 16 + q * 4;
                const float* xsrc = l > 0 ? &W_X[(size_t)m * 1024 + n] : (m < NLAT ? &p.x[(size_t)m * 1024 + n] : &p.ctx[(size_t)(m - NLAT) * 1024 + n]);
                float4 xv = *(const float4*)xsrc;
                const float4 g = *(const float4*)&g1[n];
                xv.x += g.x * acc[i][j][0]; xv.y += g.y * acc[i][j][1]; xv.z += g.z * acc[i][j][2]; xv.w += g.w * acc[i][j][3];
                *(float4*)&W_X[(size_t)m * 1024 + n] = xv;
            }
    }
}

__device__ void phase_norm2(const Params& p, int l, float* sm) {
    const int tid = TIDX, wave = tid >> 6, lane = tid & 63, r16 = lane & 15, kq = lane >> 4;
    const int nrows = (l < DEPTH - 1) ? TT : NLAT;
    float* red = sm;
    float* lg = sm + 64;
    for (int t16 = wq_next(WQ(p, l, 14), sm); t16 < nrows / 16; t16 = wq_next(WQ(p, l, 14), sm)) {
        const int row = t16 * 16 + r16;
        const int bi = bidx_of(t16 * 16);
        const int kb = wave * 256 + kq * 64;
        const float* xr = W_X + (size_t)row * 1024 + kb;
        float ss = 0.f;
#pragma unroll
        for (int i = 0; i < 16; i++) { const float4 v = *(const float4*)&xr[i * 4]; ss += v.x * v.x + v.y * v.y + v.z * v.z + v.w * v.w; }
        ss += __shfl_xor(ss, 16); ss += __shfl_xor(ss, 32);
        if (kq == 0) red[wave * 16 + r16] = ss;
        __syncthreads();
        const float rstd = rsqrtf((red[r16] + red[16 + r16] + red[32 + r16] + red[48 + r16]) * (1.f / 1024.f) + EPSF);
        const float* md = W_MOD + (size_t)(l * 9 + bi) * 6144 + kb;
        const float* gn = W_norm2_g + l * 1024 + kb;
        const float* we = W_moe_we + (size_t)(l * 1024 + kb) * 32 + r16;
        const float* wg = W_moe_wg + (size_t)(l * 1024 + kb) * 4 + (r16 & 3);
        bf16_t* hr = W_H + (size_t)row * 1024 + kb;
        f32x4 a0 = (f32x4){0.f, 0.f, 0.f, 0.f}, a1 = a0, a2 = a0;
#pragma unroll 2
        for (int i = 0; i < 16; i++) {
            const float4 xq = *(const float4*)&xr[i * 4];
            const float4 g = *(const float4*)&gn[i * 4];
            const float4 sh = *(const float4*)&md[3072 + i * 4];
            const float4 sc = *(const float4*)&md[4096 + i * 4];
            float h[4];
            h[0] = xq.x * rstd * g.x * (1.f + sc.x) + sh.x; h[1] = xq.y * rstd * g.y * (1.f + sc.y) + sh.y;
            h[2] = xq.z * rstd * g.z * (1.f + sc.z) + sh.z; h[3] = xq.w * rstd * g.w * (1.f + sc.w) + sh.w;
            st4bf(hr + i * 4, make_float4(h[0], h[1], h[2], h[3]));
#pragma unroll
            for (int e = 0; e < 4; e++) {
                const int k = i * 4 + e;
                const float b0 = we[k * 32], b1 = we[k * 32 + 16];
                const float b2 = r16 < 4 ? wg[k * 4] : 0.f;
                a0 = __builtin_amdgcn_mfma_f32_16x16x4f32(h[e], b0, a0, 0, 0, 0);
                a1 = __builtin_amdgcn_mfma_f32_16x16x4f32(h[e], b1, a1, 0, 0, 0);
                a2 = __builtin_amdgcn_mfma_f32_16x16x4f32(h[e], b2, a2, 0, 0, 0);
            }
        }
        float* lw = lg + wave * 768;
#pragma unroll
        for (int e = 0; e < 4; e++) {
            lw[(kq * 4 + e) * 48 + r16] = a0[e];
            lw[(kq * 4 + e) * 48 + 16 + r16] = a1[e];
            lw[(kq * 4 + e) * 48 + 32 + r16] = a2[e];
        }
        __syncthreads();
        if (tid < 16) {
            const float* L0 = lg + tid * 48;
            const int rrow = t16 * 16 + tid;
            float gl[4];
#pragma unroll
            for (int c = 0; c < 4; c++) gl[c] = L0[32 + c] + L0[768 + 32 + c] + L0[1536 + 32 + c] + L0[2304 + 32 + c] + W_moe_bg[l * 4 + c];
            int gs = 0; float best = gl[0];
#pragma unroll
            for (int c = 1; c < 4; c++) if (gl[c] > best) { best = gl[c]; gs = c; }
            float den = 0.f;
#pragma unroll
            for (int c = 0; c < 4; c++) den += expf(gl[c] - best);
            const float psel = 1.f / den;
            float le[8];
#pragma unroll
            for (int i = 0; i < 8; i++) { const int c = gs * 8 + i; le[i] = L0[c] + L0[768 + c] + L0[1536 + c] + L0[2304 + c] + W_moe_be[l * 32 + c]; }
            int i1 = 0; float v1 = le[0];
#pragma unroll
            for (int i = 1; i < 8; i++) if (le[i] > v1) { v1 = le[i]; i1 = i; }
            int i2 = -1; float v2 = -3.0e38f;
#pragma unroll
            for (int i = 0; i < 8; i++) if (i != i1 && le[i] > v2) { v2 = le[i]; i2 = i; }
            const float e2 = expf(v2 - v1);
            const float w1 = psel / (1.f + e2), w2 = psel * e2 / (1.f + e2);
            const int ea = gs * 8 + i1, eb = gs * 8 + i2;
            const int n0 = rrow * 2, n1 = rrow * 2 + 1;
            W_EW[n0] = w1; W_EW[n1] = w2;
            const int pa = atomicAdd(&W_cnt[l * 32 + ea], 1);
            W_LIST[(size_t)ea * TT + pa] = n0;
            const int pb = atomicAdd(&W_cnt[l * 32 + eb], 1);
            W_LIST[(size_t)eb * TT + pb] = n1;
        }
    }
}

__device__ void phase_moe1(const Params& p, int l, float* sm) {
    int* offs = (int*)(sm + 16384);
    int* ns = (int*)(sm + 16384 + 64);
    const int tid = TIDX, lane = tid & 63, w = tid >> 6, wm = w >> 1, wn = w & 1, r16 = lane & 15, q = lane >> 4;
    __syncthreads();
    if (tid == 0) { int a = 0; for (int e = 0; e < 32; e++) { offs[e] = a; a += (W_cnt[l * 32 + e] + 127) >> 7; } offs[32] = a; }
    __syncthreads();
    const int total = offs[32] * 8;
    for (int u = wq_next(WQ(p, l, 11), sm); u < total; u = wq_next(WQ(p, l, 11), sm)) {
        const int rbg = u >> 3, cb = u & 7;
        int e = 0;
        while (offs[e + 1] <= rbg) e++;
        const int rbi = rbg - offs[e];
        const int ce = W_cnt[l * 32 + e];
        __syncthreads();
        if (tid < 128) { const int idx = rbi * 128 + tid; ns[tid] = idx < ce ? W_LIST[(size_t)e * TT + idx] : -1; }
        __syncthreads();
        const int j0 = cb * 64;
        const bf16_t* hb = W_H;
        const int c = tid & 127;
        const int hid = j0 + (c >> 6) * 32 + ((c >> 4) & 1) * 16 + (c & 15);
        const float* wp = (((c >> 4) & 3) >= 2 ? p.moe_w_up : p.moe_w_gate) + (size_t)(l * 32 + e) * 1024 * 512 + hid;
        f32x4 acc[4][4];
        gemm128_main<true>(1024, (char*)sm, [&](int r) { return hb + (size_t)(max(ns[r], 0) >> 1) * 1024; },
                           [&](int k, int n) { return wp[(size_t)k * 512]; }, acc);
#pragma unroll
        for (int i = 0; i < 4; i++) {
            const int n = ns[wm * 64 + i * 16 + r16];
            if (n >= 0) {
#pragma unroll
                for (int j = 0; j < 2; j++) {
                    const int hh = j0 + wn * 32 + j * 16 + q * 4;
                    float4 a;
                    a.x = siluf_(acc[i][j][0]) * acc[i][j + 2][0]; a.y = siluf_(acc[i][j][1]) * acc[i][j + 2][1];
                    a.z = siluf_(acc[i][j][2]) * acc[i][j + 2][2]; a.w = siluf_(acc[i][j][3]) * acc[i][j + 2][3];
                    st4bf(&W_ACT[(size_t)n * 512 + hh], a);
                }
            }
        }
    }
}
__device__ void phase_moe2(const Params& p, int l, float* sm) {
    int* offs = (int*)(sm + 16384);
    int* ns = (int*)(sm + 16384 + 64);
    const int tid = TIDX, lane = tid & 63, w = tid >> 6, wm = w >> 1, wn = w & 1, r16 = lane & 15, q = lane >> 4;
    __syncthreads();
    if (tid == 0) { int a = 0; for (int e = 0; e < 32; e++) { offs[e] = a; a += (W_cnt[l * 32 + e] + 127) >> 7; } offs[32] = a; }
    __syncthreads();
    const int total = offs[32] * 8;
    for (int u = wq_next(WQ(p, l, 12), sm); u < total; u = wq_next(WQ(p, l, 12), sm)) {
        const int rbg = u >> 3, cb = u & 7;
        int e = 0;
        while (offs[e + 1] <= rbg) e++;
        const int rbi = rbg - offs[e];
        const int ce = W_cnt[l * 32 + e];
        __syncthreads();
        if (tid < 128) { const int idx = rbi * 128 + tid; ns[tid] = idx < ce ? W_LIST[(size_t)e * TT + idx] : -1; }
        __syncthreads();
        const int n0 = cb * 128;
        const bf16_t* ab_ = W_ACT;
        const float* wp = p.moe_w_down + (size_t)(l * 32 + e) * 512 * 1024 + n0 + (tid & 127);
        f32x4 acc[4][4];
        gemm128_main<true>(512, (char*)sm, [&](int r) { return ab_ + (size_t)max(ns[r], 0) * 512; }, [&](int k, int n) { return wp[(size_t)k * 1024]; }, acc);
#pragma unroll
        for (int i = 0; i < 4; i++) {
            const int n = ns[wm * 64 + i * 16 + r16];
            if (n >= 0) {
                const float wt = W_EW[n];
#pragma unroll
                for (int j = 0; j < 4; j++) {
                    const int col = n0 + wn * 64 + j * 16 + q * 4;
                    st4bf(&W_YEXP[(size_t)n * 1024 + col], make_float4(acc[i][j][0] * wt, acc[i][j][1] * wt, acc[i][j][2] * wt, acc[i][j][3] * wt));
                }
            }
        }
    }
}

enum { PH_PRO1 = 0, PH_PRO2, PH_NORM1, PH_GEMM1, PH_PREP, PH_MIX, PH_HGOUT, PH_GEMM2, PH_NORM2, PH_MOE1, PH_MOE2, PH_FINAL };

template <int PH>
__device__ __forceinline__ void run_phase(const Params& p, int l, float* sm) {
    if (PH == PH_PRO1) phase_pro1(p, sm);
    else if (PH == PH_PRO2) phase_pro2(p, sm);
    else if (PH == PH_NORM1) phase_norm1(p, l, sm);
    else if (PH == PH_GEMM1) phase_gemm1(p, l, sm);
    else if (PH == PH_PREP) phase_prep(p, l, sm);
    else if (PH == PH_MIX) phase_mix(p, l, sm);
    else if (PH == PH_HGOUT) phase_mix2(p, l, sm);
    else if (PH == PH_GEMM2) phase_gemm2(p, l, sm);
    else if (PH == PH_NORM2) phase_norm2(p, l, sm);
    else if (PH == PH_MOE1) phase_moe1(p, l, sm);
    else if (PH == PH_MOE2) phase_moe2(p, l, sm);
    else if (PH == PH_FINAL) phase_final(p, sm);
}

#if !MEGA
template <int PH>
__global__ void __launch_bounds__(256, 2) k_phase(Params p, int l) {
    __shared__ float sm[SMF];
    run_phase<PH>(p, l, sm);
}
#else
__global__ void __launch_bounds__(256, 2) k_mega(Params p) {
    __shared__ float sm[SMF];
    __shared__ uint4 xb_words;
    if (TIDX == 0) xb_words = make_uint4(0u, 0u, 0u, 0u);
    __syncthreads();
    if (threadIdx.x == 0) ((int*)sm)[SMF - 2] = 0;
    __syncthreads();
    XcdBarrier bar = xcd_barrier_post(W_bar, (volatile LAS unsigned*)&xb_words);
#if USE_CG
#define xcd_barrier(b) cooperative_groups::this_grid().sync()
#endif
    for (int r = 0; r < p.rep[PH_PRO1]; r++) { if (threadIdx.x == 0) ((int*)sm)[SMF - 2] = r; __syncthreads(); run_phase<PH_PRO1>(p, 0, sm); xcd_barrier(bar); }
    for (int r = 0; r < p.rep[PH_PRO2]; r++) { if (threadIdx.x == 0) ((int*)sm)[SMF - 2] = r; __syncthreads(); run_phase<PH_PRO2>(p, 0, sm); xcd_barrier(bar); }
    for (int l = 0; l < DEPTH; l++) {
        if (threadIdx.x == 0) ((int*)sm)[SMF - 2] = 0; __syncthreads(); run_phase<PH_NORM1>(p, l, sm); xcd_barrier(bar);
        for (int r = 0; r < p.rep[PH_GEMM1]; r++) { if (threadIdx.x == 0) ((int*)sm)[SMF - 2] = r; __syncthreads(); run_phase<PH_GEMM1>(p, l, sm); xcd_barrier(bar); }
        for (int r = 0; r < p.rep[PH_PREP]; r++) { if (threadIdx.x == 0) ((int*)sm)[SMF - 2] = r; __syncthreads(); run_phase<PH_PREP>(p, l, sm); xcd_barrier(bar); }
        for (int r = 0; r < p.rep[PH_MIX]; r++) { if (threadIdx.x == 0) ((int*)sm)[SMF - 2] = r; __syncthreads(); run_phase<PH_MIX>(p, l, sm); xcd_barrier(bar); }
        for (int r = 0; r < p.rep[PH_HGOUT]; r++) { if (threadIdx.x == 0) ((int*)sm)[SMF - 2] = r; __syncthreads(); run_phase<PH_HGOUT>(p, l, sm); xcd_barrier(bar); }
        if (threadIdx.x == 0) ((int*)sm)[SMF - 2] = 0; __syncthreads(); run_phase<PH_GEMM2>(p, l, sm); xcd_barrier(bar);
        run_phase<PH_NORM2>(p, l, sm); xcd_barrier(bar);
        for (int r = 0; r < p.rep[PH_MOE1]; r++) { if (threadIdx.x == 0) ((int*)sm)[SMF - 2] = r; __syncthreads(); run_phase<PH_MOE1>(p, l, sm); xcd_barrier(bar); }
        for (int r = 0; r < p.rep[PH_MOE2]; r++) { if (threadIdx.x == 0) ((int*)sm)[SMF - 2] = r; __syncthreads(); run_phase<PH_MOE2>(p, l, sm); xcd_barrier(bar); }
    }
    run_phase<PH_FINAL>(p, 0, sm);
}
#endif

static inline size_t align_up(size_t v, size_t a) { return (v + a - 1) / a * a; }

extern "C" void kernel_launch(void* const* d_in, const int* in_sizes, int n_in, void* d_out, int out_size, void* d_ws, size_t ws_size,
                              hipStream_t stream) {
    Params p{};
    const float* const* in = (const float* const*)d_in;
    p.x = in[0]; p.c = in[1]; p.ctx = in[2]; p.c_ctx = in[3]; p.w_ada = in[4]; p.b_ada = in[5]; p.norm1_g = in[6]; p.norm2_g = in[7];
    p.w_in = in[8]; p.w_out = in[9]; p.lb_logits = in[10]; p.hgrn_norm_g = in[11];
    p.hy_short_w = in[12]; p.hy_short_b = in[13]; p.hy_w1 = in[14]; p.hy_b1 = in[15]; p.hy_freq = in[16]; p.hy_w2 = in[17]; p.hy_b2 = in[18];
    p.hy_w3 = in[19]; p.hy_b3 = in[20]; p.hy_decay = in[21]; p.hy_bias = in[22];
    p.na_rpb = in[23]; p.na_q_g = in[24]; p.na_k_g = in[25];
    p.mla_q_a_g = in[26]; p.mla_kv_a_g = in[27]; p.mla_w_uq = in[28]; p.mla_w_ukv = in[29]; p.mla_q_g = in[30]; p.mla_k_g = in[31];
    p.moe_wg = in[32]; p.moe_bg = in[33]; p.moe_we = in[34]; p.moe_be = in[35]; p.moe_w_gate = in[36]; p.moe_w_up = in[37]; p.moe_w_down = in[38];
    p.out = (float*)d_out;
    for (int i = 0; i < 16; i++) p.rep[i] = 1;
#ifdef PROBE_PH
    p.rep[PROBE_PH] = 2;
#endif
#ifdef PROBE_PH2
    p.rep[PROBE_PH2] = 2;
#endif

    p.ws = (char*)d_ws;
    const size_t off = WS_TOTAL;
    if (off > ws_size) { fprintf(stderr, "workspace too small: need %zu have %zu\n", off, ws_size); return; }

#if !MEGA
#ifndef BIGMASK
#define BIGMASK 0xFFF
#endif
#define GR(ph) (((BIGMASK >> (ph)) & 1) ? 1024 : 256)
    k_phase<PH_PRO1><<<GR(PH_PRO1), 256, 0, stream>>>(p, 0);
    k_phase<PH_PRO2><<<GR(PH_PRO2), 256, 0, stream>>>(p, 0);
    for (int l = 0; l < DEPTH; l++) {
        k_phase<PH_NORM1><<<GR(PH_NORM1), 256, 0, stream>>>(p, l);
        k_phase<PH_GEMM1><<<GR(PH_GEMM1), 256, 0, stream>>>(p, l);
        k_phase<PH_PREP><<<GR(PH_PREP), 256, 0, stream>>>(p, l);
        k_phase<PH_MIX><<<GR(PH_MIX), 256, 0, stream>>>(p, l);
        k_phase<PH_HGOUT><<<GR(PH_HGOUT), 256, 0, stream>>>(p, l);
        k_phase<PH_GEMM2><<<GR(PH_GEMM2), 256, 0, stream>>>(p, l);
        k_phase<PH_NORM2><<<GR(PH_NORM2), 256, 0, stream>>>(p, l);
        k_phase<PH_MOE1><<<GR(PH_MOE1), 256, 0, stream>>>(p, l);
        k_phase<PH_MOE2><<<GR(PH_MOE2), 256, 0, stream>>>(p, l);
    }
    k_phase<PH_FINAL><<<GR(PH_FINAL), 256, 0, stream>>>(p, 0);
#else
    static int grid = 0;
    if (!grid) {
        int dev = 0, cus = 0, per_cu = 0;
        hipGetDevice(&dev);
        hipDeviceGetAttribute(&cus, hipDeviceAttributeMultiprocessorCount, dev);
        hipOccupancyMaxActiveBlocksPerMultiprocessor(&per_cu, k_mega, 256, 0);
        if (per_cu > 2) per_cu = 2;
        if (per_cu < 1) per_cu = 1;
        grid = cus * per_cu;
    }
    hipMemsetAsync(p.ws + OFF_bar, 0, (XCD_BAR_WORDS + WQ_WORDS) * sizeof(unsigned), stream);
#if USE_CG
    { void* args[] = {&p}; hipLaunchCooperativeKernel((void*)k_mega, dim3(grid), dim3(256), args, 0, stream); }
#else
    k_mega<<<grid, 256, 0, stream>>>(p);
#endif
#endif
}
```

```cpp
#include <hip/hip_runtime.h>
#include <stdint.h>
#include <stdio.h>
#include <hip/hip_cooperative_groups.h>
#define USE_CG 0

#ifndef MEGA
#define MEGA 1
#endif

#define DM 1024
#define NB 8
#define SEQ 2048
#define CTXL 256
#define NLAT (NB * SEQ)
#define NCTX (NB * CTXL)
#define TT (NLAT + NCTX)
#define DIN 3232
#define DEPTH 4
#define EPSF 1e-6f
#define C_HQ 0
#define C_ZF 256
#define C_ZB 512
#define C_HI 768
#define C_HG 1024
#define C_HY 1280
#define C_NA 2048
#define C_CQ 2816
#define C_CKV 3072
#define C_KR 3200

#define SMF 17920

typedef unsigned short bf16_t;

struct Params {
    const float *x, *c, *ctx, *c_ctx, *w_ada, *b_ada, *norm1_g, *norm2_g, *w_in, *w_out, *lb_logits, *hgrn_norm_g;
    const float *hy_short_w, *hy_short_b, *hy_w1, *hy_b1, *hy_freq, *hy_w2, *hy_b2, *hy_w3, *hy_b3, *hy_decay, *hy_bias;
    const float *na_rpb, *na_q_g, *na_k_g, *mla_q_a_g, *mla_kv_a_g, *mla_w_uq, *mla_w_ukv, *mla_q_g, *mla_k_g;
    const float *moe_wg, *moe_bg, *moe_we, *moe_be, *moe_w_gate, *moe_w_up, *moe_w_down;
    float* out;
    char* ws;
    int rep[16];
};

#define XB_TMO      128
#define XB_XCNT(j)  (256  + 64 * (j))
#define XB_XSUB(j)  (1280 + 64 * (j))
#define XB_XGEN(j)  (2304 + 64 * (j))
#define XB_TOP      3328
#define XB_TOPGEN   3392
#define XCD_BAR_WORDS 3456
#define XB_SPIN_CAP (1u << 22)
#define LAS __attribute__((address_space(3)))

__device__ __forceinline__ unsigned xb_ld(unsigned* p)              { return __hip_atomic_load(p, __ATOMIC_RELAXED, __HIP_MEMORY_SCOPE_AGENT); }
__device__ __forceinline__ unsigned xb_add(unsigned* p, unsigned v) { return __hip_atomic_fetch_add(p, v, __ATOMIC_RELAXED, __HIP_MEMORY_SCOPE_AGENT); }
__device__ __forceinline__ unsigned xb_xcc_id() { return (unsigned)__builtin_amdgcn_s_getreg((3 << 11) | 20) & 0xFu; }
#define XB_SPIN(cond, bar) do { unsigned _sp = 0; while (cond) { __builtin_amdgcn_s_sleep(1); \
    if ((++_sp & 255u) == 0u) { if (xb_ld(&(bar)[XB_TMO])) break; if (_sp > XB_SPIN_CAP) { atomicAdd(&(bar)[XB_TMO], 1u); break; } } } } while (0)

struct XcdBarrier { unsigned* bar; unsigned x; volatile LAS unsigned* st; };

__device__ __forceinline__ XcdBarrier xcd_barrier_post(unsigned* bar, volatile LAS unsigned* st) {
    XcdBarrier b; b.bar = bar; b.x = xb_xcc_id(); b.st = st;
    if (threadIdx.x == 0) (void)xb_add(&bar[XB_XCNT(b.x)], 1u);
    return b;
}
__device__ __forceinline__ void xcd_barrier_complete(unsigned* bar, unsigned x, unsigned& nloc, unsigned& nx) {
    const unsigned G = gridDim.x * gridDim.y * gridDim.z;
    unsigned sum, cnt, mine, sp = 0u;
    for (;;) {
        sum = 0u; cnt = 0u; mine = 0u;
#pragma unroll
        for (unsigned j = 0; j < 16; ++j) { const unsigned c = xb_ld(&bar[XB_XCNT(j)]); sum += c; cnt += (c > 0u) ? 1u : 0u; mine = (j == x) ? c : mine; }
        if (sum == G) break;
        __builtin_amdgcn_s_sleep(1);
        if ((++sp & 255u) == 0u) { if (xb_ld(&bar[XB_TMO])) break; if (sp > XB_SPIN_CAP) { atomicAdd(&bar[XB_TMO], 1u); break; } }
    }
    nloc = mine > 0u ? mine : 1u; nx = cnt > 0u ? cnt : 1u;
}
__device__ __forceinline__ void xcd_barrier(const XcdBarrier& b) {
    asm volatile("s_waitcnt vmcnt(0)" ::: "memory");
    __syncthreads();
    if (threadIdx.x == 0) {
        unsigned* bar = b.bar;
        __builtin_amdgcn_s_waitcnt(0);
        unsigned nloc = b.st[0], nx = b.st[1];
        if (nloc == 0u) { xcd_barrier_complete(bar, b.x, nloc, nx); b.st[0] = nloc; b.st[1] = nx; }
        const unsigned old = xb_add(&bar[XB_XSUB(b.x)], 1u);
        const unsigned gen = old / nloc;
        if (old + 1u == (gen + 1u) * nloc) {
            __builtin_amdgcn_fence(__ATOMIC_RELEASE, "agent");
            asm volatile("s_waitcnt vmcnt(0)" ::: "memory");
            const unsigned og = xb_add(&bar[XB_TOP], 1u);
            const unsigned tg = og / nx;
            if (og + 1u == (tg + 1u) * nx) xb_add(&bar[XB_TOPGEN], 1u);
            else XB_SPIN(xb_ld(&bar[XB_TOPGEN]) == tg, bar);
            __builtin_amdgcn_fence(__ATOMIC_ACQUIRE, "agent");
            xb_add(&bar[XB_XGEN(b.x)], 1u);
            asm volatile("s_waitcnt vmcnt(0)" ::: "memory");
        } else {
            XB_SPIN(xb_ld(&bar[XB_XGEN(b.x)]) == gen, bar);
            __builtin_amdgcn_fence(__ATOMIC_ACQUIRE, "agent");
            asm volatile("s_waitcnt vmcnt(0)" ::: "memory");
        }
    }
    __syncthreads();
}

__device__ __forceinline__ int tid_opaque() { int t = threadIdx.x; asm volatile("" : "+v"(t)); return t; }
__device__ __forceinline__ int bid_opaque() { int t = blockIdx.x; asm volatile("" : "+s"(t)); return t; }
#define TIDX tid_opaque()
#define BIDX bid_opaque()
typedef __attribute__((ext_vector_type(8))) short bf16x8;
typedef __attribute__((ext_vector_type(4))) float f32x4;
typedef __attribute__((ext_vector_type(4))) unsigned u32x4;
typedef __attribute__((ext_vector_type(2))) __bf16 bf16x2_t;
__device__ __forceinline__ bf16_t f2bf(float f) { return __builtin_bit_cast(bf16_t, (__bf16)f); }
__device__ __forceinline__ float bf2f(bf16_t h) { return __uint_as_float(((unsigned)h) << 16); }
__device__ __forceinline__ unsigned pack2bf(float a, float b) { bf16x2_t v; v[0] = (__bf16)a; v[1] = (__bf16)b; return __builtin_bit_cast(unsigned, v); }
__device__ __forceinline__ float4 ld4bf(const bf16_t* p) { const uint2 u = *(const uint2*)p; float4 r; r.x = __uint_as_float(u.x << 16); r.y = __uint_as_float(u.x & 0xFFFF0000u); r.z = __uint_as_float(u.y << 16); r.w = __uint_as_float(u.y & 0xFFFF0000u); return r; }
__device__ __forceinline__ void st4bf(bf16_t* p, float4 v) { uint2 u; u.x = pack2bf(v.x, v.y); u.y = pack2bf(v.z, v.w); *(uint2*)p = u; }
__device__ __forceinline__ float wave_sum(float v) {
#pragma unroll
    for (int o = 32; o > 0; o >>= 1) v += __shfl_xor(v, o);
    return v;
}
__device__ __forceinline__ float sigmoidf_(float z) { return 1.f / (1.f + __expf(-z)); }
__device__ __forceinline__ float siluf_(float z) { return z / (1.f + __expf(-z)); }
__device__ __forceinline__ int bidx_of(int row) { return row < NLAT ? (row >> 11) : 8; }
__device__ __forceinline__ int kv_pos(int kidx) { const int w = kidx & 31; return (kidx & ~31) | (((w >> 2) & 3) * 8 + (w >> 4) * 4 + (w & 3)); }

__device__ __forceinline__ float block_sum(float v, float* red) {
    v = wave_sum(v);
    __syncthreads();
    if ((TIDX & 63) == 0) red[TIDX >> 6] = v;
    __syncthreads();
    float r = red[0] + red[1] + red[2] + red[3];
    __syncthreads();
    return r;
}

typedef __attribute__((address_space(1))) char gchar_t;
__device__ __forceinline__ gchar_t* ws_opaque(char* w) { gchar_t* g = (gchar_t*)w; asm volatile("" : "+s"(g)); return g; }
#define WQ_SLOTS 32
#define WQ_WORDS ((DEPTH + 1) * WQ_SLOTS * 16)
constexpr size_t ws_al(size_t v) { return (v + 255) / 256 * 256; }
#define WSB(p) ws_opaque((p).ws)
constexpr size_t OFF_bar = 0;
constexpr size_t OFF_cnt = ws_al(OFF_bar + ((XCD_BAR_WORDS + WQ_WORDS) * 4));
constexpr size_t OFF_X = ws_al(OFF_cnt + (DEPTH * 32 * 4));
constexpr size_t OFF_MOD = ws_al(OFF_X + ((size_t)TT * 1024 * 4));
constexpr size_t OFF_LB = ws_al(OFF_MOD + ((size_t)DEPTH * 9 * 6144 * 4));
constexpr size_t OFF_HDN = ws_al(OFF_LB + (DEPTH * 512 * 4));
constexpr size_t OFF_TW = ws_al(OFF_HDN + ((size_t)DEPTH * 2 * 2048 * 64 * 4));
constexpr size_t OFF_KSPEC = ws_al(OFF_TW + (4096 * 8));
constexpr size_t OFF_HYKC = ws_al(OFF_KSPEC + ((size_t)DEPTH * 2 * 256 * 4096 * 8));
constexpr size_t OFF_H = ws_al(OFF_HYKC + ((size_t)DEPTH * 2 * 256 * 2 * 256 * 4));
constexpr size_t OFF_P = ws_al(OFF_H + ((size_t)TT * 1024 * 2));
constexpr size_t OFF_OF = ws_al(OFF_P + ((size_t)TT * DIN * 2));
constexpr size_t OFF_HU = ws_al(OFF_OF + ((size_t)TT * 256 * 4));
constexpr size_t OFF_HQ = ws_al(OFF_HU + ((size_t)1152 * 2 * 4096 * 4));
constexpr size_t OFF_HD = ws_al(OFF_HQ + ((size_t)1152 * 2 * 4096 * 4));
constexpr size_t OFF_NQ = ws_al(OFF_HD + ((size_t)1152 * 2 * 64 * 4));
constexpr size_t OFF_NK = ws_al(OFF_NQ + ((size_t)TT * 256 * 2));
constexpr size_t OFF_NVT = ws_al(OFF_NK + ((size_t)TT * 256 * 2));
constexpr size_t OFF_MQ = ws_al(OFF_NVT + ((size_t)NB * 4 * 64 * 2304 * 2));
constexpr size_t OFF_MK = ws_al(OFF_MQ + ((size_t)TT * 384 * 2));
constexpr size_t OFF_MVT = ws_al(OFF_MK + ((size_t)TT * 384 * 2));
constexpr size_t OFF_CAT = ws_al(OFF_MVT + ((size_t)NB * 4 * 64 * 2304 * 2));
constexpr size_t OFF_EW = ws_al(OFF_CAT + ((size_t)TT * 1024 * 2));
constexpr size_t OFF_LIST = ws_al(OFF_EW + ((size_t)TT * 2 * 4));
constexpr size_t OFF_ACT = ws_al(OFF_LIST + ((size_t)32 * TT * 4));
constexpr size_t OFF_YEXP = ws_al(OFF_ACT + ((size_t)TT * 2 * 512 * 2));
constexpr size_t OFF_norm1_g = ws_al(OFF_YEXP + ((size_t)TT * 2 * 1024 * 4));
constexpr size_t OFF_norm2_g = ws_al(OFF_norm1_g + ((size_t)(DEPTH * 1024) * 4));
constexpr size_t OFF_hgrn_norm_g = ws_al(OFF_norm2_g + ((size_t)(DEPTH * 1024) * 4));
constexpr size_t OFF_hy_short_w = ws_al(OFF_hgrn_norm_g + ((size_t)(DEPTH * 64) * 4));
constexpr size_t OFF_hy_short_b = ws_al(OFF_hy_short_w + ((size_t)(DEPTH * 3 * 768) * 4));
constexpr size_t OFF_hy_bias = ws_al(OFF_hy_short_b + ((size_t)(DEPTH * 768) * 4));
constexpr size_t OFF_na_rpb = ws_al(OFF_hy_bias + ((size_t)(DEPTH * 2 * 256) * 4));
constexpr size_t OFF_na_q_g = ws_al(OFF_na_rpb + ((size_t)(DEPTH * 4 * 15 * 31) * 4));
constexpr size_t OFF_na_k_g = ws_al(OFF_na_q_g + ((size_t)(DEPTH * 64) * 4));
constexpr size_t OFF_mla_q_a_g = ws_al(OFF_na_k_g + ((size_t)(DEPTH * 64) * 4));
constexpr size_t OFF_mla_kv_a_g = ws_al(OFF_mla_q_a_g + ((size_t)(DEPTH * 256) * 4));
constexpr size_t OFF_mla_w_uq = ws_al(OFF_mla_kv_a_g + ((size_t)(DEPTH * 128) * 4));
constexpr size_t OFF_mla_w_ukv = ws_al(OFF_mla_w_uq + ((size_t)(DEPTH * 256 * 384) * 4));
constexpr size_t OFF_mla_q_g = ws_al(OFF_mla_w_ukv + ((size_t)(DEPTH * 128 * 512) * 4));
constexpr size_t OFF_mla_k_g = ws_al(OFF_mla_q_g + ((size_t)(DEPTH * 96) * 4));
constexpr size_t OFF_moe_wg = ws_al(OFF_mla_k_g + ((size_t)(DEPTH * 96) * 4));
constexpr size_t OFF_moe_bg = ws_al(OFF_moe_wg + ((size_t)(DEPTH * 1024 * 4) * 4));
constexpr size_t OFF_moe_we = ws_al(OFF_moe_bg + ((size_t)(DEPTH * 4) * 4));
constexpr size_t OFF_moe_be = ws_al(OFF_moe_we + ((size_t)(DEPTH * 1024 * 32) * 4));
constexpr size_t OFF_WUQT = ws_al(OFF_moe_be + ((size_t)(DEPTH * 32) * 4));
constexpr size_t OFF_WUKVT = ws_al(OFF_WUQT + (size_t)DEPTH * 384 * 256 * 2);
constexpr size_t OFF_ROPE = ws_al(OFF_WUKVT + (size_t)DEPTH * 512 * 128 * 2);
constexpr size_t OFF_SP = ws_al(OFF_ROPE + (size_t)2048 * 16 * 8);
constexpr size_t OFF_WINT = ws_al(OFF_SP + (size_t)1152 * 2 * 4096 * 4);
constexpr size_t OFF_WOUTT = ws_al(OFF_WINT + (size_t)DEPTH * DIN * 1024 * 2);
constexpr size_t OFF_HYT = ws_al(OFF_WOUTT + (size_t)DEPTH * 1024 * 1024 * 2);
constexpr size_t WS_TOTAL = ws_al(OFF_HYT + (size_t)NB * 768 * 2048 * 2);
#define W_HYT ((bf16_t*)(WSB(p) + OFF_HYT))
#define W_WINT ((bf16_t*)(WSB(p) + OFF_WINT))
#define W_WOUTT ((bf16_t*)(WSB(p) + OFF_WOUTT))
#define W_SP ((float*)(WSB(p) + OFF_SP))
#define W_WUQT ((bf16_t*)(WSB(p) + OFF_WUQT))
#define W_WUKVT ((bf16_t*)(WSB(p) + OFF_WUKVT))
#define W_ROPE ((float2*)(WSB(p) + OFF_ROPE))
#define W_bar ((unsigned*)(WSB(p) + OFF_bar))
#define W_cnt ((int*)(WSB(p) + OFF_cnt))
#define W_X ((float*)(WSB(p) + OFF_X))
#define W_MOD ((float*)(WSB(p) + OFF_MOD))
#define W_LB ((float*)(WSB(p) + OFF_LB))
#define W_HDN ((float*)(WSB(p) + OFF_HDN))
#define W_TW ((float2*)(WSB(p) + OFF_TW))
#define W_KSPEC ((float2*)(WSB(p) + OFF_KSPEC))
#define W_HYKC ((float*)(WSB(p) + OFF_HYKC))
#define W_H ((bf16_t*)(WSB(p) + OFF_H))
#define W_P ((bf16_t*)(WSB(p) + OFF_P))
#define W_OF ((float*)(WSB(p) + OFF_OF))
#define W_HU ((float*)(WSB(p) + OFF_HU))
#define W_HQ ((float*)(WSB(p) + OFF_HQ))
#define W_HD ((float*)(WSB(p) + OFF_HD))
#define W_NQ ((bf16_t*)(WSB(p) + OFF_NQ))
#define W_NK ((bf16_t*)(WSB(p) + OFF_NK))
#define W_NVT ((bf16_t*)(WSB(p) + OFF_NVT))
#define W_MQ ((bf16_t*)(WSB(p) + OFF_MQ))
#define W_MK ((bf16_t*)(WSB(p) + OFF_MK))
#define W_MVT ((bf16_t*)(WSB(p) + OFF_MVT))
#define W_CAT ((bf16_t*)(WSB(p) + OFF_CAT))
#define W_EW ((float*)(WSB(p) + OFF_EW))
#define W_LIST ((int*)(WSB(p) + OFF_LIST))
#define W_ACT ((bf16_t*)(WSB(p) + OFF_ACT))
#define W_YEXP ((bf16_t*)(WSB(p) + OFF_YEXP))
#define W_wq (W_bar + XCD_BAR_WORDS)
#define W_norm1_g ((const float*)(WSB(p) + OFF_norm1_g))
#define W_norm2_g ((const float*)(WSB(p) + OFF_norm2_g))
#define W_hgrn_norm_g ((const float*)(WSB(p) + OFF_hgrn_norm_g))
#define W_hy_short_w ((const float*)(WSB(p) + OFF_hy_short_w))
#define W_hy_short_b ((const float*)(WSB(p) + OFF_hy_short_b))
#define W_hy_bias ((const float*)(WSB(p) + OFF_hy_bias))
#define W_na_rpb ((const float*)(WSB(p) + OFF_na_rpb))
#define W_na_q_g ((const float*)(WSB(p) + OFF_na_q_g))
#define W_na_k_g ((const float*)(WSB(p) + OFF_na_k_g))
#define W_mla_q_a_g ((const float*)(WSB(p) + OFF_mla_q_a_g))
#define W_mla_kv_a_g ((const float*)(WSB(p) + OFF_mla_kv_a_g))
#define W_mla_w_uq ((const float*)(WSB(p) + OFF_mla_w_uq))
#define W_mla_w_ukv ((const float*)(WSB(p) + OFF_mla_w_ukv))
#define W_mla_q_g ((const float*)(WSB(p) + OFF_mla_q_g))
#define W_mla_k_g ((const float*)(WSB(p) + OFF_mla_k_g))
#define W_moe_wg ((const float*)(WSB(p) + OFF_moe_wg))
#define W_moe_bg ((const float*)(WSB(p) + OFF_moe_bg))
#define W_moe_we ((const float*)(WSB(p) + OFF_moe_we))
#define W_moe_be ((const float*)(WSB(p) + OFF_moe_be))

__device__ __forceinline__ int wq_next(unsigned* ctr, float* sm) {
    int* slot = (int*)(sm + SMF - 1);
    __syncthreads();
    if (TIDX == 0) *slot = (int)__hip_atomic_fetch_add(ctr, 1u, __ATOMIC_RELAXED, __HIP_MEMORY_SCOPE_AGENT);
    __syncthreads();
    return *slot;
}
#define WQ(p, l, site) (W_wq + (((l) + 1) * WQ_SLOTS + (site) + 16 * ((const int*)sm)[SMF - 2]) * 16)
template <class FA, class FB, class FE>
__device__ __forceinline__ void gemm_tile_f32(int K, float* sm, FA fa, FB fb, FE fe) {
    float* As = sm;
    float* Bs = sm + 16 * 68;
    const int tid = TIDX, tx = tid & 15, ty = tid >> 4;
    float acc[4][4];
#pragma unroll
    for (int a = 0; a < 4; a++)
#pragma unroll
        for (int b = 0; b < 4; b++) acc[a][b] = 0.f;
    for (int k0 = 0; k0 < K; k0 += 16) {
#pragma unroll
        for (int q = 0; q < 4; q++) { int e = tid + 256 * q; int i = e >> 4, kk = e & 15; As[kk * 68 + i] = fa(i, k0 + kk); }
#pragma unroll
        for (int q = 0; q < 4; q++) { int e = tid + 256 * q; int kk = e >> 6, j = e & 63; Bs[kk * 68 + j] = fb(k0 + kk, j); }
        __syncthreads();
#pragma unroll
        for (int kk = 0; kk < 16; kk++) {
            float4 a4 = *(const float4*)&As[kk * 68 + ty * 4];
            float4 b4 = *(const float4*)&Bs[kk * 68 + tx * 4];
            float av[4] = {a4.x, a4.y, a4.z, a4.w}, bv[4] = {b4.x, b4.y, b4.z, b4.w};
#pragma unroll
            for (int a = 0; a < 4; a++)
#pragma unroll
                for (int b = 0; b < 4; b++) acc[a][b] += av[a] * bv[b];
        }
        __syncthreads();
    }
#pragma unroll
    for (int a = 0; a < 4; a++)
#pragma unroll
        for (int b = 0; b < 4; b++) fe(ty * 4 + a, tx * 4 + b, acc[a][b]);
}


#define GEMM_LOAD(k0) { _Pragma("unroll") for (int i_ = 0; i_ < 4; i_++) ra[i_] = *(const u32x4*)(ap[i_] + (k0)); \
    _Pragma("unroll") for (int i_ = 0; i_ < 4; i_++) _Pragma("unroll") for (int j_ = 0; j_ < 8; j_++) rb[i_][j_] = bload((k0) + (bkg + 2 * i_) * 8 + j_, bn); }
#define GEMM_WRITE(buf) { char* As_ = smc + (buf) * 16384; char* Bs_ = smc + 32768 + (buf) * 16384; \
    _Pragma("unroll") for (int i_ = 0; i_ < 4; i_++) *(u32x4*)(As_ + (arow + 32 * i_) * 128 + ((ac ^ (arow & 7)) * 16)) = ra[i_]; \
    _Pragma("unroll") for (int i_ = 0; i_ < 4; i_++) { u32x4 b_; b_[0] = pack2bf(rb[i_][0], rb[i_][1]); b_[1] = pack2bf(rb[i_][2], rb[i_][3]); \
        b_[2] = pack2bf(rb[i_][4], rb[i_][5]); b_[3] = pack2bf(rb[i_][6], rb[i_][7]); \
        *(u32x4*)(Bs_ + bn * 128 + (((bkg + 2 * i_) ^ (bn & 7)) * 16)) = b_; } }
template <bool SWAP, class FA, class FB>
__device__ __forceinline__ void gemm128_main(int K, char* smc, FA arowp, FB bload, f32x4 (&acc)[4][4]) {
    const int tid = TIDX, lane = tid & 63, w = tid >> 6;
    const int wm = w >> 1, wn = w & 1, r16 = lane & 15, q = lane >> 4;
#pragma unroll
    for (int i = 0; i < 4; i++)
#pragma unroll
        for (int j = 0; j < 4; j++) acc[i][j] = (f32x4){0.f, 0.f, 0.f, 0.f};
    const int arow = tid >> 3, ac = tid & 7;
    const int bn = tid & 127, bkg = tid >> 7;
    const bf16_t* ap[4];
#pragma unroll
    for (int i = 0; i < 4; i++) ap[i] = arowp(arow + 32 * i) + ac * 8;
    u32x4 ra[4];
    float rb[4][8];
    GEMM_LOAD(0)
    __syncthreads();
    GEMM_WRITE(0)
    __syncthreads();
    const int KT = K >> 6;
    for (int kt = 0; kt < KT; kt++) {
        const bool more = (kt + 1 < KT);
        if (more) GEMM_LOAD((kt + 1) * 64)
        const char* As = smc + (kt & 1) * 16384;
        const char* Bs = smc + 32768 + (kt & 1) * 16384;
#pragma unroll
        for (int ks = 0; ks < 2; ks++) {
            bf16x8 af[4], bfr[4];
            const int sw = ((ks * 4 + q) ^ (r16 & 7)) * 16;
#pragma unroll
            for (int i = 0; i < 4; i++) af[i] = *(const bf16x8*)(As + (wm * 64 + i * 16 + r16) * 128 + sw);
#pragma unroll
            for (int j = 0; j < 4; j++) bfr[j] = *(const bf16x8*)(Bs + (wn * 64 + j * 16 + r16) * 128 + sw);
            __builtin_amdgcn_s_setprio(1);
#pragma unroll
            for (int i = 0; i < 4; i++)
#pragma unroll
                for (int j = 0; j < 4; j++)
                    acc[i][j] = SWAP ? __builtin_amdgcn_mfma_f32_16x16x32_bf16(bfr[j], af[i], acc[i][j], 0, 0, 0)
                                     : __builtin_amdgcn_mfma_f32_16x16x32_bf16(af[i], bfr[j], acc[i][j], 0, 0, 0);
            __builtin_amdgcn_s_setprio(0);
        }
        if (more) GEMM_WRITE((kt + 1) & 1)
        __syncthreads();
    }
}

#define GEMMBT_LOAD(k0) { _Pragma("unroll") for (int i_ = 0; i_ < 4; i_++) { ra[i_] = *(const u32x4*)(ap[i_] + (k0)); rbv[i_] = *(const u32x4*)(bp[i_] + (k0)); } }
#define GEMMBT_WRITE(buf) { char* As_ = smc + (buf) * 16384; char* Bs_ = smc + 32768 + (buf) * 16384; \
    _Pragma("unroll") for (int i_ = 0; i_ < 4; i_++) { *(u32x4*)(As_ + (arow + 32 * i_) * 128 + ((ac ^ (arow & 7)) * 16)) = ra[i_]; \
                                                      *(u32x4*)(Bs_ + (arow + 32 * i_) * 128 + ((ac ^ (arow & 7)) * 16)) = rbv[i_]; } }
#define GEMMBT_LOADS(k0, RA, RB) { _Pragma("unroll") for (int i_ = 0; i_ < 4; i_++) { RA[i_] = *(const u32x4*)(ap[i_] + (k0)); RB[i_] = *(const u32x4*)(bp[i_] + (k0)); } }
#define GEMMBT_WRITES(buf, RA, RB) { char* As_ = smc + (buf) * 16384; char* Bs_ = smc + 32768 + (buf) * 16384; \
    _Pragma("unroll") for (int i_ = 0; i_ < 4; i_++) { *(u32x4*)(As_ + (arow + 32 * i_) * 128 + ((ac ^ (arow & 7)) * 16)) = RA[i_]; \
                                                      *(u32x4*)(Bs_ + (arow + 32 * i_) * 128 + ((ac ^ (arow & 7)) * 16)) = RB[i_]; } }
#define GEMMBT_COMPUTE(buf) { const char* As = smc + (buf) * 16384; const char* Bs = smc + 32768 + (buf) * 16384; \
    _Pragma("unroll") for (int ks = 0; ks < 2; ks++) { bf16x8 af[4], bfr[4]; const int sw = ((ks * 4 + q) ^ (r16 & 7)) * 16; \
        _Pragma("unroll") for (int i = 0; i < 4; i++) af[i] = *(const bf16x8*)(As + (wm * 64 + i * 16 + r16) * 128 + sw); \
        _Pragma("unroll") for (int j = 0; j < 4; j++) bfr[j] = *(const bf16x8*)(Bs + (wn * 64 + j * 16 + r16) * 128 + sw); \
        __builtin_amdgcn_s_setprio(1); \
        _Pragma("unroll") for (int i = 0; i < 4; i++) _Pragma("unroll") for (int j = 0; j < 4; j++) \
            acc[i][j] = SWAP ? __builtin_amdgcn_mfma_f32_16x16x32_bf16(bfr[j], af[i], acc[i][j], 0, 0, 0) \
                             : __builtin_amdgcn_mfma_f32_16x16x32_bf16(af[i], bfr[j], acc[i][j], 0, 0, 0); \
        __builtin_amdgcn_s_setprio(0); } }
template <bool SWAP, class FA, class FBR>
__device__ __forceinline__ void gemm128_bt(int K, char* smc, FA arowp, FBR browp, f32x4 (&acc)[4][4]) {
    const int tid = TIDX, lane = tid & 63, w = tid >> 6;
    const int wm = w >> 1, wn = w & 1, r16 = lane & 15, q = lane >> 4;
#pragma unroll
    for (int i = 0; i < 4; i++)
#pragma unroll
        for (int j = 0; j < 4; j++) acc[i][j] = (f32x4){0.f, 0.f, 0.f, 0.f};
    const int arow = tid >> 3, ac = tid & 7;
    const bf16_t* ap[4];
    const bf16_t* bp[4];
#pragma unroll
    for (int i = 0; i < 4; i++) { ap[i] = arowp(arow + 32 * i) + ac * 8; bp[i] = browp(arow + 32 * i) + ac * 8; }
    u32x4 ra0[4], rb0[4], ra1[4], rb1[4];
    GEMMBT_LOADS(0, ra0, rb0)
    GEMMBT_LOADS(64, ra1, rb1)
    __syncthreads();
    GEMMBT_WRITES(0, ra0, rb0)
    __syncthreads();
    const int KT = K >> 6;
    for (int kt = 0; kt < KT; kt += 2) {
        if (kt + 2 < KT) GEMMBT_LOADS((kt + 2) * 64, ra0, rb0)
        GEMMBT_COMPUTE(0)
        GEMMBT_WRITES(1, ra1, rb1)
        __syncthreads();
        if (kt + 3 < KT) GEMMBT_LOADS((kt + 3) * 64, ra1, rb1)
        GEMMBT_COMPUTE(1)
        if (kt + 2 < KT) GEMMBT_WRITES(0, ra0, rb0)
        __syncthreads();
    }
}

#define FFT_PHYS(pos) ((pos) + ((pos) >> 4))
__device__ __forceinline__ float2 cmul(float2 a, float2 b) { return make_float2(a.x * b.x - a.y * b.y, a.x * b.y + a.y * b.x); }
__device__ __forceinline__ float2 cmulc(float2 a, float2 b) { return make_float2(a.x * b.x + a.y * b.y, a.y * b.x - a.x * b.y); }
__device__ __forceinline__ void dft4f(float2& a0, float2& a1, float2& a2, float2& a3) {
    const float2 t0 = make_float2(a0.x + a2.x, a0.y + a2.y), t1 = make_float2(a0.x - a2.x, a0.y - a2.y);
    const float2 t2 = make_float2(a1.x + a3.x, a1.y + a3.y), t3 = make_float2(a1.x - a3.x, a1.y - a3.y);
    a0 = make_float2(t0.x + t2.x, t0.y + t2.y);
    a1 = make_float2(t1.x + t3.y, t1.y - t3.x);
    a2 = make_float2(t0.x - t2.x, t0.y - t2.y);
    a3 = make_float2(t1.x - t3.y, t1.y + t3.x);
}
__device__ __forceinline__ void dft4i(float2& a0, float2& a1, float2& a2, float2& a3) {
    const float2 t0 = make_float2(a0.x + a2.x, a0.y + a2.y), t1 = make_float2(a0.x - a2.x, a0.y - a2.y);
    const float2 t2 = make_float2(a1.x + a3.x, a1.y + a3.y), t3 = make_float2(a1.x - a3.x, a1.y - a3.y);
    a0 = make_float2(t0.x + t2.x, t0.y + t2.y);
    a1 = make_float2(t1.x - t3.y, t1.y + t3.x);
    a2 = make_float2(t0.x - t2.x, t0.y - t2.y);
    a3 = make_float2(t1.x + t3.y, t1.y - t3.x);
}
template <int S> struct FftGeo { static constexpr int Ns = 4096 >> (2 * S), Ms = Ns / 4, Ms1 = Ms / 4; };
template <int S>
__device__ __forceinline__ int fft_phys_base(int tid) {
    if (S == 0) return tid + (tid >> 4);
    if (S == 2) return (tid >> 4) * 272 + (tid & 15);
    return tid * 17;
}
template <int S>
__device__ __forceinline__ constexpr int fft_phys_off(int r1, int r2) {
    return S == 0 ? 272 * (r1 * 4 + r2) : (S == 2 ? 68 * r1 + 17 * r2 : 4 * r1 + r2);
}
template <int S>
__device__ __forceinline__ void fft_fwd_pass(float2 (&v)[4][4], int tid, const float2* __restrict__ TW) {
    const int jp = tid % FftGeo<S>::Ms1;
#pragma unroll
    for (int r2 = 0; r2 < 4; r2++) {
        dft4f(v[0][r2], v[1][r2], v[2][r2], v[3][r2]);
        const float2 w = TW[((jp + r2 * FftGeo<S>::Ms1) << (2 * S)) & 4095];
        const float2 w2 = cmul(w, w), w3 = cmul(w2, w);
        v[1][r2] = cmul(v[1][r2], w); v[2][r2] = cmul(v[2][r2], w2); v[3][r2] = cmul(v[3][r2], w3);
    }
    if (S < 4) {
        const float2 w = TW[(jp << (2 * S + 2)) & 4095];
        const float2 w2 = cmul(w, w), w3 = cmul(w2, w);
#pragma unroll
        for (int q1 = 0; q1 < 4; q1++) {
            dft4f(v[q1][0], v[q1][1], v[q1][2], v[q1][3]);
            v[q1][1] = cmul(v[q1][1], w); v[q1][2] = cmul(v[q1][2], w2); v[q1][3] = cmul(v[q1][3], w3);
        }
    } else {
#pragma unroll
        for (int q1 = 0; q1 < 4; q1++) dft4f(v[q1][0], v[q1][1], v[q1][2], v[q1][3]);
    }
}
template <int S>
__device__ __forceinline__ void fft_inv_pass(float2 (&v)[4][4], int tid, const float2* __restrict__ TW) {
    const int jp = tid % FftGeo<S>::Ms1;
    if (S < 4) {
        const float2 w = TW[(jp << (2 * S + 2)) & 4095];
        const float2 w2 = cmul(w, w), w3 = cmul(w2, w);
#pragma unroll
        for (int q1 = 0; q1 < 4; q1++) {
            v[q1][1] = cmulc(v[q1][1], w); v[q1][2] = cmulc(v[q1][2], w2); v[q1][3] = cmulc(v[q1][3], w3);
            dft4i(v[q1][0], v[q1][1], v[q1][2], v[q1][3]);
        }
    } else {
#pragma unroll
        for (int q1 = 0; q1 < 4; q1++) dft4i(v[q1][0], v[q1][1], v[q1][2], v[q1][3]);
    }
#pragma unroll
    for (int r2 = 0; r2 < 4; r2++) {
        const float2 w = TW[((jp + r2 * FftGeo<S>::Ms1) << (2 * S)) & 4095];
        const float2 w2 = cmul(w, w), w3 = cmul(w2, w);
        v[1][r2] = cmulc(v[1][r2], w); v[2][r2] = cmulc(v[2][r2], w2); v[3][r2] = cmulc(v[3][r2], w3);
        dft4i(v[0][r2], v[1][r2], v[2][r2], v[3][r2]);
    }
}
template <int S>
__device__ __forceinline__ void fft_lds_read(float2 (&v)[4][4], int tid, const float2* fb) {
    const float2* fbb = fb + fft_phys_base<S>(tid);
#pragma unroll
    for (int r1 = 0; r1 < 4; r1++)
#pragma unroll
        for (int r2 = 0; r2 < 4; r2++) v[r1][r2] = fbb[fft_phys_off<S>(r1, r2)];
}
template <int S>
__device__ __forceinline__ void fft_lds_write(const float2 (&v)[4][4], int tid, float2* fb) {
    float2* fbb = fb + fft_phys_base<S>(tid);
#pragma unroll
    for (int r1 = 0; r1 < 4; r1++)
#pragma unroll
        for (int r2 = 0; r2 < 4; r2++) fbb[fft_phys_off<S>(r1, r2)] = v[r1][r2];
}

__device__ void phase_pro1(const Params& p, float* sm) {
    const int tid = TIDX, nth = blockDim.x * gridDim.x, gtid = BIDX * blockDim.x + tid;
    for (int i = gtid; i < DEPTH * 32; i += nth) W_cnt[i] = 0;
    for (int i = gtid; i < 4096; i += nth) { float sn, cs; sincospif((float)i * (1.f / 2048.f), &sn, &cs); W_TW[i] = make_float2(cs, -sn); }
    for (int i = gtid; i < 512; i += nth) {
        float z0 = p.lb_logits[i], z1 = p.lb_logits[512 + i], z2 = p.lb_logits[1024 + i], z3 = p.lb_logits[1536 + i];
        float m = fmaxf(fmaxf(z0, z1), fmaxf(z2, z3));
        float e0 = expf(z0 - m), e1 = expf(z1 - m), e2 = expf(z2 - m), e3 = expf(z3 - m);
        float inv = 1.f / (e0 + e1 + e2 + e3);
        W_LB[i] = 0.f; W_LB[512 + i] = e1 * inv; W_LB[1024 + i] = (e1 + e2) * inv; W_LB[1536 + i] = (e1 + e2 + e3) * inv;
    }
    for (int i = gtid; i < DEPTH * 384 * 256; i += nth) {
        const int k = i & 255, n = (i >> 8) % 384, ll = i / (384 * 256);
        ((bf16_t*)(p.ws + OFF_WUQT))[i] = f2bf(p.mla_q_a_g[ll * 256 + k] * p.mla_w_uq[(size_t)(ll * 256 + k) * 384 + n]);
    }
    for (int i = gtid; i < DEPTH * 512 * 128; i += nth) {
        const int k = i & 127, n = (i >> 7) & 511, ll = i >> 16;
        ((bf16_t*)(p.ws + OFF_WUKVT))[i] = f2bf(p.mla_kv_a_g[ll * 128 + k] * p.mla_w_ukv[(size_t)(ll * 128 + k) * 512 + n]);
    }
    for (int i = gtid; i < 2048 * 16; i += nth) {
        const int t = i >> 4, j = i & 15;
        const float pos = j < 8 ? (float)(t >> 6) : (float)(t & 63);
        const float inv = expf(-9.210340371976184f * (float)(j & 7) * 0.125f);
        float sn, cs;
        sincosf(pos * inv, &sn, &cs);
        ((float2*)(p.ws + OFF_ROPE))[i] = make_float2(cs, sn);
    }
    {
        const int NT_IN = DEPTH * 16 * 51, NT_OUT = DEPTH * 16 * 16;
        for (int u = wq_next(WQ(p, -1, 2), sm); u < NT_IN + NT_OUT; u = wq_next(WQ(p, -1, 2), sm)) {
            const float* src; bf16_t* dst; int N, kt, nt;
            if (u < NT_IN) { const int ll = u / (16 * 51), r = u % (16 * 51); kt = r / 51; nt = r % 51; N = DIN; src = p.w_in + (size_t)ll * 1024 * DIN; dst = (bf16_t*)(p.ws + OFF_WINT) + (size_t)ll * DIN * 1024; }
            else { const int v = u - NT_IN; const int ll = v >> 8, r = v & 255; kt = r >> 4; nt = r & 15; N = 1024; src = p.w_out + (size_t)ll * 1024 * 1024; dst = (bf16_t*)(p.ws + OFF_WOUTT) + (size_t)ll * 1024 * 1024; }
#pragma unroll
            for (int i = 0; i < 4; i++) {
                const int idx = tid + 256 * i, kr = idx >> 4, c4 = idx & 15;
                const int n = nt * 64 + c4 * 4;
                float4 v = make_float4(0.f, 0.f, 0.f, 0.f);
                if (n < N) v = *(const float4*)&src[(size_t)(kt * 64 + kr) * N + n];
                sm[kr * 68 + c4 * 4 + 0] = v.x; sm[kr * 68 + c4 * 4 + 1] = v.y; sm[kr * 68 + c4 * 4 + 2] = v.z; sm[kr * 68 + c4 * 4 + 3] = v.w;
            }
            __syncthreads();
#pragma unroll
            for (int i = 0; i < 2; i++) {
                const int idx = tid + 256 * i, nr = idx >> 3, c8 = idx & 7;
                const int n = nt * 64 + nr;
                if (n < N) {
                    u32x4 o;
                    o[0] = pack2bf(sm[(c8 * 8 + 0) * 68 + nr], sm[(c8 * 8 + 1) * 68 + nr]); o[1] = pack2bf(sm[(c8 * 8 + 2) * 68 + nr], sm[(c8 * 8 + 3) * 68 + nr]);
                    o[2] = pack2bf(sm[(c8 * 8 + 4) * 68 + nr], sm[(c8 * 8 + 5) * 68 + nr]); o[3] = pack2bf(sm[(c8 * 8 + 6) * 68 + nr], sm[(c8 * 8 + 7) * 68 + nr]);
                    *(u32x4*)&dst[(size_t)n * 1024 + kt * 64 + c8 * 8] = o;
                }
            }
        }
    }
    for (int i = gtid; i < (DEPTH * 1024); i += nth) ((float*)(WSB(p) + OFF_norm1_g))[i] = p.norm1_g[i];
    for (int i = gtid; i < (DEPTH * 1024); i += nth) ((float*)(WSB(p) + OFF_norm2_g))[i] = p.norm2_g[i];
    for (int i = gtid; i < (DEPTH * 64); i += nth) ((float*)(WSB(p) + OFF_hgrn_norm_g))[i] = p.hgrn_norm_g[i];
    for (int i = gtid; i < (DEPTH * 3 * 768); i += nth) ((float*)(WSB(p) + OFF_hy_short_w))[i] = p.hy_short_w[i];
    for (int i = gtid; i < (DEPTH * 768); i += nth) ((float*)(WSB(p) + OFF_hy_short_b))[i] = p.hy_short_b[i];
    for (int i = gtid; i < (DEPTH * 2 * 256); i += nth) ((float*)(WSB(p) + OFF_hy_bias))[i] = p.hy_bias[i];
    for (int i = gtid; i < (DEPTH * 4 * 15 * 31); i += nth) ((float*)(WSB(p) + OFF_na_rpb))[i] = p.na_rpb[i];
    for (int i = gtid; i < (DEPTH * 64); i += nth) ((float*)(WSB(p) + OFF_na_q_g))[i] = p.na_q_g[i];
    for (int i = gtid; i < (DEPTH * 64); i += nth) ((float*)(WSB(p) + OFF_na_k_g))[i] = p.na_k_g[i];
    for (int i = gtid; i < (DEPTH * 256); i += nth) ((float*)(WSB(p) + OFF_mla_q_a_g))[i] = p.mla_q_a_g[i];
    for (int i = gtid; i < (DEPTH * 128); i += nth) ((float*)(WSB(p) + OFF_mla_kv_a_g))[i] = p.mla_kv_a_g[i];
    for (int i = gtid; i < (DEPTH * 256 * 384); i += nth) ((float*)(WSB(p) + OFF_mla_w_uq))[i] = p.mla_w_uq[i];
    for (int i = gtid; i < (DEPTH * 128 * 512); i += nth) ((float*)(WSB(p) + OFF_mla_w_ukv))[i] = p.mla_w_ukv[i];
    for (int i = gtid; i < (DEPTH * 96); i += nth) ((float*)(WSB(p) + OFF_mla_q_g))[i] = p.mla_q_g[i];
    for (int i = gtid; i < (DEPTH * 96); i += nth) ((float*)(WSB(p) + OFF_mla_k_g))[i] = p.mla_k_g[i];
    for (int i = gtid; i < (DEPTH * 1024 * 4); i += nth) ((float*)(WSB(p) + OFF_moe_wg))[i] = p.moe_wg[i];
    for (int i = gtid; i < (DEPTH * 4); i += nth) ((float*)(WSB(p) + OFF_moe_bg))[i] = p.moe_bg[i];
    for (int i = gtid; i < (DEPTH * 1024 * 32); i += nth) ((float*)(WSB(p) + OFF_moe_we))[i] = p.moe_we[i];
    for (int i = gtid; i < (DEPTH * 32); i += nth) ((float*)(WSB(p) + OFF_moe_be))[i] = p.moe_be[i];
    for (int u = wq_next(WQ(p, -1, 0), sm); u < DEPTH * 96; u = wq_next(WQ(p, -1, 0), sm)) {
        const int l = u / 96, cg = u % 96;
        for (int i = tid; i < 9 * 1024; i += 256) { float v = i < 8192 ? p.c[i] : p.c_ctx[i - 8192]; sm[i] = siluf_(v); }
        __syncthreads();
        const int col = cg * 64 + (tid & 63), kq = tid >> 6;
        float acc[9];
#pragma unroll
        for (int r = 0; r < 9; r++) acc[r] = 0.f;
        const float* w = p.w_ada + (size_t)l * 1024 * 6144 + col;
        for (int k = kq * 256; k < kq * 256 + 256; k++) {
            float wv = w[(size_t)k * 6144];
#pragma unroll
            for (int r = 0; r < 9; r++) acc[r] += sm[r * 1024 + k] * wv;
        }
        float* red = sm + 9 * 1024;
#pragma unroll
        for (int r = 0; r < 9; r++) red[(kq * 9 + r) * 64 + (tid & 63)] = acc[r];
        __syncthreads();
        if (tid < 64) {
#pragma unroll
            for (int r = 0; r < 9; r++)
                W_MOD[(size_t)(l * 9 + r) * 6144 + col] = red[(0 * 9 + r) * 64 + tid] + red[(1 * 9 + r) * 64 + tid] + red[(2 * 9 + r) * 64 + tid] +
                                                          red[(3 * 9 + r) * 64 + tid] + p.b_ada[l * 6144 + col];
        }
        __syncthreads();
    }
    {
        const int wave = tid >> 6, lane = tid & 63;
        for (int wu = BIDX * 4 + wave; wu < DEPTH * 2304; wu += gridDim.x * 4) {
            const int l = wu / 2304, rem = wu % 2304;
            const int which = rem >= 2048 ? 1 : 0;
            const int t = which ? rem - 2048 : rem;
            const int L = which ? 256 : 2048;
            const float tu = (float)t / (float)(L - 1);
            float feat = 0.f;
            if (lane == 0) feat = tu;
            else if (lane <= 32) {
                const int bi = (lane - 1) & 15;
                const float band = 1e-4f + (float)bi * ((15.f - 1e-4f) / 15.f);
                float uu = (float)t * band / (float)L;
                uu -= floorf(uu);
                float s_, c_;
                sincospif(2.f * uu, &s_, &c_);
                feat = lane <= 16 ? c_ : -s_;
            }
            const float fr = p.hy_freq[l * 64 + lane];
            float a = p.hy_b1[l * 64 + lane];
            for (int e = 0; e < 33; e++) a += __shfl(feat, e) * p.hy_w1[(l * 33 + e) * 64 + lane];
            const float h1 = sinf(fr * a);
            float a2 = p.hy_b2[l * 64 + lane];
            for (int i = 0; i < 64; i++) a2 += __shfl(h1, i) * p.hy_w2[(l * 64 + i) * 64 + lane];
            const float h2 = sinf(fr * a2);
            W_HDN[((size_t)(l * 2 + which) * 2048 + t) * 64 + lane] = h2;
        }
    }
}

template <int LL>
__device__ __forceinline__ void hyk_unit(const Params& p, int l, int o, int c, float* sm) {
    constexpr int NT = LL / 256;
    constexpr int which = (LL == 256) ? 1 : 0;
    const int tid = TIDX;
    const int colf = o * 512 + c, colb = o * 512 + 256 + c;
    __syncthreads();
    if (tid < 64) { sm[tid] = p.hy_w3[(size_t)(l * 64 + tid) * 1024 + colf]; sm[64 + tid] = p.hy_w3[(size_t)(l * 64 + tid) * 1024 + colb]; }
    __syncthreads();
    const float bf = p.hy_b3[l * 1024 + colf], bb = p.hy_b3[l * 1024 + colb];
    const float df = p.hy_decay[((l * 2 + o) * 2 + 0) * 256 + c], dbw = p.hy_decay[((l * 2 + o) * 2 + 1) * 256 + c];
    float vf[NT], vb[NT];
    float ss = 0.f;
#pragma unroll
    for (int i = 0; i < NT; i++) {
        const int t = tid + 256 * i;
        const float* h = W_HDN + ((size_t)(l * 2 + which) * 2048 + t) * 64;
        float af = bf, ab = bb;
#pragma unroll 4
        for (int k = 0; k < 64; k++) { float hv = h[k]; af += hv * sm[k]; ab += hv * sm[64 + k]; }
        const float tu = (float)t / (float)(LL - 1);
        af *= expf(-tu * df); ab *= expf(-tu * dbw);
        vf[i] = af; vb[i] = ab;
        ss += af * af + (t > 0 ? ab * ab : 0.f);
    }
    const float tot = block_sum(ss, sm + 128);
    const float scale = rsqrtf(tot + EPSF);
    if (which) {
        float* outp = W_HYKC + (size_t)((l * 2 + o) * 256 + c) * 2 * LL;
#pragma unroll
        for (int i = 0; i < NT; i++) { const int t = tid + 256 * i; outp[t] = vf[i] * scale; outp[LL + t] = vb[i] * scale; }
    } else {
        float* kl = sm + 256;
        float2* fb = (float2*)(sm + 256 + 4096);
#pragma unroll
        for (int i = 0; i < NT; i++) {
            const int t = tid + 256 * i;
            kl[t] = vf[i] * scale;
            if (t > 0) kl[4096 - t] = vb[i] * scale;
        }
        if (tid == 0) kl[2048] = 0.f;
        __syncthreads();
        float2 v[4][4];
#pragma unroll
        for (int r1 = 0; r1 < 4; r1++)
#pragma unroll
            for (int r2 = 0; r2 < 4; r2++) v[r1][r2] = make_float2(kl[tid + 256 * (r1 * 4 + r2)], 0.f);
        fft_fwd_pass<0>(v, tid, W_TW);
        fft_lds_write<0>(v, tid, fb);
        __syncthreads();
        fft_lds_read<2>(v, tid, fb);
        fft_fwd_pass<2>(v, tid, W_TW);
        fft_lds_write<2>(v, tid, fb);
        __syncthreads();
        fft_lds_read<4>(v, tid, fb);
        fft_fwd_pass<4>(v, tid, W_TW);
        float2* outp = W_KSPEC + (size_t)((l * 2 + o) * 256 + c) * 4096 + tid * 16;
#pragma unroll
        for (int r1 = 0; r1 < 4; r1++)
#pragma unroll
            for (int r2 = 0; r2 < 4; r2++) outp[r1 * 4 + r2] = make_float2(v[r1][r2].x * (1.f / 4096.f), v[r1][r2].y * (1.f / 4096.f));
    }
}
__device__ void phase_pro2(const Params& p, float* sm) {
    for (int u = wq_next(WQ(p, -1, 1), sm); u < DEPTH * 512 + (DEPTH - 1) * 512; u = wq_next(WQ(p, -1, 1), sm)) {
        const int which = u / (DEPTH * 512), r = u % (DEPTH * 512);
        const int l = r / 512, o = (r / 256) & 1, c = r & 255;
        if (which == 0) hyk_unit<2048>(p, l, o, c, sm); else hyk_unit<256>(p, l, o, c, sm);
    }
}

__device__ void phase_norm1(const Params& p, int l, float* sm) {
    const int wave = TIDX >> 6, lane = TIDX & 63;
    for (int row = BIDX * 4 + wave; row < TT; row += gridDim.x * 4) {
        const int bi = bidx_of(row);
        float4 xv[4];
        float ss = 0.f;
#pragma unroll
        for (int i = 0; i < 4; i++) {
            const int k = i * 256 + lane * 4;
            const float* xsrc = l > 0 ? &W_X[(size_t)row * 1024 + k] : (row < NLAT ? &p.x[(size_t)row * 1024 + k] : &p.ctx[(size_t)(row - NLAT) * 1024 + k]);
            float4 v = *(const float4*)xsrc;
            if (l > 0) {
                const float4 g2 = *(const float4*)&W_MOD[(size_t)((l - 1) * 9 + bi) * 6144 + 5120 + k];
                const float4 y0 = ld4bf(&W_YEXP[((size_t)row * 2 + 0) * 1024 + k]);
                const float4 y1 = ld4bf(&W_YEXP[((size_t)row * 2 + 1) * 1024 + k]);
                v.x += g2.x * (y0.x + y1.x); v.y += g2.y * (y0.y + y1.y); v.z += g2.z * (y0.z + y1.z); v.w += g2.w * (y0.w + y1.w);
                *(float4*)&W_X[(size_t)row * 1024 + k] = v;
            }
            xv[i] = v;
            ss += v.x * v.x + v.y * v.y + v.z * v.z + v.w * v.w;
        }
        ss = wave_sum(ss);
        const float rstd = rsqrtf(ss * (1.f / 1024.f) + EPSF);
        const float* md = W_MOD + (size_t)(l * 9 + bi) * 6144;
#pragma unroll
        for (int i = 0; i < 4; i++) {
            const int k = i * 256 + lane * 4;
            const float4 g = *(const float4*)&W_norm1_g[l * 1024 + k];
            const float4 sh = *(const float4*)&md[k];
            const float4 sc = *(const float4*)&md[1024 + k];
            float4 o;
            o.x = xv[i].x * rstd * g.x * (1.f + sc.x) + sh.x;
            o.y = xv[i].y * rstd * g.y * (1.f + sc.y) + sh.y;
            o.z = xv[i].z * rstd * g.z * (1.f + sc.z) + sh.z;
            o.w = xv[i].w * rstd * g.w * (1.f + sc.w) + sh.w;
            st4bf(&W_H[(size_t)row * 1024 + k], o);
        }
    }
}

__device__ void phase_final(const Params& p, float* sm) {
    const int nth = blockDim.x * gridDim.x, gtid = BIDX * blockDim.x + TIDX;
    for (int i = gtid; i < NLAT * 256; i += nth) {
        const int row = i >> 8, k = (i & 255) * 4;
        const int bi = row >> 11;
        float4 v = *(const float4*)&W_X[(size_t)row * 1024 + k];
        const float4 g2 = *(const float4*)&W_MOD[(size_t)(3 * 9 + bi) * 6144 + 5120 + k];
        const float4 y0 = ld4bf(&W_YEXP[((size_t)row * 2 + 0) * 1024 + k]);
        const float4 y1 = ld4bf(&W_YEXP[((size_t)row * 2 + 1) * 1024 + k]);
        v.x += g2.x * (y0.x + y1.x); v.y += g2.y * (y0.y + y1.y); v.z += g2.z * (y0.z + y1.z); v.w += g2.w * (y0.w + y1.w);
        *(float4*)&p.out[(size_t)row * 1024 + k] = v;
    }
}

__device__ void phase_gemm1(const Params& p, int l, float* sm) {
    const int NTN = (DIN + 127) / 128;
    const float* W = p.w_in + (size_t)l * 1024 * DIN;
    const int tid = TIDX, lane = tid & 63, w = tid >> 6, wm = w >> 1, wn = w & 1, r16 = lane & 15, q = lane >> 4;
    for (int u = wq_next(WQ(p, l, 0), sm); u < 144 * 4 * 7; u = wq_next(WQ(p, l, 0), sm)) {
        const int band = u / (144 * 4), rem = u % (144 * 4);
        const int bw = min(4, NTN - band * 4);
        const int rb = rem / bw, cb = band * 4 + rem % bw;
        if (rb >= 144) continue;
        const int r0 = rb * 128, n0 = cb * 128;
        f32x4 acc[4][4];
        const bf16_t* hb = W_H + (size_t)r0 * 1024;
        const bf16_t* wb = W_WINT + (size_t)l * DIN * 1024;
        gemm128_bt<true>(1024, (char*)sm, [&](int r) { return hb + (size_t)r * 1024; },
                         [&](int r) { return wb + (size_t)min(n0 + r, DIN - 1) * 1024; }, acc);
#pragma unroll
        for (int i = 0; i < 4; i++)
#pragma unroll
            for (int j = 0; j < 4; j++) {
                const int m = r0 + wm * 64 + i * 16 + r16, n = n0 + wn * 64 + j * 16 + q * 4;
                if (n0 >= C_HY && n0 < C_NA && r0 < NLAT) {
                    bf16_t* dst = W_HYT + ((size_t)(m >> 11) * 768 + (n - C_HY)) * 2048 + (m & 2047);
#pragma unroll
                    for (int e = 0; e < 4; e++) dst[(size_t)e * 2048] = f2bf(acc[i][j][e]);
                } else if (n < DIN) st4bf(&W_P[(size_t)m * DIN + n], make_float4(acc[i][j][0], acc[i][j][1], acc[i][j][2], acc[i][j][3]));
            }
    }
}

__device__ void phase_prep_main(const Params& p, int l, float* sm);
__device__ __forceinline__ void hgrn_local_unit(const Params& p, int l, int u, float* sm);
__device__ void phase_prep(const Params& p, int l, float* sm) {
    const bool main_first = (BIDX >> 8) & 1;
    if (main_first) phase_prep_main(p, l, sm);
    for (int u = wq_next(WQ(p, l, 1), sm); u < 1152; u = wq_next(WQ(p, l, 1), sm)) hgrn_local_unit(p, l, u, sm);
    if (!main_first) phase_prep_main(p, l, sm);
}
__device__ void phase_prep_main(const Params& p, int l, float* sm) {
    const int tid = TIDX, lane = tid & 63, w = tid >> 6, r16 = lane & 15, q4 = lane >> 4;
    char* smc = (char*)sm;
    char* Acq = smc;
    char* Ackv = smc + 8704;
    float* R = (float*)(smc + 13312);
    float* krf = (float*)(smc + 13312 + 16 * 516 * 4);
    float* rsq = krf + 512;
    float* rskv = rsq + 16;
    for (int u = wq_next(WQ(p, l, 2), sm); u < TT / 16; u = wq_next(WQ(p, l, 2), sm)) {
        const int r0 = u * 16;
        const bool lat = r0 < NLAT;
        const int bb = lat ? (r0 >> 11) : ((r0 - NLAT) >> 8);
        const int kidx0 = lat ? (r0 & 2047) : 2048 + ((r0 - NLAT) & 255);
        const int posb = (kidx0 & ~31) + ((kidx0 >> 4) & 1) * 4;
        const bf16_t* Pb = W_P + (size_t)r0 * DIN;
        {
            for (int c = tid; c < 512; c += 256) { const int row = c >> 5, cc = c & 31; *(u32x4*)(Acq + row * 544 + cc * 16) = *(const u32x4*)(Pb + (size_t)row * DIN + C_CQ + cc * 8); }
            { const int row = tid >> 4, cc = tid & 15; *(u32x4*)(Ackv + row * 288 + cc * 16) = *(const u32x4*)(Pb + (size_t)row * DIN + C_CKV + cc * 8); }
            for (int i = tid; i < 512; i += 256) krf[i] = bf2f(Pb[(size_t)(i >> 5) * DIN + C_KR + (i & 31)]);
        }
        {
            const float4 gq = *(const float4*)&W_na_q_g[l * 64 + r16 * 4];
            const float4 gk = *(const float4*)&W_na_k_g[l * 64 + r16 * 4];
#pragma unroll 2
            for (int ps = 0; ps < 8; ps++) {
                const int item = ps * 16 + (tid >> 4);
                const int tk = item >> 3, h = (item >> 1) & 3, wh = item & 1;
                const float4 v = ld4bf(Pb + (size_t)tk * DIN + C_NA + wh * 256 + h * 64 + r16 * 4);
                float ss = v.x * v.x + v.y * v.y + v.z * v.z + v.w * v.w;
                ss += __shfl_xor(ss, 1); ss += __shfl_xor(ss, 2); ss += __shfl_xor(ss, 4); ss += __shfl_xor(ss, 8);
                const float rs = rsqrtf(ss * (1.f / 64.f) + EPSF);
                const float4 g = wh ? gk : gq;
                st4bf((wh ? W_NK : W_NQ) + (size_t)(r0 + tk) * 256 + h * 64 + r16 * 4, make_float4(v.x * rs * g.x, v.y * rs * g.y, v.z * rs * g.z, v.w * rs * g.w));
            }
            const int h = tid >> 6, d = tid & 63;
            bf16_t* dst = W_NVT + (size_t)((bb * 4 + h) * 64 + d) * 2304 + posb;
#pragma unroll
            for (int qq = 0; qq < 4; qq++) {
                const bf16_t* src = Pb + (size_t)(qq * 4) * DIN + C_NA + 512 + h * 64 + d;
                uint2 pk;
                pk.x = (unsigned)src[0] | ((unsigned)src[DIN] << 16);
                pk.y = (unsigned)src[2 * DIN] | ((unsigned)src[3 * DIN] << 16);
                *(uint2*)(dst + qq * 8) = pk;
            }
        }
        __syncthreads();
        {
            const int tk = w * 4 + q4;
            float ss = 0.f;
#pragma unroll
            for (int j = 0; j < 2; j++) { const float4 a = ld4bf((const bf16_t*)(Acq + tk * 544) + r16 * 16 + j * 8), b = ld4bf((const bf16_t*)(Acq + tk * 544) + r16 * 16 + j * 8 + 4);
                ss += a.x * a.x + a.y * a.y + a.z * a.z + a.w * a.w + b.x * b.x + b.y * b.y + b.z * b.z + b.w * b.w; }
            ss += __shfl_xor(ss, 1); ss += __shfl_xor(ss, 2); ss += __shfl_xor(ss, 4); ss += __shfl_xor(ss, 8);
            float s2 = 0.f;
            { const float4 a = ld4bf((const bf16_t*)(Ackv + tk * 288) + r16 * 8), b = ld4bf((const bf16_t*)(Ackv + tk * 288) + r16 * 8 + 4);
              s2 = a.x * a.x + a.y * a.y + a.z * a.z + a.w * a.w + b.x * b.x + b.y * b.y + b.z * b.z + b.w * b.w; }
            s2 += __shfl_xor(s2, 1); s2 += __shfl_xor(s2, 2); s2 += __shfl_xor(s2, 4); s2 += __shfl_xor(s2, 8);
            if (r16 == 0) { rsq[tk] = rsqrtf(ss * (1.f / 256.f) + EPSF); rskv[tk] = rsqrtf(s2 * (1.f / 128.f) + EPSF); }
        }
        __syncthreads();
        {
            const bf16_t* WB = W_WUQT + (size_t)l * 384 * 256;
            const float rs = rsq[r16];
#pragma unroll 2
            for (int it = 0; it < 6; it++) {
                const int nt = it * 4 + w;
                f32x4 acc = (f32x4){0.f, 0.f, 0.f, 0.f};
#pragma unroll
                for (int ks = 0; ks < 8; ks++) {
                    const bf16x8 bfr = *(const bf16x8*)(WB + (size_t)(nt * 16 + r16) * 256 + ks * 32 + q4 * 8);
                    const bf16x8 afr = *(const bf16x8*)(Acq + r16 * 544 + ks * 64 + q4 * 16);
                    acc = __builtin_amdgcn_mfma_f32_16x16x32_bf16(bfr, afr, acc, 0, 0, 0);
                }
                *(float4*)&R[r16 * 516 + nt * 16 + q4 * 4] = make_float4(acc[0] * rs, acc[1] * rs, acc[2] * rs, acc[3] * rs);
            }
        }
        __syncthreads();
        {
            const int tk = w * 4 + q4;
            const int trow = r0 + tk;
            const float* gq = W_mla_q_g + l * 96;
            const float2* rp = W_ROPE + (size_t)(trow & 2047) * 16;
#pragma unroll 1
            for (int h = 0; h < 4; h++) {
                float v[6];
                float ss = 0.f;
#pragma unroll
                for (int m = 0; m < 6; m++) { v[m] = R[tk * 516 + h * 96 + m * 16 + r16]; ss += v[m] * v[m]; }
                ss += __shfl_xor(ss, 1); ss += __shfl_xor(ss, 2); ss += __shfl_xor(ss, 4); ss += __shfl_xor(ss, 8);
                const float rs = rsqrtf(ss * (1.f / 96.f) + EPSF);
#pragma unroll
                for (int m = 0; m < 6; m++) v[m] = v[m] * rs * gq[m * 16 + r16];
                if (lat) {
#pragma unroll
                    for (int m = 4; m < 6; m++) {
                        const float other = __shfl_xor(v[m], 8);
                        const float2 cs = rp[(m - 4) * 8 + (r16 & 7)];
                        v[m] = (r16 < 8) ? (v[m] * cs.x - other * cs.y) : (other * cs.y + v[m] * cs.x);
                    }
                }
                bf16_t* dst = W_MQ + (size_t)trow * 384 + h * 96;
#pragma unroll
                for (int m = 0; m < 6; m++) dst[m * 16 + r16] = f2bf(v[m]);
            }
        }
        __syncthreads();
        {
            const bf16_t* WB = W_WUKVT + (size_t)l * 512 * 128;
            const float rs = rskv[r16];
#pragma unroll 2
            for (int it = 0; it < 8; it++) {
                const int nt = it * 4 + w;
                f32x4 acc = (f32x4){0.f, 0.f, 0.f, 0.f};
#pragma unroll
                for (int ks = 0; ks < 4; ks++) {
                    const bf16x8 bfr = *(const bf16x8*)(WB + (size_t)(nt * 16 + r16) * 128 + ks * 32 + q4 * 8);
                    const bf16x8 afr = *(const bf16x8*)(Ackv + r16 * 288 + ks * 64 + q4 * 16);
                    acc = __builtin_amdgcn_mfma_f32_16x16x32_bf16(bfr, afr, acc, 0, 0, 0);
                }
                *(float4*)&R[r16 * 516 + nt * 16 + q4 * 4] = make_float4(acc[0] * rs, acc[1] * rs, acc[2] * rs, acc[3] * rs);
            }
        }
        __syncthreads();
        {
            const int tk = w * 4 + q4;
            const int trow = r0 + tk;
            const float* gk = W_mla_k_g + l * 96;
            const float2* rp = W_ROPE + (size_t)(trow & 2047) * 16;
            const float kr0 = krf[tk * 32 + r16], kr1 = krf[tk * 32 + 16 + r16];
#pragma unroll 1
            for (int h = 0; h < 4; h++) {
                float v[6];
                float ss = 0.f;
#pragma unroll
                for (int m = 0; m < 4; m++) { v[m] = R[tk * 516 + h * 128 + m * 16 + r16]; ss += v[m] * v[m]; }
                v[4] = kr0; v[5] = kr1; ss += kr0 * kr0 + kr1 * kr1;
                ss += __shfl_xor(ss, 1); ss += __shfl_xor(ss, 2); ss += __shfl_xor(ss, 4); ss += __shfl_xor(ss, 8);
                const float rs = rsqrtf(ss * (1.f / 96.f) + EPSF);
#pragma unroll
                for (int m = 0; m < 6; m++) v[m] = v[m] * rs * gk[m * 16 + r16];
                if (lat) {
#pragma unroll
                    for (int m = 4; m < 6; m++) {
                        const float other = __shfl_xor(v[m], 8);
                        const float2 cs = rp[(m - 4) * 8 + (r16 & 7)];
                        v[m] = (r16 < 8) ? (v[m] * cs.x - other * cs.y) : (other * cs.y + v[m] * cs.x);
                    }
                }
                bf16_t* dst = W_MK + (size_t)trow * 384 + h * 96;
#pragma unroll
                for (int m = 0; m < 6; m++) dst[m * 16 + r16] = f2bf(v[m]);
            }
        }
        {
            const int h = tid >> 6, d = tid & 63;
            bf16_t* dst = W_MVT + (size_t)((bb * 4 + h) * 64 + d) * 2304 + posb;
            const float* src = R + h * 128 + 64 + d;
#pragma unroll
            for (int qq = 0; qq < 4; qq++) {
                uint2 pk;
                pk.x = pack2bf(src[(qq * 4 + 0) * 516], src[(qq * 4 + 1) * 516]);
                pk.y = pack2bf(src[(qq * 4 + 2) * 516], src[(qq * 4 + 3) * 516]);
                *(uint2*)(dst + qq * 8) = pk;
            }
        }
    }
}

template <int DQK, int QT, bool NA, class KIDX>
__device__ __forceinline__ void flash_attn(char* smc, const bf16_t* qrow0, int qstride, const bf16_t* kbuf_h, int kstride, int b,
                                           const bf16_t* vbase_bh, int nkb, KIDX kidx_of, float scale, bf16_t* orow0, int ostride,
                                           const float* rpbs, int na_r, int na_rs) {
    constexpr int KS = DQK / 32, CPR = DQK / 8, KSTR = DQK * 2 + 32, KBUF = 64 * KSTR, NKC = 64 * CPR / 256, VSTR = 160, VBUF = 64 * VSTR;
    const int tid = TIDX, lane = tid & 63, w = tid >> 6, r16 = lane & 15, q = lane >> 4;
    char* Kb = smc;
    char* Vb = smc + 2 * KBUF;
    bf16x8 qf[QT][KS];
#pragma unroll
    for (int qt = 0; qt < QT; qt++)
#pragma unroll
        for (int ks = 0; ks < KS; ks++) qf[qt][ks] = *(const bf16x8*)(qrow0 + (size_t)(w * QT * 16 + qt * 16 + r16) * qstride + ks * 32 + q * 8);
    f32x4 o[4][QT];
    float m[QT], ls[QT];
#pragma unroll
    for (int qt = 0; qt < QT; qt++) {
        m[qt] = -1e30f; ls[qt] = 0.f;
#pragma unroll
        for (int dt = 0; dt < 4; dt++) o[dt][qt] = (f32x4){0.f, 0.f, 0.f, 0.f};
    }
    u32x4 rk[NKC], rv[2];
    {
        const int kidx = kidx_of(0);
        const int trow = kidx < 2048 ? b * 2048 + kidx : NLAT + b * 256 + (kidx - 2048);
        const bf16_t* kp = kbuf_h + (size_t)trow * kstride;
        const bf16_t* vp = vbase_bh + kidx;
#pragma unroll
        for (int i = 0; i < NKC; i++) { const int c = tid + 256 * i; const int row = c / CPR, cc = c % CPR; rk[i] = *(const u32x4*)(kp + (size_t)row * kstride + cc * 8); }
#pragma unroll
        for (int i = 0; i < 2; i++) { const int c = tid + 256 * i; const int row = c >> 3, cc = c & 7; rv[i] = *(const u32x4*)(vp + (size_t)row * 2304 + cc * 8); }
    }
    __syncthreads();
#pragma unroll
    for (int i = 0; i < NKC; i++) { const int c = tid + 256 * i; const int row = c / CPR, cc = c % CPR; *(u32x4*)(Kb + row * KSTR + cc * 16) = rk[i]; }
#pragma unroll
    for (int i = 0; i < 2; i++) { const int c = tid + 256 * i; const int row = c >> 3, cc = c & 7; *(u32x4*)(Vb + row * VSTR + cc * 16) = rv[i]; }
    __syncthreads();
    for (int kb = 0; kb < nkb; kb++) {
        const bool more = kb + 1 < nkb;
        if (more) {
            const int kidx = kidx_of(kb + 1);
            const int trow = kidx < 2048 ? b * 2048 + kidx : NLAT + b * 256 + (kidx - 2048);
            const bf16_t* kp = kbuf_h + (size_t)trow * kstride;
            const bf16_t* vp = vbase_bh + kidx;
#pragma unroll
            for (int i = 0; i < NKC; i++) { const int c = tid + 256 * i; const int row = c / CPR, cc = c % CPR; rk[i] = *(const u32x4*)(kp + (size_t)row * kstride + cc * 8); }
#pragma unroll
            for (int i = 0; i < 2; i++) { const int c = tid + 256 * i; const int row = c >> 3, cc = c & 7; rv[i] = *(const u32x4*)(vp + (size_t)row * 2304 + cc * 8); }
        }
        const char* Ks_ = Kb + (kb & 1) * KBUF;
        const char* Vs_ = Vb + (kb & 1) * VBUF;
        f32x4 s[4][QT];
#pragma unroll
        for (int kt = 0; kt < 4; kt++) {
#pragma unroll
            for (int qt = 0; qt < QT; qt++) s[kt][qt] = (f32x4){0.f, 0.f, 0.f, 0.f};
#pragma unroll
            for (int ks = 0; ks < KS; ks++) {
                const bf16x8 kf = *(const bf16x8*)(Ks_ + (kt * 16 + r16) * KSTR + ks * 64 + q * 16);
#pragma unroll
                for (int qt = 0; qt < QT; qt++) s[kt][qt] = __builtin_amdgcn_mfma_f32_16x16x32_bf16(kf, qf[qt][ks], s[kt][qt], 0, 0, 0);
            }
        }
#pragma unroll
        for (int qt = 0; qt < QT; qt++) {
            float bm = -1e30f;
#pragma unroll
            for (int kt = 0; kt < 4; kt++)
#pragma unroll
                for (int e = 0; e < 4; e++) {
                    float v = s[kt][qt][e] * scale;
                    if (NA) {
                        if (kb < 8) {
                            const int kc = kt * 16 + q * 4 + e;
                            const int cq = w * 16 + r16;
                            const int dr = na_rs + kb - na_r + 7;
                            const int dc = min(max(kc - cq + 15, 0), 30);
                            const int cs = min(max(cq - 8, 0), 48);
                            const bool ok = (kc >= cs) && (kc < cs + 16);
                            v = ok ? v + rpbs[dr * 31 + dc] : -1e30f;
                        }
                    }
                    s[kt][qt][e] = v;
                    bm = fmaxf(bm, v);
                }
            bm = fmaxf(bm, __shfl_xor(bm, 16));
            bm = fmaxf(bm, __shfl_xor(bm, 32));
            const float mn = fmaxf(m[qt], bm);
            const float corr = __builtin_amdgcn_exp2f(m[qt] - mn);
            m[qt] = mn;
            float rsum = 0.f;
#pragma unroll
            for (int kt = 0; kt < 4; kt++)
#pragma unroll
                for (int e = 0; e < 4; e++) { const float pe = __builtin_amdgcn_exp2f(s[kt][qt][e] - mn); s[kt][qt][e] = pe; rsum += pe; }
            ls[qt] = ls[qt] * corr + rsum;
#pragma unroll
            for (int dt = 0; dt < 4; dt++) { o[dt][qt][0] *= corr; o[dt][qt][1] *= corr; o[dt][qt][2] *= corr; o[dt][qt][3] *= corr; }
        }
#pragma unroll
        for (int g = 0; g < 2; g++) {
            bf16x8 pf[QT];
#pragma unroll
            for (int qt = 0; qt < QT; qt++) {
                union { bf16x8 v; unsigned u[4]; } pk;
                pk.u[0] = pack2bf(s[2 * g][qt][0], s[2 * g][qt][1]); pk.u[1] = pack2bf(s[2 * g][qt][2], s[2 * g][qt][3]);
                pk.u[2] = pack2bf(s[2 * g + 1][qt][0], s[2 * g + 1][qt][1]); pk.u[3] = pack2bf(s[2 * g + 1][qt][2], s[2 * g + 1][qt][3]);
                pf[qt] = pk.v;
            }
#pragma unroll
            for (int dt = 0; dt < 4; dt++) {
                const bf16x8 vf = *(const bf16x8*)(Vs_ + (dt * 16 + r16) * VSTR + g * 64 + q * 16);
#pragma unroll
                for (int qt = 0; qt < QT; qt++) o[dt][qt] = __builtin_amdgcn_mfma_f32_16x16x32_bf16(vf, pf[qt], o[dt][qt], 0, 0, 0);
            }
        }
        if (more) {
            char* Kw = Kb + ((kb + 1) & 1) * KBUF;
            char* Vw = Vb + ((kb + 1) & 1) * VBUF;
#pragma unroll
            for (int i = 0; i < NKC; i++) { const int c = tid + 256 * i; const int row = c / CPR, cc = c % CPR; *(u32x4*)(Kw + row * KSTR + cc * 16) = rk[i]; }
#pragma unroll
            for (int i = 0; i < 2; i++) { const int c = tid + 256 * i; const int row = c >> 3, cc = c & 7; *(u32x4*)(Vw + row * VSTR + cc * 16) = rv[i]; }
        }
        __syncthreads();
    }
#pragma unroll
    for (int qt = 0; qt < QT; qt++) {
        float lt = ls[qt];
        lt += __shfl_xor(lt, 16);
        lt += __shfl_xor(lt, 32);
        const float inv = 1.f / lt;
#pragma unroll
        for (int dt = 0; dt < 4; dt++)
            st4bf(orow0 + (size_t)(w * QT * 16 + qt * 16 + r16) * ostride + dt * 16 + q * 4,
                  make_float4(o[dt][qt][0] * inv, o[dt][qt][1] * inv, o[dt][qt][2] * inv, o[dt][qt][3] * inv));
    }
}

__device__ __forceinline__ void mla_unit(const Params& p, int l, int u, bool isctx, float* sm) {
    int b, h, qb;
    if (!isctx) { b = u >> 6; h = (u >> 4) & 3; qb = u & 15; } else { b = u >> 3; h = (u >> 1) & 3; qb = u & 1; }
    const int qrow = (isctx ? NLAT + b * 256 : b * 2048) + qb * 128;
    const bf16_t* vb = W_MVT + (size_t)((b * 4 + h) * 64) * 2304;
    const float scale = 0.10206207261596577f * 1.4426950408889634f;
    if (!isctx)
        flash_attn<96, 2, false>((char*)sm, W_MQ + (size_t)qrow * 384 + h * 96, 384, W_MK + h * 96, 384, b, vb, 36, [](int kb) { return kb * 64; }, scale,
                                 W_CAT + (size_t)qrow * 1024 + 768 + h * 64, 1024, nullptr, 0, 0);
    else
        flash_attn<96, 2, false>((char*)sm, W_MQ + (size_t)qrow * 384 + h * 96, 384, W_MK + h * 96, 384, b, vb, 4, [](int kb) { return 2048 + kb * 64; }, scale,
                                 W_CAT + (size_t)qrow * 1024 + 768 + h * 64, 1024, nullptr, 0, 0);
}
__device__ __forceinline__ void na_unit(const Params& p, int l, int u, bool isctx, float* sm) {
    if (!isctx) {
        const int b = u >> 7, h = (u >> 5) & 3, r = u & 31;
        const int rs = min(max(r - 4, 0), 24);
        float* rpbs = sm + 10240;
        __syncthreads();
        for (int i = TIDX; i < 15 * 31; i += 256) rpbs[i] = W_na_rpb[(size_t)(l * 4 + h) * 465 + i] * 1.4426950408889634f;
        const int qrow = b * 2048 + r * 64;
        flash_attn<64, 1, true>((char*)sm, W_NQ + (size_t)qrow * 256 + h * 64, 256, W_NK + h * 64, 256, b, W_NVT + (size_t)((b * 4 + h) * 64) * 2304, 12,
                                [rs](int kb) { return kb < 8 ? (rs + kb) * 64 : 2048 + (kb - 8) * 64; }, 0.125f * 1.4426950408889634f,
                                W_CAT + (size_t)qrow * 1024 + 512 + h * 64, 1024, rpbs, r, rs);
    } else {
        const int b = u >> 4, h = (u >> 2) & 3, qb = u & 3;
        const int qrow = NLAT + b * 256 + qb * 64;
        flash_attn<64, 1, false>((char*)sm, W_NQ + (size_t)qrow * 256 + h * 64, 256, W_NK + h * 64, 256, b, W_NVT + (size_t)((b * 4 + h) * 64) * 2304, 4,
                                 [](int kb) { return 2048 + kb * 64; }, 0.125f * 1.4426950408889634f, W_CAT + (size_t)qrow * 1024 + 512 + h * 64, 1024, nullptr, 0, 0);
    }
}

__device__ __forceinline__ void hgrn_local_unit(const Params& p, int l, int u, float* sm) {
    const int tid = TIDX;
    const int b = u / 144, h = (u / 36) & 3, cid = u % 36;
    const int row0 = cid < 4 ? NLAT + b * 256 + cid * 64 : b * 2048 + (cid - 4) * 64;
    float* B0 = sm;
    char* VT = (char*)(sm + 4352);
    char* KB = (char*)(sm + 6656);
    float* B2 = sm + 8960;
    float* B3 = sm + 13312;
    float* SC = sm + 17408;
    const int lane_ = tid & 63, w_ = tid >> 6, r16 = lane_ & 15, q4 = lane_ >> 4;
    const int k = tid & 63, seg = tid >> 6;
    const int ti = tid >> 4, ts = tid & 15;
    float acc[4][4];
#pragma unroll
    for (int a = 0; a < 4; a++)
#pragma unroll
        for (int c = 0; c < 4; c++) acc[a][c] = 0.f;
    __syncthreads();
    {
        const int s_ = tid >> 2, c0 = (tid & 3) * 16;
        const bf16_t* src = W_P + (size_t)(row0 + s_) * DIN + C_HI + h * 64 + c0;
        const u32x4 v0 = *(const u32x4*)src, v1 = *(const u32x4*)(src + 8);
#pragma unroll
        for (int j = 0; j < 4; j++) {
            *(bf16_t*)(VT + (c0 + 2 * j) * 144 + s_ * 2) = (bf16_t)(v0[j] & 0xFFFFu);
            *(bf16_t*)(VT + (c0 + 2 * j + 1) * 144 + s_ * 2) = (bf16_t)(v0[j] >> 16);
            *(bf16_t*)(VT + (c0 + 8 + 2 * j) * 144 + s_ * 2) = (bf16_t)(v1[j] & 0xFFFFu);
            *(bf16_t*)(VT + (c0 + 8 + 2 * j + 1) * 144 + s_ * 2) = (bf16_t)(v1[j] >> 16);
        }
    }
    float qv[16];
#pragma unroll
    for (int j = 0; j < 16; j++) qv[j] = bf2f(W_P[(size_t)(row0 + seg * 16 + j) * DIN + C_HQ + h * 64 + k]);
#pragma unroll
    for (int j = 0; j < 4; j++) *(float4*)&B0[k * 68 + seg * 16 + 4 * j] = make_float4(qv[4 * j], qv[4 * j + 1], qv[4 * j + 2], qv[4 * j + 3]);
#pragma unroll 1
    for (int dir = 0; dir < 2; dir++) {
        const int zoff = dir ? C_ZB : C_ZF;
        const float lbv = W_LB[(l * 2 + dir) * 256 + h * 64 + k];
        const size_t ud = (size_t)u * 2 + dir;
        float bl[16], kkv[16];
#pragma unroll
        for (int j = 0; j < 16; j++) {
            float z = bf2f(W_P[(size_t)(row0 + seg * 16 + j) * DIN + zoff + h * 64 + k]);
            z = fminf(fmaxf(z, -20.f), 20.f);
            const float e_ = __expf(-z);
            const float sg = 1.f / (1.f + e_);
            const float f = lbv + (1.f - lbv) * sg;
            bl[j] = __log2f(f);
            kkv[j] = (1.f - lbv) * (e_ * sg);
        }
        float tot;
        if (dir == 0) {
#pragma unroll
            for (int j = 1; j < 16; j++) bl[j] += bl[j - 1];
            tot = bl[15];
        } else {
#pragma unroll
            for (int j = 14; j >= 0; j--) bl[j] += bl[j + 1];
            tot = bl[0];
        }
        SC[seg * 64 + k] = tot;
        __syncthreads();
        float off = 0.f;
#pragma unroll
        for (int s2 = 0; s2 < 4; s2++) if (dir ? (s2 > seg) : (s2 < seg)) off += SC[s2 * 64 + k];
        const float btot = SC[k] + SC[64 + k] + SC[128 + k] + SC[192 + k];
#pragma unroll
        for (int j = 0; j < 16; j++) bl[j] += off;
#pragma unroll
        for (int j = 0; j < 4; j++) {
            const float Rj = dir ? bl[4 * j] : bl[4 * j + 3];
            *(float4*)&B2[k * 68 + seg * 16 + 4 * j] = make_float4(kkv[4 * j] * __builtin_amdgcn_exp2f(Rj - bl[4 * j]), kkv[4 * j + 1] * __builtin_amdgcn_exp2f(Rj - bl[4 * j + 1]),
                                                                   kkv[4 * j + 2] * __builtin_amdgcn_exp2f(Rj - bl[4 * j + 2]), kkv[4 * j + 3] * __builtin_amdgcn_exp2f(Rj - bl[4 * j + 3]));
            *(float4*)&B3[k * 64 + seg * 16 + 4 * j] = make_float4(bl[4 * j], bl[4 * j + 1], bl[4 * j + 2], bl[4 * j + 3]);
#pragma unroll
            for (int jj = 0; jj < 4; jj++)
                ((bf16_t*)W_HQ)[(ud * 64 + seg * 16 + 4 * j + jj) * 64 + k] = f2bf(qv[4 * j + jj] * __builtin_amdgcn_exp2f(bl[4 * j + jj]));
        }
        if (seg == 0) W_HD[ud * 64 + k] = __builtin_amdgcn_exp2f(btot);
        {
            u32x4 k0, k1;
#pragma unroll
            for (int j = 0; j < 4; j++) {
                k0[j] = pack2bf(kkv[2 * j] * __builtin_amdgcn_exp2f(btot - bl[2 * j]), kkv[2 * j + 1] * __builtin_amdgcn_exp2f(btot - bl[2 * j + 1]));
                k1[j] = pack2bf(kkv[8 + 2 * j] * __builtin_amdgcn_exp2f(btot - bl[8 + 2 * j]), kkv[8 + 2 * j + 1] * __builtin_amdgcn_exp2f(btot - bl[8 + 2 * j + 1]));
            }
            *(u32x4*)(KB + k * 144 + seg * 32) = k0;
            *(u32x4*)(KB + k * 144 + seg * 32 + 16) = k1;
        }
        __syncthreads();
        const bool active = dir ? (ts >= ti) : (ts <= ti);
        if (active) {
            float a2[4][4];
#pragma unroll
            for (int a = 0; a < 4; a++)
#pragma unroll
                for (int c = 0; c < 4; c++) a2[a][c] = 0.f;
#pragma unroll 2
            for (int kk_ = 0; kk_ < 64; kk_++) {
                const float4 q4 = *(const float4*)&B0[kk_ * 68 + ti * 4];
                const float4 bq4 = *(const float4*)&B3[kk_ * 64 + ti * 4];
                const float4 k4 = *(const float4*)&B2[kk_ * 68 + ts * 4];
                const float4 bk4 = *(const float4*)&B3[kk_ * 64 + ts * 4];
                const float R = dir ? bk4.x : bk4.w;
                const float qr[4] = {q4.x * __builtin_amdgcn_exp2f(bq4.x - R), q4.y * __builtin_amdgcn_exp2f(bq4.y - R), q4.z * __builtin_amdgcn_exp2f(bq4.z - R), q4.w * __builtin_amdgcn_exp2f(bq4.w - R)};
                const float ka[4] = {k4.x, k4.y, k4.z, k4.w};
#pragma unroll
                for (int a = 0; a < 4; a++)
#pragma unroll
                    for (int c = 0; c < 4; c++) a2[a][c] += qr[a] * ka[c];
            }
#pragma unroll
            for (int a = 0; a < 4; a++)
#pragma unroll
                for (int c = 0; c < 4; c++) {
                    const int i_ = ti * 4 + a, s_ = ts * 4 + c;
                    const bool valid = dir ? (s_ >= i_) : (s_ <= i_);
                    acc[a][c] += valid ? a2[a][c] : 0.f;
                }
        }
        {
            f32x4 ua[4];
#pragma unroll
            for (int vt = 0; vt < 4; vt++) ua[vt] = (f32x4){0.f, 0.f, 0.f, 0.f};
#pragma unroll
            for (int ss_ = 0; ss_ < 2; ss_++) {
                const bf16x8 kbf = *(const bf16x8*)(KB + (w_ * 16 + r16) * 144 + ss_ * 64 + q4 * 16);
#pragma unroll
                for (int vt = 0; vt < 4; vt++) {
                    const bf16x8 vtf = *(const bf16x8*)(VT + (vt * 16 + r16) * 144 + ss_ * 64 + q4 * 16);
                    ua[vt] = __builtin_amdgcn_mfma_f32_16x16x32_bf16(vtf, kbf, ua[vt], 0, 0, 0);
                }
            }
#pragma unroll
            for (int vt = 0; vt < 4; vt++) st4bf((bf16_t*)W_HU + ud * 4096 + (w_ * 16 + r16) * 64 + vt * 16 + q4 * 4, make_float4(ua[vt][0], ua[vt][1], ua[vt][2], ua[vt][3]));
        }
    }
    __syncthreads();
    {
        char* AB = (char*)B2;
#pragma unroll
        for (int a2_ = 0; a2_ < 4; a2_++) {
            uint2 pk; pk.x = pack2bf(acc[a2_][0], acc[a2_][1]); pk.y = pack2bf(acc[a2_][2], acc[a2_][3]);
            *(uint2*)(AB + (ti * 4 + a2_) * 144 + ts * 8) = pk;
        }
        __syncthreads();
        f32x4 oa[4];
#pragma unroll
        for (int vt = 0; vt < 4; vt++) oa[vt] = (f32x4){0.f, 0.f, 0.f, 0.f};
#pragma unroll
        for (int ss_ = 0; ss_ < 2; ss_++) {
            const bf16x8 abf = *(const bf16x8*)(AB + (w_ * 16 + r16) * 144 + ss_ * 64 + q4 * 16);
#pragma unroll
            for (int vt = 0; vt < 4; vt++) {
                const bf16x8 vtf = *(const bf16x8*)(VT + (vt * 16 + r16) * 144 + ss_ * 64 + q4 * 16);
                oa[vt] = __builtin_amdgcn_mfma_f32_16x16x32_bf16(vtf, abf, oa[vt], 0, 0, 0);
            }
        }
#pragma unroll
        for (int vt = 0; vt < 4; vt++) *(f32x4*)&W_OF[(size_t)(row0 + w_ * 16 + r16) * 256 + h * 64 + vt * 16 + q4 * 4] = oa[vt];
    }
}

__device__ __forceinline__ void hgrn_scan_unit(const Params& p, int l, int u) {
    const int tid = TIDX;
    const int bh = u >> 5, dir = (u >> 4) & 1, sl = u & 15;
    const int ubase = bh * 36;
    const int e = sl * 256 + tid;
    const int kq = e >> 6;
    const bf16_t* HUb = (const bf16_t*)W_HU; const float* HDb = W_HD; bf16_t* SPb = (bf16_t*)W_SP;
    float S = 0.f;
#pragma unroll 6
    for (int n = 0; n < 36; n++) {
        const int cn = dir == 0 ? n : (n < 4 ? 3 - n : 39 - n);
        const size_t ud = (size_t)(ubase + cn) * 2 + dir;
        SPb[ud * 4096 + e] = f2bf(S);
        S = S * HDb[ud * 64 + kq] + bf2f(HUb[ud * 4096 + e]);
    }
}
__device__ __forceinline__ void hgrn_final_unit(const Params& p, int l, int u, float* sm) {
    const int tid = TIDX, lane = tid & 63, w = tid >> 6, r16 = lane & 15, q4 = lane >> 4;
    const int b = u / 144, h = (u / 36) & 3, cid = u % 36;
    const int row0 = cid < 4 ? NLAT + b * 256 + cid * 64 : b * 2048 + (cid - 4) * 64;
    char* ST = (char*)sm;
    __syncthreads();
#pragma unroll
    for (int dir = 0; dir < 2; dir++) {
        const bf16_t* sp = (const bf16_t*)W_SP + ((size_t)u * 2 + dir) * 4096;
#pragma unroll
        for (int j = 0; j < 2; j++) {
            const int e8 = tid + 256 * j, kk_ = e8 >> 3, v0 = (e8 & 7) * 8;
            const u32x4 sv = *(const u32x4*)&sp[e8 * 8];
            char* dst = ST + dir * 9216 + kk_ * 2;
#pragma unroll
            for (int t = 0; t < 4; t++) {
                *(bf16_t*)(dst + (v0 + 2 * t) * 144) = (bf16_t)(sv[t] & 0xFFFFu);
                *(bf16_t*)(dst + (v0 + 2 * t + 1) * 144) = (bf16_t)(sv[t] >> 16);
            }
        }
    }
    const int row = row0 + w * 16 + r16;
    f32x4 oa[4];
#pragma unroll
    for (int vt = 0; vt < 4; vt++) oa[vt] = *(const f32x4*)&W_OF[(size_t)row * 256 + h * 64 + vt * 16 + q4 * 4];
    bf16x8 qd[2][2];
#pragma unroll
    for (int dir = 0; dir < 2; dir++)
#pragma unroll
        for (int ks = 0; ks < 2; ks++) qd[dir][ks] = *(const bf16x8*)((const bf16_t*)W_HQ + (((size_t)u * 2 + dir) * 64 + w * 16 + r16) * 64 + ks * 32 + q4 * 8);
    __syncthreads();
#pragma unroll
    for (int dir = 0; dir < 2; dir++)
#pragma unroll
        for (int ks = 0; ks < 2; ks++)
#pragma unroll
            for (int vt = 0; vt < 4; vt++) {
                const bf16x8 stf = *(const bf16x8*)(ST + dir * 9216 + (vt * 16 + r16) * 144 + ks * 64 + q4 * 16);
                oa[vt] = __builtin_amdgcn_mfma_f32_16x16x32_bf16(stf, qd[dir][ks], oa[vt], 0, 0, 0);
            }
    float ss = 0.f;
#pragma unroll
    for (int vt = 0; vt < 4; vt++) ss += oa[vt][0] * oa[vt][0] + oa[vt][1] * oa[vt][1] + oa[vt][2] * oa[vt][2] + oa[vt][3] * oa[vt][3];
    ss += __shfl_xor(ss, 16); ss += __shfl_xor(ss, 32);
    const float rs = rsqrtf(ss * (1.f / 64.f) + EPSF);
#pragma unroll
    for (int vt = 0; vt < 4; vt++) {
        const int v0 = vt * 16 + q4 * 4;
        const float4 g = *(const float4*)&W_hgrn_norm_g[l * 64 + v0];
        const float4 gt = ld4bf(&W_P[(size_t)row * DIN + C_HG + h * 64 + v0]);
        st4bf(&W_CAT[(size_t)row * 1024 + h * 64 + v0],
              make_float4(oa[vt][0] * rs * g.x * siluf_(gt.x), oa[vt][1] * rs * g.y * siluf_(gt.y), oa[vt][2] * rs * g.z * siluf_(gt.z), oa[vt][3] * rs * g.w * siluf_(gt.w)));
    }
}

template <int LL>
__device__ __forceinline__ void hyena_unit(const Params& p, int l, int b, int cp, float* sm) {
    constexpr int NT = LL / 256;
    float zprev[NT];
#pragma unroll 1
    for (int chh = 0; chh < 2; chh++) {
    const int c = cp * 2 + chh;
    constexpr bool isctx = (LL == 256);
    const int tid = TIDX;
    float* zs = sm;
    float* kc = sm + LL;
    const int rowbase = isctx ? NLAT + b * 256 : b * 2048;
    float z[NT], x1[NT], x2[NT];
#pragma unroll
    for (int i = 0; i < NT; i++) {
        const int t = tid + 256 * i;
        float val[3];
#pragma unroll
        for (int q = 0; q < 3; q++) {
            const int chn = q * 256 + c;
            const int col = C_HY + chn;
            const float um = t > 0 ? bf2f(W_P[(size_t)(rowbase + t - 1) * DIN + col]) : 0.f;
            const float u0 = bf2f(W_P[(size_t)(rowbase + t) * DIN + col]);
            const float up = t < LL - 1 ? bf2f(W_P[(size_t)(rowbase + t + 1) * DIN + col]) : 0.f;
            val[q] = W_hy_short_w[(l * 3 + 0) * 768 + chn] * um + W_hy_short_w[(l * 3 + 1) * 768 + chn] * u0 + W_hy_short_w[(l * 3 + 2) * 768 + chn] * up +
                     W_hy_short_b[l * 768 + chn];
        }
        z[i] = val[0]; x1[i] = val[1]; x2[i] = val[2];
    }
#pragma unroll
    for (int o = 0; o < 2; o++) {
        const float* kbase = W_HYKC + (size_t)((l * 2 + o) * 256 + c) * 2 * LL;
        __syncthreads();
        for (int i = tid; i < 2 * LL - 1; i += 256) { const int d = i - (LL - 1); kc[i] = d >= 0 ? kbase[d] : kbase[LL - d]; }
#pragma unroll
        for (int i = 0; i < NT; i++) zs[tid + 256 * i] = z[i];
        __syncthreads();
        float acc[NT];
#pragma unroll
        for (int i = 0; i < NT; i++) acc[i] = 0.f;
        for (int s = 0; s < LL; s++) {
            const float zv = zs[s];
#pragma unroll
            for (int i = 0; i < NT; i++) acc[i] += kc[(tid + 256 * i) - s + (LL - 1)] * zv;
        }
        const float dbv = W_hy_bias[(l * 2 + o) * 256 + c];
#pragma unroll
        for (int i = 0; i < NT; i++) z[i] = (o == 0 ? x1[i] : x2[i]) * (acc[i] + dbv * z[i]);
    }
    if (chh == 0) {
#pragma unroll
        for (int i = 0; i < NT; i++) zprev[i] = z[i];
    } else {
#pragma unroll
        for (int i = 0; i < NT; i++) *(unsigned*)&W_CAT[(size_t)(rowbase + tid + 256 * i) * 1024 + 256 + cp * 2] = pack2bf(zprev[i], z[i]);
    }
    }
}

__device__ __forceinline__ void hyena_fft_unit(const Params& p, int l, int bp, int cp, float* sm) {
    const int tid = TIDX;
    float2* fb = (float2*)sm;
    float* raw = sm + 8704;
    bf16_t* zp = (bf16_t*)(sm + 12808);
    float2* twl = (float2*)(sm + 14856);
    __syncthreads();
    { const float2* twg = W_TW;
#pragma unroll
      for (int i = 0; i < 4; i++) twl[tid + 256 * i] = twg[tid + 256 * i]; }
    if (tid < 2) { raw[tid * 2050] = 0.f; raw[tid * 2050 + 2049] = 0.f; }
#pragma unroll 1
    for (int chh = 0; chh < 2; chh++) {
        const int c = cp * 2 + chh;
        float z[2][8];
#pragma unroll 1
        for (int st = 0; st < 3; st++) {
            if (st > 0) {
                const int o = st - 1;
                float2 v[4][4];
#pragma unroll
                for (int r1 = 0; r1 < 4; r1++)
#pragma unroll
                    for (int r2 = 0; r2 < 4; r2++) v[r1][r2] = r1 < 2 ? make_float2(z[0][(r1 & 1) * 4 + r2], z[1][(r1 & 1) * 4 + r2]) : make_float2(0.f, 0.f);
                fft_fwd_pass<0>(v, tid, twl);
                fft_lds_write<0>(v, tid, fb);
                __syncthreads();
                const float2* ks = W_KSPEC + (size_t)((l * 2 + o) * 256 + c) * 4096 + tid * 16;
                float2 kv[16];
#pragma unroll
                for (int j = 0; j < 16; j++) kv[j] = ks[j];
                fft_lds_read<2>(v, tid, fb);
                fft_fwd_pass<2>(v, tid, twl);
                fft_lds_write<2>(v, tid, fb);
                __syncthreads();
                fft_lds_read<4>(v, tid, fb);
                fft_fwd_pass<4>(v, tid, twl);
#pragma unroll
                for (int r1 = 0; r1 < 4; r1++)
#pragma unroll
                    for (int r2 = 0; r2 < 4; r2++) v[r1][r2] = cmul(v[r1][r2], kv[r1 * 4 + r2]);
                fft_inv_pass<4>(v, tid, twl);
                fft_lds_write<4>(v, tid, fb);
                __syncthreads();
                fft_lds_read<2>(v, tid, fb);
                fft_inv_pass<2>(v, tid, twl);
                fft_lds_write<2>(v, tid, fb);
                __syncthreads();
                fft_lds_read<0>(v, tid, fb);
                fft_inv_pass<0>(v, tid, twl);
                const float dbv = W_hy_bias[(l * 2 + o) * 256 + c];
#pragma unroll
                for (int r1 = 0; r1 < 2; r1++)
#pragma unroll
                    for (int r2 = 0; r2 < 4; r2++) {
                        const int i = r1 * 4 + r2;
                        z[0][i] = v[r1][r2].x + dbv * z[0][i];
                        z[1][i] = v[r1][r2].y + dbv * z[1][i];
                    }
            }
            const int chn = st * 256 + c;
#pragma unroll 1
            for (int b2 = 0; b2 < 2; b2++)
#pragma unroll 4
                for (int i = 0; i < 8; i++) {
                    const int t = tid + 256 * i;
                    raw[b2 * 2050 + 1 + t] = bf2f(W_HYT[((size_t)(bp * 2 + b2) * 768 + chn) * 2048 + t]);
                }
            __syncthreads();
            const float w0 = W_hy_short_w[(l * 3 + 0) * 768 + chn], w1 = W_hy_short_w[(l * 3 + 1) * 768 + chn], w2 = W_hy_short_w[(l * 3 + 2) * 768 + chn];
            const float sb = W_hy_short_b[l * 768 + chn];
#pragma unroll
            for (int b2 = 0; b2 < 2; b2++)
#pragma unroll
                for (int i = 0; i < 8; i++) {
                    const int t = tid + 256 * i;
                    const float val = w0 * raw[b2 * 2050 + t] + w1 * raw[b2 * 2050 + t + 1] + w2 * raw[b2 * 2050 + t + 2] + sb;
                    z[b2][i] = st == 0 ? val : val * z[b2][i];
                }
            __syncthreads();
        }
        if (chh == 0) {
#pragma unroll
            for (int b2 = 0; b2 < 2; b2++)
#pragma unroll
                for (int i = 0; i < 8; i++) zp[(b2 * 8 + i) * 256 + tid] = f2bf(z[b2][i]);
        } else {
#pragma unroll
            for (int b2 = 0; b2 < 2; b2++)
#pragma unroll
                for (int i = 0; i < 8; i++)
                    *(unsigned*)&W_CAT[(size_t)((bp * 2 + b2) * 2048 + tid + 256 * i) * 1024 + 256 + cp * 2] = ((unsigned)zp[(b2 * 8 + i) * 256 + tid] | ((unsigned)f2bf(z[b2][i]) << 16));
        }
    }
}

__device__ void phase_mix(const Params& p, int l, float* sm) {
    const bool need_ctx = l < DEPTH - 1;
    const int G = gridDim.x, bid = BIDX;
    for (int u = wq_next(WQ(p, l, 3), sm); u < 512; u = wq_next(WQ(p, l, 3), sm)) hyena_fft_unit(p, l, u >> 7, u & 127, sm);
    for (int u = wq_next(WQ(p, l, 13), sm); u < 1024; u = wq_next(WQ(p, l, 13), sm)) hgrn_scan_unit(p, l, u);
    for (int u = wq_next(WQ(p, l, 4), sm); u < 1024; u = wq_next(WQ(p, l, 4), sm)) na_unit(p, l, u, false, sm);
    if (need_ctx) {
        for (int u = wq_next(WQ(p, l, 5), sm); u < 128; u = wq_next(WQ(p, l, 5), sm)) na_unit(p, l, u, true, sm);
        for (int u = wq_next(WQ(p, l, 6), sm); u < 1024; u = wq_next(WQ(p, l, 6), sm)) hyena_unit<256>(p, l, u >> 7, u & 127, sm);
    }
}
__device__ void phase_mix2(const Params& p, int l, float* sm) {
    const bool need_ctx = l < DEPTH - 1;
    const int G = gridDim.x, bid = BIDX;
    for (int u = wq_next(WQ(p, l, 7), sm); u < 512; u = wq_next(WQ(p, l, 7), sm)) mla_unit(p, l, u, false, sm);
    for (int u = wq_next(WQ(p, l, 8), sm); u < 1152; u = wq_next(WQ(p, l, 8), sm)) { if (need_ctx || (u % 36) >= 4) hgrn_final_unit(p, l, u, sm); }
    if (need_ctx) for (int u = wq_next(WQ(p, l, 9), sm); u < 64; u = wq_next(WQ(p, l, 9), sm)) mla_unit(p, l, u, true, sm);
}

__device__ void phase_gemm2(const Params& p, int l, float* sm) {
    const int nrows = (l < DEPTH - 1) ? TT : NLAT;
    const float* W = p.w_out + (size_t)l * 1024 * 1024;
    const int tid = TIDX, lane = tid & 63, w = tid >> 6, wm = w >> 1, wn = w & 1, r16 = lane & 15, q = lane >> 4;
    for (int u = wq_next(WQ(p, l, 10), sm); u < (nrows / 128) * 8; u = wq_next(WQ(p, l, 10), sm)) {
        const int rb = u >> 3, cb = u & 7;
        const int r0 = rb * 128, n0 = cb * 128;
        const float* g1 = W_MOD + (size_t)(l * 9 + bidx_of(r0)) * 6144 + 2048;
        f32x4 acc[4][4];
        const bf16_t* cb_ = W_CAT + (size_t)r0 * 1024;
        const bf16_t* wb = W_WOUTT + (size_t)l * 1024 * 1024 + (size_t)n0 * 1024;
        gemm128_bt<true>(1024, (char*)sm, [&](int r) { return cb_ + (size_t)r * 1024; }, [&](int r) { return wb + (size_t)r * 1024; }, acc);
#pragma unroll
        for (int i = 0; i < 4; i++)
#pragma unroll
            for (int j = 0; j < 4; j++) {
                const int m = r0 + wm * 64 + i * 16 + r16, n = n0 + wn * 64 + j * 16 + q * 4;
                const float* xsrc = l > 0 ? &W_X[(size_t)m * 1024 + n] : (m < NLAT ? &p.x[(size_t)m * 1024 + n] : &p.ctx[(size_t)(m - NLAT) * 1024 + n]);
                float4 xv = *(const float4*)xsrc;
                const float4 g = *(const float4*)&g1[n];
                xv.x += g.x * acc[i][j][0]; xv.y += g.y * acc[i][j][1]; xv.z += g.z * acc[i][j][2]; xv.w += g.w * acc[i][j][3];
                *(float4*)&W_X[(size_t)m * 1024 + n] = xv;
            }
    }
}

__device__ void phase_norm2(const Params& p, int l, float* sm) {
    const int tid = TIDX, wave = tid >> 6, lane = tid & 63, r16 = lane & 15, kq = lane >> 4;
    const int nrows = (l < DEPTH - 1) ? TT : NLAT;
    float* red = sm;
    float* lg = sm + 64;
    for (int t16 = wq_next(WQ(p, l, 14), sm); t16 < nrows / 16; t16 = wq_next(WQ(p, l, 14), sm)) {
        const int row = t16 * 16 + r16;
        const int bi = bidx_of(t16 * 16);
        const int kb = wave * 256 + kq * 64;
        const float* xr = W_X + (size_t)row * 1024 + kb;
        float ss = 0.f;
#pragma unroll
        for (int i = 0; i < 16; i++) { const float4 v = *(const float4*)&xr[i * 4]; ss += v.x * v.x + v.y * v.y + v.z * v.z + v.w * v.w; }
        ss += __shfl_xor(ss, 16); ss += __shfl_xor(ss, 32);
        if (kq == 0) red[wave * 16 + r16] = ss;
        __syncthreads();
        const float rstd = rsqrtf((red[r16] + red[16 + r16] + red[32 + r16] + red[48 + r16]) * (1.f / 1024.f) + EPSF);
        const float* md = W_MOD + (size_t)(l * 9 + bi) * 6144 + kb;
        const float* gn = W_norm2_g + l * 1024 + kb;
        const float* we = W_moe_we + (size_t)(l * 1024 + kb) * 32 + r16;
        const float* wg = W_moe_wg + (size_t)(l * 1024 + kb) * 4 + (r16 & 3);
        bf16_t* hr = W_H + (size_t)row * 1024 + kb;
        f32x4 a0 = (f32x4){0.f, 0.f, 0.f, 0.f}, a1 = a0, a2 = a0;
#pragma unroll 2
        for (int i = 0; i < 16; i++) {
            const float4 xq = *(const float4*)&xr[i * 4];
            const float4 g = *(const float4*)&gn[i * 4];
            const float4 sh = *(const float4*)&md[3072 + i * 4];
            const float4 sc = *(const float4*)&md[4096 + i * 4];
            float h[4];
            h[0] = xq.x * rstd * g.x * (1.f + sc.x) + sh.x; h[1] = xq.y * rstd * g.y * (1.f + sc.y) + sh.y;
            h[2] = xq.z * rstd * g.z * (1.f + sc.z) + sh.z; h[3] = xq.w * rstd * g.w * (1.f + sc.w) + sh.w;
            st4bf(hr + i * 4, make_float4(h[0], h[1], h[2], h[3]));
#pragma unroll
            for (int e = 0; e < 4; e++) {
                const int k = i * 4 + e;
                const float b0 = we[k * 32], b1 = we[k * 32 + 16];
                const float b2 = r16 < 4 ? wg[k * 4] : 0.f;
                a0 = __builtin_amdgcn_mfma_f32_16x16x4f32(h[e], b0, a0, 0, 0, 0);
                a1 = __builtin_amdgcn_mfma_f32_16x16x4f32(h[e], b1, a1, 0, 0, 0);
                a2 = __builtin_amdgcn_mfma_f32_16x16x4f32(h[e], b2, a2, 0, 0, 0);
            }
        }
        float* lw = lg + wave * 768;
#pragma unroll
        for (int e = 0; e < 4; e++) {
            lw[(kq * 4 + e) * 48 + r16] = a0[e];
            lw[(kq * 4 + e) * 48 + 16 + r16] = a1[e];
            lw[(kq * 4 + e) * 48 + 32 + r16] = a2[e];
        }
        __syncthreads();
        if (tid < 16) {
            const float* L0 = lg + tid * 48;
            const int rrow = t16 * 16 + tid;
            float gl[4];
#pragma unroll
            for (int c = 0; c < 4; c++) gl[c] = L0[32 + c] + L0[768 + 32 + c] + L0[1536 + 32 + c] + L0[2304 + 32 + c] + W_moe_bg[l * 4 + c];
            int gs = 0; float best = gl[0];
#pragma unroll
            for (int c = 1; c < 4; c++) if (gl[c] > best) { best = gl[c]; gs = c; }
            float den = 0.f;
#pragma unroll
            for (int c = 0; c < 4; c++) den += expf(gl[c] - best);
            const float psel = 1.f / den;
            float le[8];
#pragma unroll
            for (int i = 0; i < 8; i++) { const int c = gs * 8 + i; le[i] = L0[c] + L0[768 + c] + L0[1536 + c] + L0[2304 + c] + W_moe_be[l * 32 + c]; }
            int i1 = 0; float v1 = le[0];
#pragma unroll
            for (int i = 1; i < 8; i++) if (le[i] > v1) { v1 = le[i]; i1 = i; }
            int i2 = -1; float v2 = -3.0e38f;
#pragma unroll
            for (int i = 0; i < 8; i++) if (i != i1 && le[i] > v2) { v2 = le[i]; i2 = i; }
            const float e2 = expf(v2 - v1);
            const float w1 = psel / (1.f + e2), w2 = psel * e2 / (1.f + e2);
            const int ea = gs * 8 + i1, eb = gs * 8 + i2;
            const int n0 = rrow * 2, n1 = rrow * 2 + 1;
            W_EW[n0] = w1; W_EW[n1] = w2;
            const int pa = atomicAdd(&W_cnt[l * 32 + ea], 1);
            W_LIST[(size_t)ea * TT + pa] = n0;
            const int pb = atomicAdd(&W_cnt[l * 32 + eb], 1);
            W_LIST[(size_t)eb * TT + pb] = n1;
        }
    }
}

__device__ void phase_moe1(const Params& p, int l, float* sm) {
    int* offs = (int*)(sm + 16384);
    int* ns = (int*)(sm + 16384 + 64);
    const int tid = TIDX, lane = tid & 63, w = tid >> 6, wm = w >> 1, wn = w & 1, r16 = lane & 15, q = lane >> 4;
    __syncthreads();
    if (tid == 0) { int a = 0; for (int e = 0; e < 32; e++) { offs[e] = a; a += (W_cnt[l * 32 + e] + 127) >> 7; } offs[32] = a; }
    __syncthreads();
    const int total = offs[32] * 8;
    for (int u = wq_next(WQ(p, l, 11), sm); u < total; u = wq_next(WQ(p, l, 11), sm)) {
        const int rbg = u >> 3, cb = u & 7;
        int e = 0;
        while (offs[e + 1] <= rbg) e++;
        const int rbi = rbg - offs[e];
        const int ce = W_cnt[l * 32 + e];
        __syncthreads();
        if (tid < 128) { const int idx = rbi * 128 + tid; ns[tid] = idx < ce ? W_LIST[(size_t)e * TT + idx] : -1; }
        __syncthreads();
        const int j0 = cb * 64;
        const bf16_t* hb = W_H;
        const int c = tid & 127;
        const int hid = j0 + (c >> 6) * 32 + ((c >> 4) & 1) * 16 + (c & 15);
        const float* wp = (((c >> 4) & 3) >= 2 ? p.moe_w_up : p.moe_w_gate) + (size_t)(l * 32 + e) * 1024 * 512 + hid;
        f32x4 acc[4][4];
        gemm128_main<true>(1024, (char*)sm, [&](int r) { return hb + (size_t)(max(ns[r], 0) >> 1) * 1024; },
                           [&](int k, int n) { return wp[(size_t)k * 512]; }, acc);
#pragma unroll
        for (int i = 0; i < 4; i++) {
            const int n = ns[wm * 64 + i * 16 + r16];
            if (n >= 0) {
#pragma unroll
                for (int j = 0; j < 2; j++) {
                    const int hh = j0 + wn * 32 + j * 16 + q * 4;
                    float4 a;
                    a.x = siluf_(acc[i][j][0]) * acc[i][j + 2][0]; a.y = siluf_(acc[i][j][1]) * acc[i][j + 2][1];
                    a.z = siluf_(acc[i][j][2]) * acc[i][j + 2][2]; a.w = siluf_(acc[i][j][3]) * acc[i][j + 2][3];
                    st4bf(&W_ACT[(size_t)n * 512 + hh], a);
                }
            }
        }
    }
}
__device__ void phase_moe2(const Params& p, int l, float* sm) {
    int* offs = (int*)(sm + 16384);
    int* ns = (int*)(sm + 16384 + 64);
    const int tid = TIDX, lane = tid & 63, w = tid >> 6, wm = w >> 1, wn = w & 1, r16 = lane & 15, q = lane >> 4;
    __syncthreads();
    if (tid == 0) { int a = 0; for (int e = 0; e < 32; e++) { offs[e] = a; a += (W_cnt[l * 32 + e] + 127) >> 7; } offs[32] = a; }
    __syncthreads();
    const int total = offs[32] * 8;
    for (int u = wq_next(WQ(p, l, 12), sm); u < total; u = wq_next(WQ(p, l, 12), sm)) {
        const int rbg = u >> 3, cb = u & 7;
        int e = 0;
        while (offs[e + 1] <= rbg) e++;
        const int rbi = rbg - offs[e];
        const int ce = W_cnt[l * 32 + e];
        __syncthreads();
        if (tid < 128) { const int idx = rbi * 128 + tid; ns[tid] = idx < ce ? W_LIST[(size_t)e * TT + idx] : -1; }
        __syncthreads();
        const int n0 = cb * 128;
        const bf16_t* ab_ = W_ACT;
        const float* wp = p.moe_w_down + (size_t)(l * 32 + e) * 512 * 1024 + n0 + (tid & 127);
        f32x4 acc[4][4];
        gemm128_main<true>(512, (char*)sm, [&](int r) { return ab_ + (size_t)max(ns[r], 0) * 512; }, [&](int k, int n) { return wp[(size_t)k * 1024]; }, acc);
#pragma unroll
        for (int i = 0; i < 4; i++) {
            const int n = ns[wm * 64 + i * 16 + r16];
            if (n >= 0) {
                const float wt = W_EW[n];
#pragma unroll
                for (int j = 0; j < 4; j++) {
                    const int col = n0 + wn * 64 + j * 16 + q * 4;
                    st4bf(&W_YEXP[(size_t)n * 1024 + col], make_float4(acc[i][j][0] * wt, acc[i][j][1] * wt, acc[i][j][2] * wt, acc[i][j][3] * wt));
                }
            }
        }
    }
}

enum { PH_PRO1 = 0, PH_PRO2, PH_NORM1, PH_GEMM1, PH_PREP, PH_MIX, PH_HGOUT, PH_GEMM2, PH_NORM2, PH_MOE1, PH_MOE2, PH_FINAL };

template <int PH>
__device__ __forceinline__ void run_phase(const Params& p, int l, float* sm) {
    if (PH == PH_PRO1) phase_pro1(p, sm);
    else if (PH == PH_PRO2) phase_pro2(p, sm);
    else if (PH == PH_NORM1) phase_norm1(p, l, sm);
    else if (PH == PH_GEMM1) phase_gemm1(p, l, sm);
    else if (PH == PH_PREP) phase_prep(p, l, sm);
    else if (PH == PH_MIX) phase_mix(p, l, sm);
    else if (PH == PH_HGOUT) phase_mix2(p, l, sm);
    else if (PH == PH_GEMM2) phase_gemm2(p, l, sm);
    else if (PH == PH_NORM2) phase_norm2(p, l, sm);
    else if (PH == PH_MOE1) phase_moe1(p, l, sm);
    else if (PH == PH_MOE2) phase_moe2(p, l, sm);
    else if (PH == PH_FINAL) phase_final(p, sm);
}

#if !MEGA
template <int PH>
__global__ void __launch_bounds__(256, 2) k_phase(Params p, int l) {
    __shared__ float sm[SMF];
    run_phase<PH>(p, l, sm);
}
#else
__global__ void __launch_bounds__(256, 2) k_mega(Params p) {
    __shared__ float sm[SMF];
    __shared__ uint4 xb_words;
    if (TIDX == 0) xb_words = make_uint4(0u, 0u, 0u, 0u);
    __syncthreads();
    if (threadIdx.x == 0) ((int*)sm)[SMF - 2] = 0;
    __syncthreads();
    XcdBarrier bar = xcd_barrier_post(W_bar, (volatile LAS unsigned*)&xb_words);
#if USE_CG
#define xcd_barrier(b) cooperative_groups::this_grid().sync()
#endif
    for (int r = 0; r < p.rep[PH_PRO1]; r++) { if (threadIdx.x == 0) ((int*)sm)[SMF - 2] = r; __syncthreads(); run_phase<PH_PRO1>(p, 0, sm); xcd_barrier(bar); }
    for (int r = 0; r < p.rep[PH_PRO2]; r++) { if (threadIdx.x == 0) ((int*)sm)[SMF - 2] = r; __syncthreads(); run_phase<PH_PRO2>(p, 0, sm); xcd_barrier(bar); }
    for (int l = 0; l < DEPTH; l++) {
        if (threadIdx.x == 0) ((int*)sm)[SMF - 2] = 0; __syncthreads(); run_phase<PH_NORM1>(p, l, sm); xcd_barrier(bar);
        for (int r = 0; r < p.rep[PH_GEMM1]; r++) { if (threadIdx.x == 0) ((int*)sm)[SMF - 2] = r; __syncthreads(); run_phase<PH_GEMM1>(p, l, sm); xcd_barrier(bar); }
        for (int r = 0; r < p.rep[PH_PREP]; r++) { if (threadIdx.x == 0) ((int*)sm)[SMF - 2] = r; __syncthreads(); run_phase<PH_PREP>(p, l, sm); xcd_barrier(bar); }
        for (int r = 0; r < p.rep[PH_MIX]; r++) { if (threadIdx.x == 0) ((int*)sm)[SMF - 2] = r; __syncthreads(); run_phase<PH_MIX>(p, l, sm); xcd_barrier(bar); }
        for (int r = 0; r < p.rep[PH_HGOUT]; r++) { if (threadIdx.x == 0) ((int*)sm)[SMF - 2] = r; __syncthreads(); run_phase<PH_HGOUT>(p, l, sm); xcd_barrier(bar); }
        if (threadIdx.x == 0) ((int*)sm)[SMF - 2] = 0; __syncthreads(); run_phase<PH_GEMM2>(p, l, sm); xcd_barrier(bar);
        run_phase<PH_NORM2>(p, l, sm); xcd_barrier(bar);
        for (int r = 0; r < p.rep[PH_MOE1]; r++) { if (threadIdx.x == 0) ((int*)sm)[SMF - 2] = r; __syncthreads(); run_phase<PH_MOE1>(p, l, sm); xcd_barrier(bar); }
        for (int r = 0; r < p.rep[PH_MOE2]; r++) { if (threadIdx.x == 0) ((int*)sm)[SMF - 2] = r; __syncthreads(); run_phase<PH_MOE2>(p, l, sm); xcd_barrier(bar); }
    }
    run_phase<PH_FINAL>(p, 0, sm);
}
#endif

static inline size_t align_up(size_t v, size_t a) { return (v + a - 1) / a * a; }

extern "C" void kernel_launch(void* const* d_in, const int* in_sizes, int n_in, void* d_out, int out_size, void* d_ws, size_t ws_size,
                              hipStream_t stream) {
    Params p{};
    const float* const* in = (const float* const*)d_in;
    p.x = in[0]; p.c = in[1]; p.ctx = in[2]; p.c_ctx = in[3]; p.w_ada = in[4]; p.b_ada = in[5]; p.norm1_g = in[6]; p.norm2_g = in[7];
    p.w_in = in[8]; p.w_out = in[9]; p.lb_logits = in[10]; p.hgrn_norm_g = in[11];
    p.hy_short_w = in[12]; p.hy_short_b = in[13]; p.hy_w1 = in[14]; p.hy_b1 = in[15]; p.hy_freq = in[16]; p.hy_w2 = in[17]; p.hy_b2 = in[18];
    p.hy_w3 = in[19]; p.hy_b3 = in[20]; p.hy_decay = in[21]; p.hy_bias = in[22];
    p.na_rpb = in[23]; p.na_q_g = in[24]; p.na_k_g = in[25];
    p.mla_q_a_g = in[26]; p.mla_kv_a_g = in[27]; p.mla_w_uq = in[28]; p.mla_w_ukv = in[29]; p.mla_q_g = in[30]; p.mla_k_g = in[31];
    p.moe_wg = in[32]; p.moe_bg = in[33]; p.moe_we = in[34]; p.moe_be = in[35]; p.moe_w_gate = in[36]; p.moe_w_up = in[37]; p.moe_w_down = in[38];
    p.out = (float*)d_out;
    for (int i = 0; i < 16; i++) p.rep[i] = 1;
#ifdef PROBE_PH
    p.rep[PROBE_PH] = 2;
#endif
#ifdef PROBE_PH2
    p.rep[PROBE_PH2] = 2;
#endif

    p.ws = (char*)d_ws;
    const size_t off = WS_TOTAL;
    if (off > ws_size) { fprintf(stderr, "workspace too small: need %zu have %zu\n", off, ws_size); return; }

#if !MEGA
#ifndef BIGMASK
#define BIGMASK 0xFFF
#endif
#define GR(ph) (((BIGMASK >> (ph)) & 1) ? 1024 : 256)
    k_phase<PH_PRO1><<<GR(PH_PRO1), 256, 0, stream>>>(p, 0);
    k_phase<PH_PRO2><<<GR(PH_PRO2), 256, 0, stream>>>(p, 0);
    for (int l = 0; l < DEPTH; l++) {
        k_phase<PH_NORM1><<<GR(PH_NORM1), 256, 0, stream>>>(p, l);
        k_phase<PH_GEMM1><<<GR(PH_GEMM1), 256, 0, stream>>>(p, l);
        k_phase<PH_PREP><<<GR(PH_PREP), 256, 0, stream>>>(p, l);
        k_phase<PH_MIX><<<GR(PH_MIX), 256, 0, stream>>>(p, l);
        k_phase<PH_HGOUT><<<GR(PH_HGOUT), 256, 0, stream>>>(p, l);
        k_phase<PH_GEMM2><<<GR(PH_GEMM2), 256, 0, stream>>>(p, l);
        k_phase<PH_NORM2><<<GR(PH_NORM2), 256, 0, stream>>>(p, l);
        k_phase<PH_MOE1><<<GR(PH_MOE1), 256, 0, stream>>>(p, l);
        k_phase<PH_MOE2><<<GR(PH_MOE2), 256, 0, stream>>>(p, l);
    }
    k_phase<PH_FINAL><<<GR(PH_FINAL), 256, 0, stream>>>(p, 0);
#else
    static int grid = 0;
    if (!grid) {
        int dev = 0, cus = 0, per_cu = 0;
        hipGetDevice(&dev);
        hipDeviceGetAttribute(&cus, hipDeviceAttributeMultiprocessorCount, dev);
        hipOccupancyMaxActiveBlocksPerMultiprocessor(&per_cu, k_mega, 256, 0);
        if (per_cu > 2) per_cu = 2;
        if (per_cu < 1) per_cu = 1;
        grid = cus * per_cu;
    }
    hipMemsetAsync(p.ws + OFF_bar, 0, (XCD_BAR_WORDS + WQ_WORDS) * sizeof(unsigned), stream);
#if USE_CG
    { void* args[] = {&p}; hipLaunchCooperativeKernel((void*)k_mega, dim3(grid), dim3(256), args, 0, stream); }
#else
    k_mega<<<grid, 256, 0, stream>>>(p);
#endif
#endif
}
```

```cpp
#include <hip/hip_runtime.h>
#include <stdint.h>
#include <stdio.h>
#include <hip/hip_cooperative_groups.h>
#define USE_CG 0

#ifndef MEGA
#define MEGA 1
#endif

#define DM 1024
#define NB 8
#define SEQ 2048
#define CTXL 256
#define NLAT (NB * SEQ)
#define NCTX (NB * CTXL)
#define TT (NLAT + NCTX)
#define DIN 3232
#define DEPTH 4
#define EPSF 1e-6f
#define C_HQ 0
#define C_ZF 256
#define C_ZB 512
#define C_HI 768
#define C_HG 1024
#define C_HY 1280
#define C_NA 2048
#define C_CQ 2816
#define C_CKV 3072
#define C_KR 3200

#define SMF 17920

typedef unsigned short bf16_t;

struct Params {
    const float *x, *c, *ctx, *c_ctx, *w_ada, *b_ada, *norm1_g, *norm2_g, *w_in, *w_out, *lb_logits, *hgrn_norm_g;
    const float *hy_short_w, *hy_short_b, *hy_w1, *hy_b1, *hy_freq, *hy_w2, *hy_b2, *hy_w3, *hy_b3, *hy_decay, *hy_bias;
    const float *na_rpb, *na_q_g, *na_k_g, *mla_q_a_g, *mla_kv_a_g, *mla_w_uq, *mla_w_ukv, *mla_q_g, *mla_k_g;
    const float *moe_wg, *moe_bg, *moe_we, *moe_be, *moe_w_gate, *moe_w_up, *moe_w_down;
    float* out;
    char* ws;
    int rep[16];
};

#define XB_TMO      128
#define XB_XCNT(j)  (256  + 64 * (j))
#define XB_XSUB(j)  (1280 + 64 * (j))
#define XB_XGEN(j)  (2304 + 64 * (j))
#define XB_TOP      3328
#define XB_TOPGEN   3392
#define XCD_BAR_WORDS 3456
#define XB_SPIN_CAP (1u << 22)
#define LAS __attribute__((address_space(3)))

__device__ __forceinline__ unsigned xb_ld(unsigned* p)              { return __hip_atomic_load(p, __ATOMIC_RELAXED, __HIP_MEMORY_SCOPE_AGENT); }
__device__ __forceinline__ unsigned xb_add(unsigned* p, unsigned v) { return __hip_atomic_fetch_add(p, v, __ATOMIC_RELAXED, __HIP_MEMORY_SCOPE_AGENT); }
__device__ __forceinline__ unsigned xb_xcc_id() { return (unsigned)__builtin_amdgcn_s_getreg((3 << 11) | 20) & 0xFu; }
#define XB_SPIN(cond, bar) do { unsigned _sp = 0; while (cond) { __builtin_amdgcn_s_sleep(1); \
    if ((++_sp & 255u) == 0u) { if (xb_ld(&(bar)[XB_TMO])) break; if (_sp > XB_SPIN_CAP) { atomicAdd(&(bar)[XB_TMO], 1u); break; } } } } while (0)

struct XcdBarrier { unsigned* bar; unsigned x; volatile LAS unsigned* st; };

__device__ __forceinline__ XcdBarrier xcd_barrier_post(unsigned* bar, volatile LAS unsigned* st) {
    XcdBarrier b; b.bar = bar; b.x = xb_xcc_id(); b.st = st;
    if (threadIdx.x == 0) (void)xb_add(&bar[XB_XCNT(b.x)], 1u);
    return b;
}
__device__ __forceinline__ void xcd_barrier_complete(unsigned* bar, unsigned x, unsigned& nloc, unsigned& nx) {
    const unsigned G = gridDim.x * gridDim.y * gridDim.z;
    unsigned sum, cnt, mine, sp = 0u;
    for (;;) {
        sum = 0u; cnt = 0u; mine = 0u;
#pragma unroll
        for (unsigned j = 0; j < 16; ++j) { const unsigned c = xb_ld(&bar[XB_XCNT(j)]); sum += c; cnt += (c > 0u) ? 1u : 0u; mine = (j == x) ? c : mine; }
        if (sum == G) break;
        __builtin_amdgcn_s_sleep(1);
        if ((++sp & 255u) == 0u) { if (xb_ld(&bar[XB_TMO])) break; if (sp > XB_SPIN_CAP) { atomicAdd(&bar[XB_TMO], 1u); break; } }
    }
    nloc = mine > 0u ? mine : 1u; nx = cnt > 0u ? cnt : 1u;
}
__device__ __forceinline__ void xcd_barrier(const XcdBarrier& b) {
    asm volatile("s_waitcnt vmcnt(0)" ::: "memory");
    __syncthreads();
    if (threadIdx.x == 0) {
        unsigned* bar = b.bar;
        __builtin_amdgcn_s_waitcnt(0);
        unsigned nloc = b.st[0], nx = b.st[1];
        if (nloc == 0u) { xcd_barrier_complete(bar, b.x, nloc, nx); b.st[0] = nloc; b.st[1] = nx; }
        const unsigned old = xb_add(&bar[XB_XSUB(b.x)], 1u);
        const unsigned gen = old / nloc;
        if (old + 1u == (gen + 1u) * nloc) {
            __builtin_amdgcn_fence(__ATOMIC_RELEASE, "agent");
            asm volatile("s_waitcnt vmcnt(0)" ::: "memory");
            const unsigned og = xb_add(&bar[XB_TOP], 1u);
            const unsigned tg = og / nx;
            if (og + 1u == (tg + 1u) * nx) xb_add(&bar[XB_TOPGEN], 1u);
            else XB_SPIN(xb_ld(&bar[XB_TOPGEN]) == tg, bar);
            __builtin_amdgcn_fence(__ATOMIC_ACQUIRE, "agent");
            xb_add(&bar[XB_XGEN(b.x)], 1u);
            asm volatile("s_waitcnt vmcnt(0)" ::: "memory");
        } else {
            XB_SPIN(xb_ld(&bar[XB_XGEN(b.x)]) == gen, bar);
            __builtin_amdgcn_fence(__ATOMIC_ACQUIRE, "agent");
            asm volatile("s_waitcnt vmcnt(0)" ::: "memory");
        }
    }
    __syncthreads();
}

__device__ __forceinline__ int tid_opaque() { int t = threadIdx.x; asm volatile("" : "+v"(t)); return t; }
__device__ __forceinline__ int bid_opaque() { int t = blockIdx.x; asm volatile("" : "+s"(t)); return t; }
#define TIDX tid_opaque()
#define BIDX bid_opaque()
typedef __attribute__((ext_vector_type(8))) short bf16x8;
typedef __attribute__((ext_vector_type(4))) float f32x4;
typedef __attribute__((ext_vector_type(4))) unsigned u32x4;
typedef __attribute__((ext_vector_type(2))) __bf16 bf16x2_t;
__device__ __forceinline__ bf16_t f2bf(float f) { return __builtin_bit_cast(bf16_t, (__bf16)f); }
__device__ __forceinline__ float bf2f(bf16_t h) { return __uint_as_float(((unsigned)h) << 16); }
__device__ __forceinline__ unsigned pack2bf(float a, float b) { bf16x2_t v; v[0] = (__bf16)a; v[1] = (__bf16)b; return __builtin_bit_cast(unsigned, v); }
__device__ __forceinline__ float4 ld4bf(const bf16_t* p) { const uint2 u = *(const uint2*)p; float4 r; r.x = __uint_as_float(u.x << 16); r.y = __uint_as_float(u.x & 0xFFFF0000u); r.z = __uint_as_float(u.y << 16); r.w = __uint_as_float(u.y & 0xFFFF0000u); return r; }
__device__ __forceinline__ void st4bf(bf16_t* p, float4 v) { uint2 u; u.x = pack2bf(v.x, v.y); u.y = pack2bf(v.z, v.w); *(uint2*)p = u; }
__device__ __forceinline__ float wave_sum(float v) {
#pragma unroll
    for (int o = 32; o > 0; o >>= 1) v += __shfl_xor(v, o);
    return v;
}
__device__ __forceinline__ float sigmoidf_(float z) { return 1.f / (1.f + __expf(-z)); }
__device__ __forceinline__ float siluf_(float z) { return z / (1.f + __expf(-z)); }
__device__ __forceinline__ int bidx_of(int row) { return row < NLAT ? (row >> 11) : 8; }
__device__ __forceinline__ int kv_pos(int kidx) { const int w = kidx & 31; return (kidx & ~31) | (((w >> 2) & 3) * 8 + (w >> 4) * 4 + (w & 3)); }

__device__ __forceinline__ float block_sum(float v, float* red) {
    v = wave_sum(v);
    __syncthreads();
    if ((TIDX & 63) == 0) red[TIDX >> 6] = v;
    __syncthreads();
    float r = red[0] + red[1] + red[2] + red[3];
    __syncthreads();
    return r;
}

typedef __attribute__((address_space(1))) char gchar_t;
__device__ __forceinline__ gchar_t* ws_opaque(char* w) { gchar_t* g = (gchar_t*)w; asm volatile("" : "+s"(g)); return g; }
#define WQ_SLOTS 32
#define WQ_WORDS ((DEPTH + 1) * WQ_SLOTS * 16)
constexpr size_t ws_al(size_t v) { return (v + 255) / 256 * 256; }
#define WSB(p) ws_opaque((p).ws)
constexpr size_t OFF_bar = 0;
constexpr size_t OFF_cnt = ws_al(OFF_bar + ((XCD_BAR_WORDS + WQ_WORDS) * 4));
constexpr size_t OFF_X = ws_al(OFF_cnt + (DEPTH * 32 * 4));
constexpr size_t OFF_MOD = ws_al(OFF_X + ((size_t)TT * 1024 * 4));
constexpr size_t OFF_LB = ws_al(OFF_MOD + ((size_t)DEPTH * 9 * 6144 * 4));
constexpr size_t OFF_HDN = ws_al(OFF_LB + (DEPTH * 512 * 4));
constexpr size_t OFF_TW = ws_al(OFF_HDN + ((size_t)DEPTH * 2 * 2048 * 64 * 4));
constexpr size_t OFF_KSPEC = ws_al(OFF_TW + (4096 * 8));
constexpr size_t OFF_HYKC = ws_al(OFF_KSPEC + ((size_t)DEPTH * 2 * 256 * 4096 * 8));
constexpr size_t OFF_H = ws_al(OFF_HYKC + ((size_t)DEPTH * 2 * 256 * 2 * 256 * 4));
constexpr size_t OFF_P = ws_al(OFF_H + ((size_t)TT * 1024 * 2));
constexpr size_t OFF_OF = ws_al(OFF_P + ((size_t)TT * DIN * 2));
constexpr size_t OFF_HU = ws_al(OFF_OF + ((size_t)TT * 256 * 4));
constexpr size_t OFF_HQ = ws_al(OFF_HU + ((size_t)1152 * 2 * 4096 * 4));
constexpr size_t OFF_HD = ws_al(OFF_HQ + ((size_t)1152 * 2 * 4096 * 4));
constexpr size_t OFF_NQ = ws_al(OFF_HD + ((size_t)1152 * 2 * 64 * 4));
constexpr size_t OFF_NK = ws_al(OFF_NQ + ((size_t)TT * 256 * 2));
constexpr size_t OFF_NVT = ws_al(OFF_NK + ((size_t)TT * 256 * 2));
constexpr size_t OFF_MQ = ws_al(OFF_NVT + ((size_t)NB * 4 * 64 * 2304 * 2));
constexpr size_t OFF_MK = ws_al(OFF_MQ + ((size_t)TT * 384 * 2));
constexpr size_t OFF_MVT = ws_al(OFF_MK + ((size_t)TT * 384 * 2));
constexpr size_t OFF_CAT = ws_al(OFF_MVT + ((size_t)NB * 4 * 64 * 2304 * 2));
constexpr size_t OFF_EW = ws_al(OFF_CAT + ((size_t)TT * 1024 * 2));
constexpr size_t OFF_LIST = ws_al(OFF_EW + ((size_t)TT * 2 * 4));
constexpr size_t OFF_ACT = ws_al(OFF_LIST + ((size_t)32 * TT * 4));
constexpr size_t OFF_YEXP = ws_al(OFF_ACT + ((size_t)TT * 2 * 512 * 2));
constexpr size_t OFF_norm1_g = ws_al(OFF_YEXP + ((size_t)TT * 2 * 1024 * 4));
constexpr size_t OFF_norm2_g = ws_al(OFF_norm1_g + ((size_t)(DEPTH * 1024) * 4));
constexpr size_t OFF_hgrn_norm_g = ws_al(OFF_norm2_g + ((size_t)(DEPTH * 1024) * 4));
constexpr size_t OFF_hy_short_w = ws_al(OFF_hgrn_norm_g + ((size_t)(DEPTH * 64) * 4));
constexpr size_t OFF_hy_short_b = ws_al(OFF_hy_short_w + ((size_t)(DEPTH * 3 * 768) * 4));
constexpr size_t OFF_hy_bias = ws_al(OFF_hy_short_b + ((size_t)(DEPTH * 768) * 4));
constexpr size_t OFF_na_rpb = ws_al(OFF_hy_bias + ((size_t)(DEPTH * 2 * 256) * 4));
constexpr size_t OFF_na_q_g = ws_al(OFF_na_rpb + ((size_t)(DEPTH * 4 * 15 * 31) * 4));
constexpr size_t OFF_na_k_g = ws_al(OFF_na_q_g + ((size_t)(DEPTH * 64) * 4));
constexpr size_t OFF_mla_q_a_g = ws_al(OFF_na_k_g + ((size_t)(DEPTH * 64) * 4));
constexpr size_t OFF_mla_kv_a_g = ws_al(OFF_mla_q_a_g + ((size_t)(DEPTH * 256) * 4));
constexpr size_t OFF_mla_w_uq = ws_al(OFF_mla_kv_a_g + ((size_t)(DEPTH * 128) * 4));
constexpr size_t OFF_mla_w_ukv = ws_al(OFF_mla_w_uq + ((size_t)(DEPTH * 256 * 384) * 4));
constexpr size_t OFF_mla_q_g = ws_al(OFF_mla_w_ukv + ((size_t)(DEPTH * 128 * 512) * 4));
constexpr size_t OFF_mla_k_g = ws_al(OFF_mla_q_g + ((size_t)(DEPTH * 96) * 4));
constexpr size_t OFF_moe_wg = ws_al(OFF_mla_k_g + ((size_t)(DEPTH * 96) * 4));
constexpr size_t OFF_moe_bg = ws_al(OFF_moe_wg + ((size_t)(DEPTH * 1024 * 4) * 4));
constexpr size_t OFF_moe_we = ws_al(OFF_moe_bg + ((size_t)(DEPTH * 4) * 4));
constexpr size_t OFF_moe_be = ws_al(OFF_moe_we + ((size_t)(DEPTH * 1024 * 32) * 4));
constexpr size_t OFF_WUQT = ws_al(OFF_moe_be + ((size_t)(DEPTH * 32) * 4));
constexpr size_t OFF_WUKVT = ws_al(OFF_WUQT + (size_t)DEPTH * 384 * 256 * 2);
constexpr size_t OFF_ROPE = ws_al(OFF_WUKVT + (size_t)DEPTH * 512 * 128 * 2);
constexpr size_t OFF_SP = ws_al(OFF_ROPE + (size_t)2048 * 16 * 8);
constexpr size_t OFF_WINT = ws_al(OFF_SP + (size_t)1152 * 2 * 4096 * 4);
constexpr size_t OFF_WOUTT = ws_al(OFF_WINT + (size_t)DEPTH * DIN * 1024 * 2);
constexpr size_t OFF_HYT = ws_al(OFF_WOUTT + (size_t)DEPTH * 1024 * 1024 * 2);
constexpr size_t OFF_WMOE = ws_al(OFF_HYT + (size_t)NB * 768 * 2048 * 2);
constexpr size_t WS_TOTAL = ws_al(OFF_WMOE + (size_t)3 * 32 * 512 * 1024 * 2);
#define W_WMOE ((bf16_t*)(WSB(p) + OFF_WMOE))
#define W_HYT ((bf16_t*)(WSB(p) + OFF_HYT))
#define W_WINT ((bf16_t*)(WSB(p) + OFF_WINT))
#define W_WOUTT ((bf16_t*)(WSB(p) + OFF_WOUTT))
#define W_SP ((float*)(WSB(p) + OFF_SP))
#define W_WUQT ((bf16_t*)(WSB(p) + OFF_WUQT))
#define W_WUKVT ((bf16_t*)(WSB(p) + OFF_WUKVT))
#define W_ROPE ((float2*)(WSB(p) + OFF_ROPE))
#define W_bar ((unsigned*)(WSB(p) + OFF_bar))
#define W_cnt ((int*)(WSB(p) + OFF_cnt))
#define W_X ((float*)(WSB(p) + OFF_X))
#define W_MOD ((float*)(WSB(p) + OFF_MOD))
#define W_LB ((float*)(WSB(p) + OFF_LB))
#define W_HDN ((float*)(WSB(p) + OFF_HDN))
#define W_TW ((float2*)(WSB(p) + OFF_TW))
#define W_KSPEC ((float2*)(WSB(p) + OFF_KSPEC))
#define W_HYKC ((float*)(WSB(p) + OFF_HYKC))
#define W_H ((bf16_t*)(WSB(p) + OFF_H))
#define W_P ((bf16_t*)(WSB(p) + OFF_P))
#define W_OF ((float*)(WSB(p) + OFF_OF))
#define W_HU ((float*)(WSB(p) + OFF_HU))
#define W_HQ ((float*)(WSB(p) + OFF_HQ))
#define W_HD ((float*)(WSB(p) + OFF_HD))
#define W_NQ ((bf16_t*)(WSB(p) + OFF_NQ))
#define W_NK ((bf16_t*)(WSB(p) + OFF_NK))
#define W_NVT ((bf16_t*)(WSB(p) + OFF_NVT))
#define W_MQ ((bf16_t*)(WSB(p) + OFF_MQ))
#define W_MK ((bf16_t*)(WSB(p) + OFF_MK))
#define W_MVT ((bf16_t*)(WSB(p) + OFF_MVT))
#define W_CAT ((bf16_t*)(WSB(p) + OFF_CAT))
#define W_EW ((float*)(WSB(p) + OFF_EW))
#define W_LIST ((int*)(WSB(p) + OFF_LIST))
#define W_ACT ((bf16_t*)(WSB(p) + OFF_ACT))
#define W_YEXP ((bf16_t*)(WSB(p) + OFF_YEXP))
#define W_wq (W_bar + XCD_BAR_WORDS)
#define W_norm1_g ((const float*)(WSB(p) + OFF_norm1_g))
#define W_norm2_g ((const float*)(WSB(p) + OFF_norm2_g))
#define W_hgrn_norm_g ((const float*)(WSB(p) + OFF_hgrn_norm_g))
#define W_hy_short_w ((const float*)(WSB(p) + OFF_hy_short_w))
#define W_hy_short_b ((const float*)(WSB(p) + OFF_hy_short_b))
#define W_hy_bias ((const float*)(WSB(p) + OFF_hy_bias))
#define W_na_rpb ((const float*)(WSB(p) + OFF_na_rpb))
#define W_na_q_g ((const float*)(WSB(p) + OFF_na_q_g))
#define W_na_k_g ((const float*)(WSB(p) + OFF_na_k_g))
#define W_mla_q_a_g ((const float*)(WSB(p) + OFF_mla_q_a_g))
#define W_mla_kv_a_g ((const float*)(WSB(p) + OFF_mla_kv_a_g))
#define W_mla_w_uq ((const float*)(WSB(p) + OFF_mla_w_uq))
#define W_mla_w_ukv ((const float*)(WSB(p) + OFF_mla_w_ukv))
#define W_mla_q_g ((const float*)(WSB(p) + OFF_mla_q_g))
#define W_mla_k_g ((const float*)(WSB(p) + OFF_mla_k_g))
#define W_moe_wg ((const float*)(WSB(p) + OFF_moe_wg))
#define W_moe_bg ((const float*)(WSB(p) + OFF_moe_bg))
#define W_moe_we ((const float*)(WSB(p) + OFF_moe_we))
#define W_moe_be ((const float*)(WSB(p) + OFF_moe_be))

__device__ __forceinline__ int wq_next(unsigned* ctr, float* sm) {
    int* slot = (int*)(sm + SMF - 1);
    __syncthreads();
    if (TIDX == 0) *slot = (int)__hip_atomic_fetch_add(ctr, 1u, __ATOMIC_RELAXED, __HIP_MEMORY_SCOPE_AGENT);
    __syncthreads();
    return __builtin_amdgcn_readfirstlane(*slot);
}
#define WQ(p, l, site) (W_wq + (((l) + 1) * WQ_SLOTS + (site) + 16 * ((const int*)sm)[SMF - 2]) * 16)
template <class FA, class FB, class FE>
__device__ __forceinline__ void gemm_tile_f32(int K, float* sm, FA fa, FB fb, FE fe) {
    float* As = sm;
    float* Bs = sm + 16 * 68;
    const int tid = TIDX, tx = tid & 15, ty = tid >> 4;
    float acc[4][4];
#pragma unroll
    for (int a = 0; a < 4; a++)
#pragma unroll
        for (int b = 0; b < 4; b++) acc[a][b] = 0.f;
    for (int k0 = 0; k0 < K; k0 += 16) {
#pragma unroll
        for (int q = 0; q < 4; q++) { int e = tid + 256 * q; int i = e >> 4, kk = e & 15; As[kk * 68 + i] = fa(i, k0 + kk); }
#pragma unroll
        for (int q = 0; q < 4; q++) { int e = tid + 256 * q; int kk = e >> 6, j = e & 63; Bs[kk * 68 + j] = fb(k0 + kk, j); }
        __syncthreads();
#pragma unroll
        for (int kk = 0; kk < 16; kk++) {
            float4 a4 = *(const float4*)&As[kk * 68 + ty * 4];
            float4 b4 = *(const float4*)&Bs[kk * 68 + tx * 4];
            float av[4] = {a4.x, a4.y, a4.z, a4.w}, bv[4] = {b4.x, b4.y, b4.z, b4.w};
#pragma unroll
            for (int a = 0; a < 4; a++)
#pragma unroll
                for (int b = 0; b < 4; b++) acc[a][b] += av[a] * bv[b];
        }
        __syncthreads();
    }
#pragma unroll
    for (int a = 0; a < 4; a++)
#pragma unroll
        for (int b = 0; b < 4; b++) fe(ty * 4 + a, tx * 4 + b, acc[a][b]);
}


#define GEMM_LOAD(k0) { _Pragma("unroll") for (int i_ = 0; i_ < 4; i_++) ra[i_] = *(const u32x4*)(ap[i_] + (k0)); \
    _Pragma("unroll") for (int i_ = 0; i_ < 4; i_++) _Pragma("unroll") for (int j_ = 0; j_ < 8; j_++) rb[i_][j_] = bload((k0) + (bkg + 2 * i_) * 8 + j_, bn); }
#define GEMM_WRITE(buf) { char* As_ = smc + (buf) * 16384; char* Bs_ = smc + 32768 + (buf) * 16384; \
    _Pragma("unroll") for (int i_ = 0; i_ < 4; i_++) *(u32x4*)(As_ + (arow + 32 * i_) * 128 + ((ac ^ (arow & 7)) * 16)) = ra[i_]; \
    _Pragma("unroll") for (int i_ = 0; i_ < 4; i_++) { u32x4 b_; b_[0] = pack2bf(rb[i_][0], rb[i_][1]); b_[1] = pack2bf(rb[i_][2], rb[i_][3]); \
        b_[2] = pack2bf(rb[i_][4], rb[i_][5]); b_[3] = pack2bf(rb[i_][6], rb[i_][7]); \
        *(u32x4*)(Bs_ + bn * 128 + (((bkg + 2 * i_) ^ (bn & 7)) * 16)) = b_; } }
template <bool SWAP, class FA, class FB>
__device__ __forceinline__ void gemm128_main(int K, char* smc, FA arowp, FB bload, f32x4 (&acc)[4][4]) {
    const int tid = TIDX, lane = tid & 63, w = tid >> 6;
    const int wm = w >> 1, wn = w & 1, r16 = lane & 15, q = lane >> 4;
#pragma unroll
    for (int i = 0; i < 4; i++)
#pragma unroll
        for (int j = 0; j < 4; j++) acc[i][j] = (f32x4){0.f, 0.f, 0.f, 0.f};
    const int arow = tid >> 3, ac = tid & 7;
    const int bn = tid & 127, bkg = tid >> 7;
    const bf16_t* ap[4];
#pragma unroll
    for (int i = 0; i < 4; i++) ap[i] = arowp(arow + 32 * i) + ac * 8;
    u32x4 ra[4];
    float rb[4][8];
    GEMM_LOAD(0)
    __syncthreads();
    GEMM_WRITE(0)
    __syncthreads();
    const int KT = K >> 6;
    for (int kt = 0; kt < KT; kt++) {
        const bool more = (kt + 1 < KT);
        if (more) GEMM_LOAD((kt + 1) * 64)
        const char* As = smc + (kt & 1) * 16384;
        const char* Bs = smc + 32768 + (kt & 1) * 16384;
#pragma unroll
        for (int ks = 0; ks < 2; ks++) {
            bf16x8 af[4], bfr[4];
            const int sw = ((ks * 4 + q) ^ (r16 & 7)) * 16;
#pragma unroll
            for (int i = 0; i < 4; i++) af[i] = *(const bf16x8*)(As + (wm * 64 + i * 16 + r16) * 128 + sw);
#pragma unroll
            for (int j = 0; j < 4; j++) bfr[j] = *(const bf16x8*)(Bs + (wn * 64 + j * 16 + r16) * 128 + sw);
            __builtin_amdgcn_s_setprio(1);
#pragma unroll
            for (int i = 0; i < 4; i++)
#pragma unroll
                for (int j = 0; j < 4; j++)
                    acc[i][j] = SWAP ? __builtin_amdgcn_mfma_f32_16x16x32_bf16(bfr[j], af[i], acc[i][j], 0, 0, 0)
                                     : __builtin_amdgcn_mfma_f32_16x16x32_bf16(af[i], bfr[j], acc[i][j], 0, 0, 0);
            __builtin_amdgcn_s_setprio(0);
        }
        if (more) GEMM_WRITE((kt + 1) & 1)
        __syncthreads();
    }
}

#define GEMMBT_LOAD(k0) { _Pragma("unroll") for (int i_ = 0; i_ < 4; i_++) { ra[i_] = *(const u32x4*)(ap[i_] + (k0)); rbv[i_] = *(const u32x4*)(bp[i_] + (k0)); } }
#define GEMMBT_WRITE(buf) { char* As_ = smc + (buf) * 16384; char* Bs_ = smc + 32768 + (buf) * 16384; \
    _Pragma("unroll") for (int i_ = 0; i_ < 4; i_++) { *(u32x4*)(As_ + (arow + 32 * i_) * 128 + ((ac ^ (arow & 7)) * 16)) = ra[i_]; \
                                                      *(u32x4*)(Bs_ + (arow + 32 * i_) * 128 + ((ac ^ (arow & 7)) * 16)) = rbv[i_]; } }
#define GEMMBT_LOADS(k0, RA, RB) { _Pragma("unroll") for (int i_ = 0; i_ < 4; i_++) { RA[i_] = *(const u32x4*)(ap[i_] + (k0)); RB[i_] = *(const u32x4*)(bp[i_] + (k0)); } }
#define GEMMBT_WRITES(buf, RA, RB) { char* As_ = smc + (buf) * 16384; char* Bs_ = smc + 32768 + (buf) * 16384; \
    _Pragma("unroll") for (int i_ = 0; i_ < 4; i_++) { *(u32x4*)(As_ + (arow + 32 * i_) * 128 + ((ac ^ (arow & 7)) * 16)) = RA[i_]; \
                                                      *(u32x4*)(Bs_ + (arow + 32 * i_) * 128 + ((ac ^ (arow & 7)) * 16)) = RB[i_]; } }
#define GEMMBT_COMPUTE(buf) { const char* As = smc + (buf) * 16384; const char* Bs = smc + 32768 + (buf) * 16384; \
    _Pragma("unroll") for (int ks = 0; ks < 2; ks++) { bf16x8 af[4], bfr[4]; const int sw = ((ks * 4 + q) ^ (r16 & 7)) * 16; \
        _Pragma("unroll") for (int i = 0; i < 4; i++) af[i] = *(const bf16x8*)(As + (wm * 64 + i * 16 + r16) * 128 + sw); \
        _Pragma("unroll") for (int j = 0; j < 4; j++) bfr[j] = *(const bf16x8*)(Bs + (wn * 64 + j * 16 + r16) * 128 + sw); \
        __builtin_amdgcn_s_setprio(1); \
        _Pragma("unroll") for (int i = 0; i < 4; i++) _Pragma("unroll") for (int j = 0; j < 4; j++) \
            acc[i][j] = SWAP ? __builtin_amdgcn_mfma_f32_16x16x32_bf16(bfr[j], af[i], acc[i][j], 0, 0, 0) \
                             : __builtin_amdgcn_mfma_f32_16x16x32_bf16(af[i], bfr[j], acc[i][j], 0, 0, 0); \
        __builtin_amdgcn_s_setprio(0); } }
template <bool SWAP, class FA, class FBR>
__device__ __forceinline__ void gemm128_bt(int K, char* smc, FA arowp, FBR browp, f32x4 (&acc)[4][4]) {
    const int tid = TIDX, lane = tid & 63, w = tid >> 6;
    const int wm = w >> 1, wn = w & 1, r16 = lane & 15, q = lane >> 4;
#pragma unroll
    for (int i = 0; i < 4; i++)
#pragma unroll
        for (int j = 0; j < 4; j++) acc[i][j] = (f32x4){0.f, 0.f, 0.f, 0.f};
    const int arow = tid >> 3, ac = tid & 7;
    const bf16_t* ap[4];
    const bf16_t* bp[4];
#pragma unroll
    for (int i = 0; i < 4; i++) { ap[i] = arowp(arow + 32 * i) + ac * 8; bp[i] = browp(arow + 32 * i) + ac * 8; }
    u32x4 ra0[4], rb0[4], ra1[4], rb1[4];
    GEMMBT_LOADS(0, ra0, rb0)
    GEMMBT_LOADS(64, ra1, rb1)
    __syncthreads();
    GEMMBT_WRITES(0, ra0, rb0)
    __syncthreads();
    const int KT = K >> 6;
    for (int kt = 0; kt < KT; kt += 2) {
        if (kt + 2 < KT) GEMMBT_LOADS((kt + 2) * 64, ra0, rb0)
        GEMMBT_COMPUTE(0)
        GEMMBT_WRITES(1, ra1, rb1)
        __syncthreads();
        if (kt + 3 < KT) GEMMBT_LOADS((kt + 3) * 64, ra1, rb1)
        GEMMBT_COMPUTE(1)
        if (kt + 2 < KT) GEMMBT_WRITES(0, ra0, rb0)
        __syncthreads();
    }
}

#define FFT_PHYS(pos) ((pos) + ((pos) >> 4))
__device__ __forceinline__ float2 cmul(float2 a, float2 b) { return make_float2(a.x * b.x - a.y * b.y, a.x * b.y + a.y * b.x); }
__device__ __forceinline__ float2 cmulc(float2 a, float2 b) { return make_float2(a.x * b.x + a.y * b.y, a.y * b.x - a.x * b.y); }
__device__ __forceinline__ void dft4f(float2& a0, float2& a1, float2& a2, float2& a3) {
    const float2 t0 = make_float2(a0.x + a2.x, a0.y + a2.y), t1 = make_float2(a0.x - a2.x, a0.y - a2.y);
    const float2 t2 = make_float2(a1.x + a3.x, a1.y + a3.y), t3 = make_float2(a1.x - a3.x, a1.y - a3.y);
    a0 = make_float2(t0.x + t2.x, t0.y + t2.y);
    a1 = make_float2(t1.x + t3.y, t1.y - t3.x);
    a2 = make_float2(t0.x - t2.x, t0.y - t2.y);
    a3 = make_float2(t1.x - t3.y, t1.y + t3.x);
}
__device__ __forceinline__ void dft4i(float2& a0, float2& a1, float2& a2, float2& a3) {
    const float2 t0 = make_float2(a0.x + a2.x, a0.y + a2.y), t1 = make_float2(a0.x - a2.x, a0.y - a2.y);
    const float2 t2 = make_float2(a1.x + a3.x, a1.y + a3.y), t3 = make_float2(a1.x - a3.x, a1.y - a3.y);
    a0 = make_float2(t0.x + t2.x, t0.y + t2.y);
    a1 = make_float2(t1.x - t3.y, t1.y + t3.x);
    a2 = make_float2(t0.x - t2.x, t0.y - t2.y);
    a3 = make_float2(t1.x + t3.y, t1.y - t3.x);
}
template <int S> struct FftGeo { static constexpr int Ns = 4096 >> (2 * S), Ms = Ns / 4, Ms1 = Ms / 4; };
template <int S>
__device__ __forceinline__ int fft_phys_base(int tid) {
    if (S == 0) return tid + (tid >> 4);
    if (S == 2) return (tid >> 4) * 272 + (tid & 15);
    return tid * 17;
}
template <int S>
__device__ __forceinline__ constexpr int fft_phys_off(int r1, int r2) {
    return S == 0 ? 272 * (r1 * 4 + r2) : (S == 2 ? 68 * r1 + 17 * r2 : 4 * r1 + r2);
}
template <int S>
__device__ __forceinline__ void fft_fwd_pass(float2 (&v)[4][4], int tid, const float2* __restrict__ TW) {
    const int jp = tid % FftGeo<S>::Ms1;
#pragma unroll
    for (int r2 = 0; r2 < 4; r2++) {
        dft4f(v[0][r2], v[1][r2], v[2][r2], v[3][r2]);
        const float2 w = TW[((jp + r2 * FftGeo<S>::Ms1) << (2 * S)) & 4095];
        const float2 w2 = cmul(w, w), w3 = cmul(w2, w);
        v[1][r2] = cmul(v[1][r2], w); v[2][r2] = cmul(v[2][r2], w2); v[3][r2] = cmul(v[3][r2], w3);
    }
    if (S < 4) {
        const float2 w = TW[(jp << (2 * S + 2)) & 4095];
        const float2 w2 = cmul(w, w), w3 = cmul(w2, w);
#pragma unroll
        for (int q1 = 0; q1 < 4; q1++) {
            dft4f(v[q1][0], v[q1][1], v[q1][2], v[q1][3]);
            v[q1][1] = cmul(v[q1][1], w); v[q1][2] = cmul(v[q1][2], w2); v[q1][3] = cmul(v[q1][3], w3);
        }
    } else {
#pragma unroll
        for (int q1 = 0; q1 < 4; q1++) dft4f(v[q1][0], v[q1][1], v[q1][2], v[q1][3]);
    }
}
template <int S>
__device__ __forceinline__ void fft_inv_pass(float2 (&v)[4][4], int tid, const float2* __restrict__ TW) {
    const int jp = tid % FftGeo<S>::Ms1;
    if (S < 4) {
        const float2 w = TW[(jp << (2 * S + 2)) & 4095];
        const float2 w2 = cmul(w, w), w3 = cmul(w2, w);
#pragma unroll
        for (int q1 = 0; q1 < 4; q1++) {
            v[q1][1] = cmulc(v[q1][1], w); v[q1][2] = cmulc(v[q1][2], w2); v[q1][3] = cmulc(v[q1][3], w3);
            dft4i(v[q1][0], v[q1][1], v[q1][2], v[q1][3]);
        }
    } else {
#pragma unroll
        for (int q1 = 0; q1 < 4; q1++) dft4i(v[q1][0], v[q1][1], v[q1][2], v[q1][3]);
    }
#pragma unroll
    for (int r2 = 0; r2 < 4; r2++) {
        const float2 w = TW[((jp + r2 * FftGeo<S>::Ms1) << (2 * S)) & 4095];
        const float2 w2 = cmul(w, w), w3 = cmul(w2, w);
        v[1][r2] = cmulc(v[1][r2], w); v[2][r2] = cmulc(v[2][r2], w2); v[3][r2] = cmulc(v[3][r2], w3);
        dft4i(v[0][r2], v[1][r2], v[2][r2], v[3][r2]);
    }
}
template <int S>
__device__ __forceinline__ void fft_lds_read(float2 (&v)[4][4], int tid, const float2* fb) {
    const float2* fbb = fb + fft_phys_base<S>(tid);
#pragma unroll
    for (int r1 = 0; r1 < 4; r1++)
#pragma unroll
        for (int r2 = 0; r2 < 4; r2++) v[r1][r2] = fbb[fft_phys_off<S>(r1, r2)];
}
template <int S>
__device__ __forceinline__ void fft_lds_write(const float2 (&v)[4][4], int tid, float2* fb) {
    float2* fbb = fb + fft_phys_base<S>(tid);
#pragma unroll
    for (int r1 = 0; r1 < 4; r1++)
#pragma unroll
        for (int r2 = 0; r2 < 4; r2++) fbb[fft_phys_off<S>(r1, r2)] = v[r1][r2];
}

__device__ void phase_pro1(const Params& p, float* sm) {
    const int tid = TIDX, nth = blockDim.x * gridDim.x, gtid = BIDX * blockDim.x + tid;
    for (int i = gtid; i < DEPTH * 32; i += nth) W_cnt[i] = 0;
    for (int i = gtid; i < 4096; i += nth) { float sn, cs; sincospif((float)i * (1.f / 2048.f), &sn, &cs); W_TW[i] = make_float2(cs, -sn); }
    for (int i = gtid; i < 512; i += nth) {
        float z0 = p.lb_logits[i], z1 = p.lb_logits[512 + i], z2 = p.lb_logits[1024 + i], z3 = p.lb_logits[1536 + i];
        float m = fmaxf(fmaxf(z0, z1), fmaxf(z2, z3));
        float e0 = expf(z0 - m), e1 = expf(z1 - m), e2 = expf(z2 - m), e3 = expf(z3 - m);
        float inv = 1.f / (e0 + e1 + e2 + e3);
        W_LB[i] = 0.f; W_LB[512 + i] = e1 * inv; W_LB[1024 + i] = (e1 + e2) * inv; W_LB[1536 + i] = (e1 + e2 + e3) * inv;
    }
    for (int i = gtid; i < DEPTH * 384 * 256; i += nth) {
        const int k = i & 255, n = (i >> 8) % 384, ll = i / (384 * 256);
        ((bf16_t*)(p.ws + OFF_WUQT))[i] = f2bf(p.mla_q_a_g[ll * 256 + k] * p.mla_w_uq[(size_t)(ll * 256 + k) * 384 + n]);
    }
    for (int i = gtid; i < DEPTH * 512 * 128; i += nth) {
        const int k = i & 127, n = (i >> 7) & 511, ll = i >> 16;
        ((bf16_t*)(p.ws + OFF_WUKVT))[i] = f2bf(p.mla_kv_a_g[ll * 128 + k] * p.mla_w_ukv[(size_t)(ll * 128 + k) * 512 + n]);
    }
    for (int i = gtid; i < 2048 * 16; i += nth) {
        const int t = i >> 4, j = i & 15;
        const float pos = j < 8 ? (float)(t >> 6) : (float)(t & 63);
        const float inv = expf(-9.210340371976184f * (float)(j & 7) * 0.125f);
        float sn, cs;
        sincosf(pos * inv, &sn, &cs);
        ((float2*)(p.ws + OFF_ROPE))[i] = make_float2(cs, sn);
    }
    {
        const int NT_IN = DEPTH * 16 * 51, NT_OUT = DEPTH * 16 * 16;
        for (int u = wq_next(WQ(p, -1, 2), sm); u < NT_IN + NT_OUT; u = wq_next(WQ(p, -1, 2), sm)) {
            const float* src; bf16_t* dst; int N, kt, nt;
            if (u < NT_IN) { const int ll = u / (16 * 51), r = u % (16 * 51); kt = r / 51; nt = r % 51; N = DIN; src = p.w_in + (size_t)ll * 1024 * DIN; dst = (bf16_t*)(p.ws + OFF_WINT) + (size_t)ll * DIN * 1024; }
            else { const int v = u - NT_IN; const int ll = v >> 8, r = v & 255; kt = r >> 4; nt = r & 15; N = 1024; src = p.w_out + (size_t)ll * 1024 * 1024; dst = (bf16_t*)(p.ws + OFF_WOUTT) + (size_t)ll * 1024 * 1024; }
#pragma unroll
            for (int i = 0; i < 4; i++) {
                const int idx = tid + 256 * i, kr = idx >> 4, c4 = idx & 15;
                const int n = nt * 64 + c4 * 4;
                float4 v = make_float4(0.f, 0.f, 0.f, 0.f);
                if (n < N) v = *(const float4*)&src[(size_t)(kt * 64 + kr) * N + n];
                sm[kr * 68 + c4 * 4 + 0] = v.x; sm[kr * 68 + c4 * 4 + 1] = v.y; sm[kr * 68 + c4 * 4 + 2] = v.z; sm[kr * 68 + c4 * 4 + 3] = v.w;
            }
            __syncthreads();
#pragma unroll
            for (int i = 0; i < 2; i++) {
                const int idx = tid + 256 * i, nr = idx >> 3, c8 = idx & 7;
                const int n = nt * 64 + nr;
                if (n < N) {
                    u32x4 o;
                    o[0] = pack2bf(sm[(c8 * 8 + 0) * 68 + nr], sm[(c8 * 8 + 1) * 68 + nr]); o[1] = pack2bf(sm[(c8 * 8 + 2) * 68 + nr], sm[(c8 * 8 + 3) * 68 + nr]);
                    o[2] = pack2bf(sm[(c8 * 8 + 4) * 68 + nr], sm[(c8 * 8 + 5) * 68 + nr]); o[3] = pack2bf(sm[(c8 * 8 + 6) * 68 + nr], sm[(c8 * 8 + 7) * 68 + nr]);
                    *(u32x4*)&dst[(size_t)n * 1024 + kt * 64 + c8 * 8] = o;
                }
            }
        }
    }
    for (int i = gtid; i < (DEPTH * 1024); i += nth) ((float*)(WSB(p) + OFF_norm1_g))[i] = p.norm1_g[i];
    for (int i = gtid; i < (DEPTH * 1024); i += nth) ((float*)(WSB(p) + OFF_norm2_g))[i] = p.norm2_g[i];
    for (int i = gtid; i < (DEPTH * 64); i += nth) ((float*)(WSB(p) + OFF_hgrn_norm_g))[i] = p.hgrn_norm_g[i];
    for (int i = gtid; i < (DEPTH * 3 * 768); i += nth) ((float*)(WSB(p) + OFF_hy_short_w))[i] = p.hy_short_w[i];
    for (int i = gtid; i < (DEPTH * 768); i += nth) ((float*)(WSB(p) + OFF_hy_short_b))[i] = p.hy_short_b[i];
    for (int i = gtid; i < (DEPTH * 2 * 256); i += nth) ((float*)(WSB(p) + OFF_hy_bias))[i] = p.hy_bias[i];
    for (int i = gtid; i < (DEPTH * 4 * 15 * 31); i += nth) ((float*)(WSB(p) + OFF_na_rpb))[i] = p.na_rpb[i];
    for (int i = gtid; i < (DEPTH * 64); i += nth) ((float*)(WSB(p) + OFF_na_q_g))[i] = p.na_q_g[i];
    for (int i = gtid; i < (DEPTH * 64); i += nth) ((float*)(WSB(p) + OFF_na_k_g))[i] = p.na_k_g[i];
    for (int i = gtid; i < (DEPTH * 256); i += nth) ((float*)(WSB(p) + OFF_mla_q_a_g))[i] = p.mla_q_a_g[i];
    for (int i = gtid; i < (DEPTH * 128); i += nth) ((float*)(WSB(p) + OFF_mla_kv_a_g))[i] = p.mla_kv_a_g[i];
    for (int i = gtid; i < (DEPTH * 256 * 384); i += nth) ((float*)(WSB(p) + OFF_mla_w_uq))[i] = p.mla_w_uq[i];
    for (int i = gtid; i < (DEPTH * 128 * 512); i += nth) ((float*)(WSB(p) + OFF_mla_w_ukv))[i] = p.mla_w_ukv[i];
    for (int i = gtid; i < (DEPTH * 96); i += nth) ((float*)(WSB(p) + OFF_mla_q_g))[i] = p.mla_q_g[i];
    for (int i = gtid; i < (DEPTH * 96); i += nth) ((float*)(WSB(p) + OFF_mla_k_g))[i] = p.mla_k_g[i];
    for (int i = gtid; i < (DEPTH * 1024 * 4); i += nth) ((float*)(WSB(p) + OFF_moe_wg))[i] = p.moe_wg[i];
    for (int i = gtid; i < (DEPTH * 4); i += nth) ((float*)(WSB(p) + OFF_moe_bg))[i] = p.moe_bg[i];
    for (int i = gtid; i < (DEPTH * 1024 * 32); i += nth) ((float*)(WSB(p) + OFF_moe_we))[i] = p.moe_we[i];
    for (int i = gtid; i < (DEPTH * 32); i += nth) ((float*)(WSB(p) + OFF_moe_be))[i] = p.moe_be[i];
    for (int u = wq_next(WQ(p, -1, 0), sm); u < DEPTH * 96; u = wq_next(WQ(p, -1, 0), sm)) {
        const int l = u / 96, cg = u % 96;
        for (int i = tid; i < 9 * 1024; i += 256) { float v = i < 8192 ? p.c[i] : p.c_ctx[i - 8192]; sm[i] = siluf_(v); }
        __syncthreads();
        const int col = cg * 64 + (tid & 63), kq = tid >> 6;
        float acc[9];
#pragma unroll
        for (int r = 0; r < 9; r++) acc[r] = 0.f;
        const float* w = p.w_ada + (size_t)l * 1024 * 6144 + col;
        for (int k = kq * 256; k < kq * 256 + 256; k++) {
            float wv = w[(size_t)k * 6144];
#pragma unroll
            for (int r = 0; r < 9; r++) acc[r] += sm[r * 1024 + k] * wv;
        }
        float* red = sm + 9 * 1024;
#pragma unroll
        for (int r = 0; r < 9; r++) red[(kq * 9 + r) * 64 + (tid & 63)] = acc[r];
        __syncthreads();
        if (tid < 64) {
#pragma unroll
            for (int r = 0; r < 9; r++)
                W_MOD[(size_t)(l * 9 + r) * 6144 + col] = red[(0 * 9 + r) * 64 + tid] + red[(1 * 9 + r) * 64 + tid] + red[(2 * 9 + r) * 64 + tid] +
                                                          red[(3 * 9 + r) * 64 + tid] + p.b_ada[l * 6144 + col];
        }
        __syncthreads();
    }
    {
        const int wave = tid >> 6, lane = tid & 63;
        for (int wu = BIDX * 4 + wave; wu < DEPTH * 2304; wu += gridDim.x * 4) {
            const int l = wu / 2304, rem = wu % 2304;
            const int which = rem >= 2048 ? 1 : 0;
            const int t = which ? rem - 2048 : rem;
            const int L = which ? 256 : 2048;
            const float tu = (float)t / (float)(L - 1);
            float feat = 0.f;
            if (lane == 0) feat = tu;
            else if (lane <= 32) {
                const int bi = (lane - 1) & 15;
                const float band = 1e-4f + (float)bi * ((15.f - 1e-4f) / 15.f);
                float uu = (float)t * band / (float)L;
                uu -= floorf(uu);
                float s_, c_;
                sincospif(2.f * uu, &s_, &c_);
                feat = lane <= 16 ? c_ : -s_;
            }
            const float fr = p.hy_freq[l * 64 + lane];
            float a = p.hy_b1[l * 64 + lane];
            for (int e = 0; e < 33; e++) a += __shfl(feat, e) * p.hy_w1[(l * 33 + e) * 64 + lane];
            const float h1 = sinf(fr * a);
            float a2 = p.hy_b2[l * 64 + lane];
            for (int i = 0; i < 64; i++) a2 += __shfl(h1, i) * p.hy_w2[(l * 64 + i) * 64 + lane];
            const float h2 = sinf(fr * a2);
            W_HDN[((size_t)(l * 2 + which) * 2048 + t) * 64 + lane] = h2;
        }
    }
}

template <int LL>
__device__ __forceinline__ void hyk_unit(const Params& p, int l, int o, int c, float* sm) {
    constexpr int NT = LL / 256;
    constexpr int which = (LL == 256) ? 1 : 0;
    const int tid = TIDX;
    const int colf = o * 512 + c, colb = o * 512 + 256 + c;
    __syncthreads();
    if (tid < 64) { sm[tid] = p.hy_w3[(size_t)(l * 64 + tid) * 1024 + colf]; sm[64 + tid] = p.hy_w3[(size_t)(l * 64 + tid) * 1024 + colb]; }
    __syncthreads();
    const float bf = p.hy_b3[l * 1024 + colf], bb = p.hy_b3[l * 1024 + colb];
    const float df = p.hy_decay[((l * 2 + o) * 2 + 0) * 256 + c], dbw = p.hy_decay[((l * 2 + o) * 2 + 1) * 256 + c];
    float vf[NT], vb[NT];
    float ss = 0.f;
#pragma unroll
    for (int i = 0; i < NT; i++) {
        const int t = tid + 256 * i;
        const float* h = W_HDN + ((size_t)(l * 2 + which) * 2048 + t) * 64;
        float af = bf, ab = bb;
#pragma unroll 4
        for (int k = 0; k < 64; k++) { float hv = h[k]; af += hv * sm[k]; ab += hv * sm[64 + k]; }
        const float tu = (float)t / (float)(LL - 1);
        af *= expf(-tu * df); ab *= expf(-tu * dbw);
        vf[i] = af; vb[i] = ab;
        ss += af * af + (t > 0 ? ab * ab : 0.f);
    }
    const float tot = block_sum(ss, sm + 128);
    const float scale = rsqrtf(tot + EPSF);
    if (which) {
        float* outp = W_HYKC + (size_t)((l * 2 + o) * 256 + c) * 2 * LL;
#pragma unroll
        for (int i = 0; i < NT; i++) { const int t = tid + 256 * i; outp[t] = vf[i] * scale; outp[LL + t] = vb[i] * scale; }
    } else {
        float* kl = sm + 256;
        float2* fb = (float2*)(sm + 256 + 4096);
#pragma unroll
        for (int i = 0; i < NT; i++) {
            const int t = tid + 256 * i;
            kl[t] = vf[i] * scale;
            if (t > 0) kl[4096 - t] = vb[i] * scale;
        }
        if (tid == 0) kl[2048] = 0.f;
        __syncthreads();
        float2 v[4][4];
#pragma unroll
        for (int r1 = 0; r1 < 4; r1++)
#pragma unroll
            for (int r2 = 0; r2 < 4; r2++) v[r1][r2] = make_float2(kl[tid + 256 * (r1 * 4 + r2)], 0.f);
        fft_fwd_pass<0>(v, tid, W_TW);
        fft_lds_write<0>(v, tid, fb);
        __syncthreads();
        fft_lds_read<2>(v, tid, fb);
        fft_fwd_pass<2>(v, tid, W_TW);
        fft_lds_write<2>(v, tid, fb);
        __syncthreads();
        fft_lds_read<4>(v, tid, fb);
        fft_fwd_pass<4>(v, tid, W_TW);
        float2* outp = W_KSPEC + (size_t)((l * 2 + o) * 256 + c) * 4096 + tid * 16;
#pragma unroll
        for (int r1 = 0; r1 < 4; r1++)
#pragma unroll
            for (int r2 = 0; r2 < 4; r2++) outp[r1 * 4 + r2] = make_float2(v[r1][r2].x * (1.f / 4096.f), v[r1][r2].y * (1.f / 4096.f));
    }
}
__device__ void phase_pro2(const Params& p, float* sm) {
    for (int u = wq_next(WQ(p, -1, 1), sm); u < DEPTH * 512 + (DEPTH - 1) * 512; u = wq_next(WQ(p, -1, 1), sm)) {
        const int which = u / (DEPTH * 512), r = u % (DEPTH * 512);
        const int l = r / 512, o = (r / 256) & 1, c = r & 255;
        if (which == 0) hyk_unit<2048>(p, l, o, c, sm); else hyk_unit<256>(p, l, o, c, sm);
    }
}

__device__ void phase_norm1(const Params& p, int l, float* sm) {
    const int wave = TIDX >> 6, lane = TIDX & 63;
    for (int row = BIDX * 4 + wave; row < TT; row += gridDim.x * 4) {
        const int bi = bidx_of(row);
        float4 xv[4];
        float ss = 0.f;
#pragma unroll
        for (int i = 0; i < 4; i++) {
            const int k = i * 256 + lane * 4;
            const float* xsrc = l > 0 ? &W_X[(size_t)row * 1024 + k] : (row < NLAT ? &p.x[(size_t)row * 1024 + k] : &p.ctx[(size_t)(row - NLAT) * 1024 + k]);
            float4 v = *(const float4*)xsrc;
            if (l > 0) {
                const float4 g2 = *(const float4*)&W_MOD[(size_t)((l - 1) * 9 + bi) * 6144 + 5120 + k];
                const float4 y0 = ld4bf(&W_YEXP[((size_t)row * 2 + 0) * 1024 + k]);
                const float4 y1 = ld4bf(&W_YEXP[((size_t)row * 2 + 1) * 1024 + k]);
                v.x += g2.x * (y0.x + y1.x); v.y += g2.y * (y0.y + y1.y); v.z += g2.z * (y0.z + y1.z); v.w += g2.w * (y0.w + y1.w);
                *(float4*)&W_X[(size_t)row * 1024 + k] = v;
            }
            xv[i] = v;
            ss += v.x * v.x + v.y * v.y + v.z * v.z + v.w * v.w;
        }
        ss = wave_sum(ss);
        const float rstd = rsqrtf(ss * (1.f / 1024.f) + EPSF);
        const float* md = W_MOD + (size_t)(l * 9 + bi) * 6144;
#pragma unroll
        for (int i = 0; i < 4; i++) {
            const int k = i * 256 + lane * 4;
            const float4 g = *(const float4*)&W_norm1_g[l * 1024 + k];
            const float4 sh = *(const float4*)&md[k];
            const float4 sc = *(const float4*)&md[1024 + k];
            float4 o;
            o.x = xv[i].x * rstd * g.x * (1.f + sc.x) + sh.x;
            o.y = xv[i].y * rstd * g.y * (1.f + sc.y) + sh.y;
            o.z = xv[i].z * rstd * g.z * (1.f + sc.z) + sh.z;
            o.w = xv[i].w * rstd * g.w * (1.f + sc.w) + sh.w;
            st4bf(&W_H[(size_t)row * 1024 + k], o);
        }
    }
}

__device__ void phase_final(const Params& p, float* sm) {
    const int nth = blockDim.x * gridDim.x, gtid = BIDX * blockDim.x + TIDX;
    for (int i = gtid; i < NLAT * 256; i += nth) {
        const int row = i >> 8, k = (i & 255) * 4;
        const int bi = row >> 11;
        float4 v = *(const float4*)&W_X[(size_t)row * 1024 + k];
        const float4 g2 = *(const float4*)&W_MOD[(size_t)(3 * 9 + bi) * 6144 + 5120 + k];
        const float4 y0 = ld4bf(&W_YEXP[((size_t)row * 2 + 0) * 1024 + k]);
        const float4 y1 = ld4bf(&W_YEXP[((size_t)row * 2 + 1) * 1024 + k]);
        v.x += g2.x * (y0.x + y1.x); v.y += g2.y * (y0.y + y1.y); v.z += g2.z * (y0.z + y1.z); v.w += g2.w * (y0.w + y1.w);
        *(float4*)&p.out[(size_t)row * 1024 + k] = v;
    }
}

__device__ void phase_gemm1(const Params& p, int l, float* sm) {
    const int NTN = (DIN + 127) / 128;
    const float* W = p.w_in + (size_t)l * 1024 * DIN;
    const int tid = TIDX, lane = tid & 63, w = tid >> 6, wm = w >> 1, wn = w & 1, r16 = lane & 15, q = lane >> 4;
    for (int u = wq_next(WQ(p, l, 0), sm); u < 144 * 4 * 7; u = wq_next(WQ(p, l, 0), sm)) {
        const int band = u / (144 * 4), rem = u % (144 * 4);
        const int bw = min(4, NTN - band * 4);
        const int rb = rem / bw, cb = band * 4 + rem % bw;
        if (rb >= 144) continue;
        const int r0 = rb * 128, n0 = cb * 128;
        f32x4 acc[4][4];
        const bf16_t* hb = W_H + (size_t)r0 * 1024;
        const bf16_t* wb = W_WINT + (size_t)l * DIN * 1024;
        gemm128_bt<true>(1024, (char*)sm, [&](int r) { return hb + (size_t)r * 1024; },
                         [&](int r) { return wb + (size_t)min(n0 + r, DIN - 1) * 1024; }, acc);
#pragma unroll
        for (int i = 0; i < 4; i++)
#pragma unroll
            for (int j = 0; j < 4; j++) {
                const int m = r0 + wm * 64 + i * 16 + r16, n = n0 + wn * 64 + j * 16 + q * 4;
                if (n0 >= C_HY && n0 < C_NA && r0 < NLAT) {
                    bf16_t* dst = W_HYT + ((size_t)(m >> 11) * 768 + (n - C_HY)) * 2048 + (m & 2047);
#pragma unroll
                    for (int e = 0; e < 4; e++) dst[(size_t)e * 2048] = f2bf(acc[i][j][e]);
                } else if (n < DIN) st4bf(&W_P[(size_t)m * DIN + n], make_float4(acc[i][j][0], acc[i][j][1], acc[i][j][2], acc[i][j][3]));
            }
    }
}

__device__ void phase_prep_main(const Params& p, int l, float* sm);
__device__ __forceinline__ void hgrn_local_unit(const Params& p, int l, int u, float* sm);
__device__ void phase_prep(const Params& p, int l, float* sm) {
    const bool main_first = (BIDX >> 8) & 1;
    if (main_first) phase_prep_main(p, l, sm);
    for (int u = wq_next(WQ(p, l, 1), sm); u < 1152; u = wq_next(WQ(p, l, 1), sm)) hgrn_local_unit(p, l, u, sm);
    if (!main_first) phase_prep_main(p, l, sm);
}
__device__ void phase_prep_main(const Params& p, int l, float* sm) {
    const int tid = TIDX, lane = tid & 63, w = tid >> 6, r16 = lane & 15, q4 = lane >> 4;
    char* smc = (char*)sm;
    char* Acq = smc;
    char* Ackv = smc + 8704;
    float* R = (float*)(smc + 13312);
    float* krf = (float*)(smc + 13312 + 16 * 516 * 4);
    float* rsq = krf + 512;
    float* rskv = rsq + 16;
    for (int u = wq_next(WQ(p, l, 2), sm); u < TT / 16; u = wq_next(WQ(p, l, 2), sm)) {
        const int r0 = u * 16;
        const bool lat = r0 < NLAT;
        const int bb = lat ? (r0 >> 11) : ((r0 - NLAT) >> 8);
        const int kidx0 = lat ? (r0 & 2047) : 2048 + ((r0 - NLAT) & 255);
        const int posb = (kidx0 & ~31) + ((kidx0 >> 4) & 1) * 4;
        const bf16_t* Pb = W_P + (size_t)r0 * DIN;
        {
            for (int c = tid; c < 512; c += 256) { const int row = c >> 5, cc = c & 31; *(u32x4*)(Acq + row * 544 + cc * 16) = *(const u32x4*)(Pb + (size_t)row * DIN + C_CQ + cc * 8); }
            { const int row = tid >> 4, cc = tid & 15; *(u32x4*)(Ackv + row * 288 + cc * 16) = *(const u32x4*)(Pb + (size_t)row * DIN + C_CKV + cc * 8); }
            for (int i = tid; i < 512; i += 256) krf[i] = bf2f(Pb[(size_t)(i >> 5) * DIN + C_KR + (i & 31)]);
        }
        {
            const float4 gq = *(const float4*)&W_na_q_g[l * 64 + r16 * 4];
            const float4 gk = *(const float4*)&W_na_k_g[l * 64 + r16 * 4];
#pragma unroll 2
            for (int ps = 0; ps < 8; ps++) {
                const int item = ps * 16 + (tid >> 4);
                const int tk = item >> 3, h = (item >> 1) & 3, wh = item & 1;
                const float4 v = ld4bf(Pb + (size_t)tk * DIN + C_NA + wh * 256 + h * 64 + r16 * 4);
                float ss = v.x * v.x + v.y * v.y + v.z * v.z + v.w * v.w;
                ss += __shfl_xor(ss, 1); ss += __shfl_xor(ss, 2); ss += __shfl_xor(ss, 4); ss += __shfl_xor(ss, 8);
                const float rs = rsqrtf(ss * (1.f / 64.f) + EPSF);
                const float4 g = wh ? gk : gq;
                st4bf((wh ? W_NK : W_NQ) + (size_t)(r0 + tk) * 256 + h * 64 + r16 * 4, make_float4(v.x * rs * g.x, v.y * rs * g.y, v.z * rs * g.z, v.w * rs * g.w));
            }
            const int h = tid >> 6, d = tid & 63;
            bf16_t* dst = W_NVT + (size_t)((bb * 4 + h) * 64 + d) * 2304 + posb;
#pragma unroll
            for (int qq = 0; qq < 4; qq++) {
                const bf16_t* src = Pb + (size_t)(qq * 4) * DIN + C_NA + 512 + h * 64 + d;
                uint2 pk;
                pk.x = (unsigned)src[0] | ((unsigned)src[DIN] << 16);
                pk.y = (unsigned)src[2 * DIN] | ((unsigned)src[3 * DIN] << 16);
                *(uint2*)(dst + qq * 8) = pk;
            }
        }
        __syncthreads();
        {
            const int tk = w * 4 + q4;
            float ss = 0.f;
#pragma unroll
            for (int j = 0; j < 2; j++) { const float4 a = ld4bf((const bf16_t*)(Acq + tk * 544) + r16 * 16 + j * 8), b = ld4bf((const bf16_t*)(Acq + tk * 544) + r16 * 16 + j * 8 + 4);
                ss += a.x * a.x + a.y * a.y + a.z * a.z + a.w * a.w + b.x * b.x + b.y * b.y + b.z * b.z + b.w * b.w; }
            ss += __shfl_xor(ss, 1); ss += __shfl_xor(ss, 2); ss += __shfl_xor(ss, 4); ss += __shfl_xor(ss, 8);
            float s2 = 0.f;
            { const float4 a = ld4bf((const bf16_t*)(Ackv + tk * 288) + r16 * 8), b = ld4bf((const bf16_t*)(Ackv + tk * 288) + r16 * 8 + 4);
              s2 = a.x * a.x + a.y * a.y + a.z * a.z + a.w * a.w + b.x * b.x + b.y * b.y + b.z * b.z + b.w * b.w; }
            s2 += __shfl_xor(s2, 1); s2 += __shfl_xor(s2, 2); s2 += __shfl_xor(s2, 4); s2 += __shfl_xor(s2, 8);
            if (r16 == 0) { rsq[tk] = rsqrtf(ss * (1.f / 256.f) + EPSF); rskv[tk] = rsqrtf(s2 * (1.f / 128.f) + EPSF); }
        }
        __syncthreads();
        {
            const bf16_t* WB = W_WUQT + (size_t)l * 384 * 256;
            const float rs = rsq[r16];
#pragma unroll 2
            for (int it = 0; it < 6; it++) {
                const int nt = it * 4 + w;
                f32x4 acc = (f32x4){0.f, 0.f, 0.f, 0.f};
#pragma unroll
                for (int ks = 0; ks < 8; ks++) {
                    const bf16x8 bfr = *(const bf16x8*)(WB + (size_t)(nt * 16 + r16) * 256 + ks * 32 + q4 * 8);
                    const bf16x8 afr = *(const bf16x8*)(Acq + r16 * 544 + ks * 64 + q4 * 16);
                    acc = __builtin_amdgcn_mfma_f32_16x16x32_bf16(bfr, afr, acc, 0, 0, 0);
                }
                *(float4*)&R[r16 * 516 + nt * 16 + q4 * 4] = make_float4(acc[0] * rs, acc[1] * rs, acc[2] * rs, acc[3] * rs);
            }
        }
        __syncthreads();
        {
            const int tk = w * 4 + q4;
            const int trow = r0 + tk;
            const float* gq = W_mla_q_g + l * 96;
            const float2* rp = W_ROPE + (size_t)(trow & 2047) * 16;
#pragma unroll 1
            for (int h = 0; h < 4; h++) {
                float v[6];
                float ss = 0.f;
#pragma unroll
                for (int m = 0; m < 6; m++) { v[m] = R[tk * 516 + h * 96 + m * 16 + r16]; ss += v[m] * v[m]; }
                ss += __shfl_xor(ss, 1); ss += __shfl_xor(ss, 2); ss += __shfl_xor(ss, 4); ss += __shfl_xor(ss, 8);
                const float rs = rsqrtf(ss * (1.f / 96.f) + EPSF);
#pragma unroll
                for (int m = 0; m < 6; m++) v[m] = v[m] * rs * gq[m * 16 + r16];
                if (lat) {
#pragma unroll
                    for (int m = 4; m < 6; m++) {
                        const float other = __shfl_xor(v[m], 8);
                        const float2 cs = rp[(m - 4) * 8 + (r16 & 7)];
                        v[m] = (r16 < 8) ? (v[m] * cs.x - other * cs.y) : (other * cs.y + v[m] * cs.x);
                    }
                }
                bf16_t* dst = W_MQ + (size_t)trow * 384 + h * 96;
#pragma unroll
                for (int m = 0; m < 6; m++) dst[m * 16 + r16] = f2bf(v[m]);
            }
        }
        __syncthreads();
        {
            const bf16_t* WB = W_WUKVT + (size_t)l * 512 * 128;
            const float rs = rskv[r16];
#pragma unroll 2
            for (int it = 0; it < 8; it++) {
                const int nt = it * 4 + w;
                f32x4 acc = (f32x4){0.f, 0.f, 0.f, 0.f};
#pragma unroll
                for (int ks = 0; ks < 4; ks++) {
                    const bf16x8 bfr = *(const bf16x8*)(WB + (size_t)(nt * 16 + r16) * 128 + ks * 32 + q4 * 8);
                    const bf16x8 afr = *(const bf16x8*)(Ackv + r16 * 288 + ks * 64 + q4 * 16);
                    acc = __builtin_amdgcn_mfma_f32_16x16x32_bf16(bfr, afr, acc, 0, 0, 0);
                }
                *(float4*)&R[r16 * 516 + nt * 16 + q4 * 4] = make_float4(acc[0] * rs, acc[1] * rs, acc[2] * rs, acc[3] * rs);
            }
        }
        __syncthreads();
        {
            const int tk = w * 4 + q4;
            const int trow = r0 + tk;
            const float* gk = W_mla_k_g + l * 96;
            const float2* rp = W_ROPE + (size_t)(trow & 2047) * 16;
            const float kr0 = krf[tk * 32 + r16], kr1 = krf[tk * 32 + 16 + r16];
#pragma unroll 1
            for (int h = 0; h < 4; h++) {
                float v[6];
                float ss = 0.f;
#pragma unroll
                for (int m = 0; m < 4; m++) { v[m] = R[tk * 516 + h * 128 + m * 16 + r16]; ss += v[m] * v[m]; }
                v[4] = kr0; v[5] = kr1; ss += kr0 * kr0 + kr1 * kr1;
                ss += __shfl_xor(ss, 1); ss += __shfl_xor(ss, 2); ss += __shfl_xor(ss, 4); ss += __shfl_xor(ss, 8);
                const float rs = rsqrtf(ss * (1.f / 96.f) + EPSF);
#pragma unroll
                for (int m = 0; m < 6; m++) v[m] = v[m] * rs * gk[m * 16 + r16];
                if (lat) {
#pragma unroll
                    for (int m = 4; m < 6; m++) {
                        const float other = __shfl_xor(v[m], 8);
                        const float2 cs = rp[(m - 4) * 8 + (r16 & 7)];
                        v[m] = (r16 < 8) ? (v[m] * cs.x - other * cs.y) : (other * cs.y + v[m] * cs.x);
                    }
                }
                bf16_t* dst = W_MK + (size_t)trow * 384 + h * 96;
#pragma unroll
                for (int m = 0; m < 6; m++) dst[m * 16 + r16] = f2bf(v[m]);
            }
        }
        {
            const int h = tid >> 6, d = tid & 63;
            bf16_t* dst = W_MVT + (size_t)((bb * 4 + h) * 64 + d) * 2304 + posb;
            const float* src = R + h * 128 + 64 + d;
#pragma unroll
            for (int qq = 0; qq < 4; qq++) {
                uint2 pk;
                pk.x = pack2bf(src[(qq * 4 + 0) * 516], src[(qq * 4 + 1) * 516]);
                pk.y = pack2bf(src[(qq * 4 + 2) * 516], src[(qq * 4 + 3) * 516]);
                *(uint2*)(dst + qq * 8) = pk;
            }
        }
    }
}

template <int DQK, int QT, bool NA, class KIDX>
__device__ __forceinline__ void flash_attn(char* smc, const bf16_t* qrow0, int qstride, const bf16_t* kbuf_h, int kstride, int b,
                                           const bf16_t* vbase_bh, int nkb, KIDX kidx_of, float scale, bf16_t* orow0, int ostride,
                                           const float* rpbs, int na_r, int na_rs) {
    constexpr int KS = DQK / 32, CPR = DQK / 8, KSTR = DQK * 2 + 32, KBUF = 64 * KSTR, NKC = 64 * CPR / 256, VSTR = 160, VBUF = 64 * VSTR;
    const int tid = TIDX, lane = tid & 63, w = tid >> 6, r16 = lane & 15, q = lane >> 4;
    char* Kb = smc;
    char* Vb = smc + 2 * KBUF;
    bf16x8 qf[QT][KS];
#pragma unroll
    for (int qt = 0; qt < QT; qt++)
#pragma unroll
        for (int ks = 0; ks < KS; ks++) qf[qt][ks] = *(const bf16x8*)(qrow0 + (size_t)(w * QT * 16 + qt * 16 + r16) * qstride + ks * 32 + q * 8);
    f32x4 o[4][QT];
    float m[QT], ls[QT];
#pragma unroll
    for (int qt = 0; qt < QT; qt++) {
        m[qt] = -1e30f; ls[qt] = 0.f;
#pragma unroll
        for (int dt = 0; dt < 4; dt++) o[dt][qt] = (f32x4){0.f, 0.f, 0.f, 0.f};
    }
    u32x4 rk[NKC], rv[2];
    {
        const int kidx = kidx_of(0);
        const int trow = kidx < 2048 ? b * 2048 + kidx : NLAT + b * 256 + (kidx - 2048);
        const bf16_t* kp = kbuf_h + (size_t)trow * kstride;
        const bf16_t* vp = vbase_bh + kidx;
#pragma unroll
        for (int i = 0; i < NKC; i++) { const int c = tid + 256 * i; const int row = c / CPR, cc = c % CPR; rk[i] = *(const u32x4*)(kp + (size_t)row * kstride + cc * 8); }
#pragma unroll
        for (int i = 0; i < 2; i++) { const int c = tid + 256 * i; const int row = c >> 3, cc = c & 7; rv[i] = *(const u32x4*)(vp + (size_t)row * 2304 + cc * 8); }
    }
    __syncthreads();
#pragma unroll
    for (int i = 0; i < NKC; i++) { const int c = tid + 256 * i; const int row = c / CPR, cc = c % CPR; *(u32x4*)(Kb + row * KSTR + cc * 16) = rk[i]; }
#pragma unroll
    for (int i = 0; i < 2; i++) { const int c = tid + 256 * i; const int row = c >> 3, cc = c & 7; *(u32x4*)(Vb + row * VSTR + cc * 16) = rv[i]; }
    __syncthreads();
    for (int kb = 0; kb < nkb; kb++) {
        const bool more = kb + 1 < nkb;
        if (more) {
            const int kidx = kidx_of(kb + 1);
            const int trow = kidx < 2048 ? b * 2048 + kidx : NLAT + b * 256 + (kidx - 2048);
            const bf16_t* kp = kbuf_h + (size_t)trow * kstride;
            const bf16_t* vp = vbase_bh + kidx;
#pragma unroll
            for (int i = 0; i < NKC; i++) { const int c = tid + 256 * i; const int row = c / CPR, cc = c % CPR; rk[i] = *(const u32x4*)(kp + (size_t)row * kstride + cc * 8); }
#pragma unroll
            for (int i = 0; i < 2; i++) { const int c = tid + 256 * i; const int row = c >> 3, cc = c & 7; rv[i] = *(const u32x4*)(vp + (size_t)row * 2304 + cc * 8); }
        }
        const char* Ks_ = Kb + (kb & 1) * KBUF;
        const char* Vs_ = Vb + (kb & 1) * VBUF;
        f32x4 s[4][QT];
#pragma unroll
        for (int kt = 0; kt < 4; kt++) {
#pragma unroll
            for (int qt = 0; qt < QT; qt++) s[kt][qt] = (f32x4){0.f, 0.f, 0.f, 0.f};
#pragma unroll
            for (int ks = 0; ks < KS; ks++) {
                const bf16x8 kf = *(const bf16x8*)(Ks_ + (kt * 16 + r16) * KSTR + ks * 64 + q * 16);
#pragma unroll
                for (int qt = 0; qt < QT; qt++) s[kt][qt] = __builtin_amdgcn_mfma_f32_16x16x32_bf16(kf, qf[qt][ks], s[kt][qt], 0, 0, 0);
            }
        }
#pragma unroll
        for (int qt = 0; qt < QT; qt++) {
            float bm = -1e30f;
#pragma unroll
            for (int kt = 0; kt < 4; kt++)
#pragma unroll
                for (int e = 0; e < 4; e++) {
                    float v = s[kt][qt][e] * scale;
                    if (NA) {
                        if (kb < 8) {
                            const int kc = kt * 16 + q * 4 + e;
                            const int cq = w * 16 + r16;
                            const int dr = na_rs + kb - na_r + 7;
                            const int dc = min(max(kc - cq + 15, 0), 30);
                            const int cs = min(max(cq - 8, 0), 48);
                            const bool ok = (kc >= cs) && (kc < cs + 16);
                            v = ok ? v + rpbs[dr * 31 + dc] : -1e30f;
                        }
                    }
                    s[kt][qt][e] = v;
                    bm = fmaxf(bm, v);
                }
            bm = fmaxf(bm, __shfl_xor(bm, 16));
            bm = fmaxf(bm, __shfl_xor(bm, 32));
            const float mn = fmaxf(m[qt], bm);
            const float corr = __builtin_amdgcn_exp2f(m[qt] - mn);
            m[qt] = mn;
            float rsum = 0.f;
#pragma unroll
            for (int kt = 0; kt < 4; kt++)
#pragma unroll
                for (int e = 0; e < 4; e++) { const float pe = __builtin_amdgcn_exp2f(s[kt][qt][e] - mn); s[kt][qt][e] = pe; rsum += pe; }
            ls[qt] = ls[qt] * corr + rsum;
#pragma unroll
            for (int dt = 0; dt < 4; dt++) { o[dt][qt][0] *= corr; o[dt][qt][1] *= corr; o[dt][qt][2] *= corr; o[dt][qt][3] *= corr; }
        }
#pragma unroll
        for (int g = 0; g < 2; g++) {
            bf16x8 pf[QT];
#pragma unroll
            for (int qt = 0; qt < QT; qt++) {
                union { bf16x8 v; unsigned u[4]; } pk;
                pk.u[0] = pack2bf(s[2 * g][qt][0], s[2 * g][qt][1]); pk.u[1] = pack2bf(s[2 * g][qt][2], s[2 * g][qt][3]);
                pk.u[2] = pack2bf(s[2 * g + 1][qt][0], s[2 * g + 1][qt][1]); pk.u[3] = pack2bf(s[2 * g + 1][qt][2], s[2 * g + 1][qt][3]);
                pf[qt] = pk.v;
            }
#pragma unroll
            for (int dt = 0; dt < 4; dt++) {
                const bf16x8 vf = *(const bf16x8*)(Vs_ + (dt * 16 + r16) * VSTR + g * 64 + q * 16);
#pragma unroll
                for (int qt = 0; qt < QT; qt++) o[dt][qt] = __builtin_amdgcn_mfma_f32_16x16x32_bf16(vf, pf[qt], o[dt][qt], 0, 0, 0);
            }
        }
        if (more) {
            char* Kw = Kb + ((kb + 1) & 1) * KBUF;
            char* Vw = Vb + ((kb + 1) & 1) * VBUF;
#pragma unroll
            for (int i = 0; i < NKC; i++) { const int c = tid + 256 * i; const int row = c / CPR, cc = c % CPR; *(u32x4*)(Kw + row * KSTR + cc * 16) = rk[i]; }
#pragma unroll
            for (int i = 0; i < 2; i++) { const int c = tid + 256 * i; const int row = c >> 3, cc = c & 7; *(u32x4*)(Vw + row * VSTR + cc * 16) = rv[i]; }
        }
        __syncthreads();
    }
#pragma unroll
    for (int qt = 0; qt < QT; qt++) {
        float lt = ls[qt];
        lt += __shfl_xor(lt, 16);
        lt += __shfl_xor(lt, 32);
        const float inv = 1.f / lt;
#pragma unroll
        for (int dt = 0; dt < 4; dt++)
            st4bf(orow0 + (size_t)(w * QT * 16 + qt * 16 + r16) * ostride + dt * 16 + q * 4,
                  make_float4(o[dt][qt][0] * inv, o[dt][qt][1] * inv, o[dt][qt][2] * inv, o[dt][qt][3] * inv));
    }
}

__device__ __forceinline__ void mla_unit(const Params& p, int l, int u, bool isctx, float* sm) {
    int b, h, qb;
    if (!isctx) { b = u >> 6; h = (u >> 4) & 3; qb = u & 15; } else { b = u >> 3; h = (u >> 1) & 3; qb = u & 1; }
    const int qrow = (isctx ? NLAT + b * 256 : b * 2048) + qb * 128;
    const bf16_t* vb = W_MVT + (size_t)((b * 4 + h) * 64) * 2304;
    const float scale = 0.10206207261596577f * 1.4426950408889634f;
    if (!isctx)
        flash_attn<96, 2, false>((char*)sm, W_MQ + (size_t)qrow * 384 + h * 96, 384, W_MK + h * 96, 384, b, vb, 36, [](int kb) { return kb * 64; }, scale,
                                 W_CAT + (size_t)qrow * 1024 + 768 + h * 64, 1024, nullptr, 0, 0);
    else
        flash_attn<96, 2, false>((char*)sm, W_MQ + (size_t)qrow * 384 + h * 96, 384, W_MK + h * 96, 384, b, vb, 4, [](int kb) { return 2048 + kb * 64; }, scale,
                                 W_CAT + (size_t)qrow * 1024 + 768 + h * 64, 1024, nullptr, 0, 0);
}
__device__ __forceinline__ void na_unit(const Params& p, int l, int u, bool isctx, float* sm) {
    if (!isctx) {
        const int b = u >> 7, h = (u >> 5) & 3, r = u & 31;
        const int rs = min(max(r - 4, 0), 24);
        float* rpbs = sm + 10240;
        __syncthreads();
        for (int i = TIDX; i < 15 * 31; i += 256) rpbs[i] = W_na_rpb[(size_t)(l * 4 + h) * 465 + i] * 1.4426950408889634f;
        const int qrow = b * 2048 + r * 64;
        flash_attn<64, 1, true>((char*)sm, W_NQ + (size_t)qrow * 256 + h * 64, 256, W_NK + h * 64, 256, b, W_NVT + (size_t)((b * 4 + h) * 64) * 2304, 12,
                                [rs](int kb) { return kb < 8 ? (rs + kb) * 64 : 2048 + (kb - 8) * 64; }, 0.125f * 1.4426950408889634f,
                                W_CAT + (size_t)qrow * 1024 + 512 + h * 64, 1024, rpbs, r, rs);
    } else {
        const int b = u >> 4, h = (u >> 2) & 3, qb = u & 3;
        const int qrow = NLAT + b * 256 + qb * 64;
        flash_attn<64, 1, false>((char*)sm, W_NQ + (size_t)qrow * 256 + h * 64, 256, W_NK + h * 64, 256, b, W_NVT + (size_t)((b * 4 + h) * 64) * 2304, 4,
                                 [](int kb) { return 2048 + kb * 64; }, 0.125f * 1.4426950408889634f, W_CAT + (size_t)qrow * 1024 + 512 + h * 64, 1024, nullptr, 0, 0);
    }
}

__device__ __forceinline__ void hgrn_local_unit(const Params& p, int l, int u, float* sm) {
    const int tid = TIDX;
    const int b = u / 144, h = (u / 36) & 3, cid = u % 36;
    const int row0 = cid < 4 ? NLAT + b * 256 + cid * 64 : b * 2048 + (cid - 4) * 64;
    float* B0 = sm;
    char* VT = (char*)(sm + 4352);
    char* KB = (char*)(sm + 6656);
    float* B2 = sm + 8960;
    float* B3 = sm + 13312;
    float* SC = sm + 17408;
    const int lane_ = tid & 63, w_ = tid >> 6, r16 = lane_ & 15, q4 = lane_ >> 4;
    const int k = tid & 63, seg = tid >> 6;
    const int ti = tid >> 4, ts = tid & 15;
    float acc[4][4];
#pragma unroll
    for (int a = 0; a < 4; a++)
#pragma unroll
        for (int c = 0; c < 4; c++) acc[a][c] = 0.f;
    __syncthreads();
    {
        const int s_ = tid >> 2, c0 = (tid & 3) * 16;
        const bf16_t* src = W_P + (size_t)(row0 + s_) * DIN + C_HI + h * 64 + c0;
        const u32x4 v0 = *(const u32x4*)src, v1 = *(const u32x4*)(src + 8);
#pragma unroll
        for (int j = 0; j < 4; j++) {
            *(bf16_t*)(VT + (c0 + 2 * j) * 144 + s_ * 2) = (bf16_t)(v0[j] & 0xFFFFu);
            *(bf16_t*)(VT + (c0 + 2 * j + 1) * 144 + s_ * 2) = (bf16_t)(v0[j] >> 16);
            *(bf16_t*)(VT + (c0 + 8 + 2 * j) * 144 + s_ * 2) = (bf16_t)(v1[j] & 0xFFFFu);
            *(bf16_t*)(VT + (c0 + 8 + 2 * j + 1) * 144 + s_ * 2) = (bf16_t)(v1[j] >> 16);
        }
    }
    float qv[16];
#pragma unroll
    for (int j = 0; j < 16; j++) qv[j] = bf2f(W_P[(size_t)(row0 + seg * 16 + j) * DIN + C_HQ + h * 64 + k]);
#pragma unroll
    for (int j = 0; j < 4; j++) *(float4*)&B0[k * 68 + seg * 16 + 4 * j] = make_float4(qv[4 * j], qv[4 * j + 1], qv[4 * j + 2], qv[4 * j + 3]);
#pragma unroll 1
    for (int dir = 0; dir < 2; dir++) {
        const int zoff = dir ? C_ZB : C_ZF;
        const float lbv = W_LB[(l * 2 + dir) * 256 + h * 64 + k];
        const size_t ud = (size_t)u * 2 + dir;
        float bl[16], kkv[16];
#pragma unroll
        for (int j = 0; j < 16; j++) {
            float z = bf2f(W_P[(size_t)(row0 + seg * 16 + j) * DIN + zoff + h * 64 + k]);
            z = fminf(fmaxf(z, -20.f), 20.f);
            const float e_ = __expf(-z);
            const float sg = 1.f / (1.f + e_);
            const float f = lbv + (1.f - lbv) * sg;
            bl[j] = __log2f(f);
            kkv[j] = (1.f - lbv) * (e_ * sg);
        }
        float tot;
        if (dir == 0) {
#pragma unroll
            for (int j = 1; j < 16; j++) bl[j] += bl[j - 1];
            tot = bl[15];
        } else {
#pragma unroll
            for (int j = 14; j >= 0; j--) bl[j] += bl[j + 1];
            tot = bl[0];
        }
        SC[seg * 64 + k] = tot;
        __syncthreads();
        float off = 0.f;
#pragma unroll
        for (int s2 = 0; s2 < 4; s2++) if (dir ? (s2 > seg) : (s2 < seg)) off += SC[s2 * 64 + k];
        const float btot = SC[k] + SC[64 + k] + SC[128 + k] + SC[192 + k];
#pragma unroll
        for (int j = 0; j < 16; j++) bl[j] += off;
#pragma unroll
        for (int j = 0; j < 4; j++) {
            const float Rj = dir ? bl[4 * j] : bl[4 * j + 3];
            *(float4*)&B2[k * 68 + seg * 16 + 4 * j] = make_float4(kkv[4 * j] * __builtin_amdgcn_exp2f(Rj - bl[4 * j]), kkv[4 * j + 1] * __builtin_amdgcn_exp2f(Rj - bl[4 * j + 1]),
                                                                   kkv[4 * j + 2] * __builtin_amdgcn_exp2f(Rj - bl[4 * j + 2]), kkv[4 * j + 3] * __builtin_amdgcn_exp2f(Rj - bl[4 * j + 3]));
            *(float4*)&B3[k * 64 + seg * 16 + 4 * j] = make_float4(bl[4 * j], bl[4 * j + 1], bl[4 * j + 2], bl[4 * j + 3]);
#pragma unroll
            for (int jj = 0; jj < 4; jj++)
                ((bf16_t*)W_HQ)[(ud * 64 + seg * 16 + 4 * j + jj) * 64 + k] = f2bf(qv[4 * j + jj] * __builtin_amdgcn_exp2f(bl[4 * j + jj]));
        }
        if (seg == 0) W_HD[ud * 64 + k] = __builtin_amdgcn_exp2f(btot);
        {
            u32x4 k0, k1;
#pragma unroll
            for (int j = 0; j < 4; j++) {
                k0[j] = pack2bf(kkv[2 * j] * __builtin_amdgcn_exp2f(btot - bl[2 * j]), kkv[2 * j + 1] * __builtin_amdgcn_exp2f(btot - bl[2 * j + 1]));
                k1[j] = pack2bf(kkv[8 + 2 * j] * __builtin_amdgcn_exp2f(btot - bl[8 + 2 * j]), kkv[8 + 2 * j + 1] * __builtin_amdgcn_exp2f(btot - bl[8 + 2 * j + 1]));
            }
            *(u32x4*)(KB + k * 144 + seg * 32) = k0;
            *(u32x4*)(KB + k * 144 + seg * 32 + 16) = k1;
        }
        __syncthreads();
        const bool active = dir ? (ts >= ti) : (ts <= ti);
        if (active) {
            float a2[4][4];
#pragma unroll
            for (int a = 0; a < 4; a++)
#pragma unroll
                for (int c = 0; c < 4; c++) a2[a][c] = 0.f;
#pragma unroll 2
            for (int kk_ = 0; kk_ < 64; kk_++) {
                const float4 q4 = *(const float4*)&B0[kk_ * 68 + ti * 4];
                const float4 bq4 = *(const float4*)&B3[kk_ * 64 + ti * 4];
                const float4 k4 = *(const float4*)&B2[kk_ * 68 + ts * 4];
                const float4 bk4 = *(const float4*)&B3[kk_ * 64 + ts * 4];
                const float R = dir ? bk4.x : bk4.w;
                const float qr[4] = {q4.x * __builtin_amdgcn_exp2f(bq4.x - R), q4.y * __builtin_amdgcn_exp2f(bq4.y - R), q4.z * __builtin_amdgcn_exp2f(bq4.z - R), q4.w * __builtin_amdgcn_exp2f(bq4.w - R)};
                const float ka[4] = {k4.x, k4.y, k4.z, k4.w};
#pragma unroll
                for (int a = 0; a < 4; a++)
#pragma unroll
                    for (int c = 0; c < 4; c++) a2[a][c] += qr[a] * ka[c];
            }
#pragma unroll
            for (int a = 0; a < 4; a++)
#pragma unroll
                for (int c = 0; c < 4; c++) {
                    const int i_ = ti * 4 + a, s_ = ts * 4 + c;
                    const bool valid = dir ? (s_ >= i_) : (s_ <= i_);
                    acc[a][c] += valid ? a2[a][c] : 0.f;
                }
        }
        {
            f32x4 ua[4];
#pragma unroll
            for (int vt = 0; vt < 4; vt++) ua[vt] = (f32x4){0.f, 0.f, 0.f, 0.f};
#pragma unroll
            for (int ss_ = 0; ss_ < 2; ss_++) {
                const bf16x8 kbf = *(const bf16x8*)(KB + (w_ * 16 + r16) * 144 + ss_ * 64 + q4 * 16);
#pragma unroll
                for (int vt = 0; vt < 4; vt++) {
                    const bf16x8 vtf = *(const bf16x8*)(VT + (vt * 16 + r16) * 144 + ss_ * 64 + q4 * 16);
                    ua[vt] = __builtin_amdgcn_mfma_f32_16x16x32_bf16(vtf, kbf, ua[vt], 0, 0, 0);
                }
            }
#pragma unroll
            for (int vt = 0; vt < 4; vt++) st4bf((bf16_t*)W_HU + ud * 4096 + (w_ * 16 + r16) * 64 + vt * 16 + q4 * 4, make_float4(ua[vt][0], ua[vt][1], ua[vt][2], ua[vt][3]));
        }
    }
    __syncthreads();
    {
        char* AB = (char*)B2;
#pragma unroll
        for (int a2_ = 0; a2_ < 4; a2_++) {
            uint2 pk; pk.x = pack2bf(acc[a2_][0], acc[a2_][1]); pk.y = pack2bf(acc[a2_][2], acc[a2_][3]);
            *(uint2*)(AB + (ti * 4 + a2_) * 144 + ts * 8) = pk;
        }
        __syncthreads();
        f32x4 oa[4];
#pragma unroll
        for (int vt = 0; vt < 4; vt++) oa[vt] = (f32x4){0.f, 0.f, 0.f, 0.f};
#pragma unroll
        for (int ss_ = 0; ss_ < 2; ss_++) {
            const bf16x8 abf = *(const bf16x8*)(AB + (w_ * 16 + r16) * 144 + ss_ * 64 + q4 * 16);
#pragma unroll
            for (int vt = 0; vt < 4; vt++) {
                const bf16x8 vtf = *(const bf16x8*)(VT + (vt * 16 + r16) * 144 + ss_ * 64 + q4 * 16);
                oa[vt] = __builtin_amdgcn_mfma_f32_16x16x32_bf16(vtf, abf, oa[vt], 0, 0, 0);
            }
        }
#pragma unroll
        for (int vt = 0; vt < 4; vt++) *(f32x4*)&W_OF[(size_t)(row0 + w_ * 16 + r16) * 256 + h * 64 + vt * 16 + q4 * 4] = oa[vt];
    }
}

__device__ __forceinline__ void hgrn_scan_unit(const Params& p, int l, int u) {
    const int tid = TIDX;
    const int bh = u >> 5, dir = (u >> 4) & 1, sl = u & 15;
    const int ubase = bh * 36;
    const int e = sl * 256 + tid;
    const int kq = e >> 6;
    const bf16_t* HUb = (const bf16_t*)W_HU; const float* HDb = W_HD; bf16_t* SPb = (bf16_t*)W_SP;
    float S = 0.f;
#pragma unroll 6
    for (int n = 0; n < 36; n++) {
        const int cn = dir == 0 ? n : (n < 4 ? 3 - n : 39 - n);
        const size_t ud = (size_t)(ubase + cn) * 2 + dir;
        SPb[ud * 4096 + e] = f2bf(S);
        S = S * HDb[ud * 64 + kq] + bf2f(HUb[ud * 4096 + e]);
    }
}
__device__ __forceinline__ void hgrn_final_unit(const Params& p, int l, int u, float* sm) {
    const int tid = TIDX, lane = tid & 63, w = tid >> 6, r16 = lane & 15, q4 = lane >> 4;
    const int b = u / 144, h = (u / 36) & 3, cid = u % 36;
    const int row0 = cid < 4 ? NLAT + b * 256 + cid * 64 : b * 2048 + (cid - 4) * 64;
    char* ST = (char*)sm;
    __syncthreads();
#pragma unroll
    for (int dir = 0; dir < 2; dir++) {
        const bf16_t* sp = (const bf16_t*)W_SP + ((size_t)u * 2 + dir) * 4096;
#pragma unroll
        for (int j = 0; j < 2; j++) {
            const int e8 = tid + 256 * j, kk_ = e8 >> 3, v0 = (e8 & 7) * 8;
            const u32x4 sv = *(const u32x4*)&sp[e8 * 8];
            char* dst = ST + dir * 9216 + kk_ * 2;
#pragma unroll
            for (int t = 0; t < 4; t++) {
                *(bf16_t*)(dst + (v0 + 2 * t) * 144) = (bf16_t)(sv[t] & 0xFFFFu);
                *(bf16_t*)(dst + (v0 + 2 * t + 1) * 144) = (bf16_t)(sv[t] >> 16);
            }
        }
    }
    const int row = row0 + w * 16 + r16;
    f32x4 oa[4];
#pragma unroll
    for (int vt = 0; vt < 4; vt++) oa[vt] = *(const f32x4*)&W_OF[(size_t)row * 256 + h * 64 + vt * 16 + q4 * 4];
    bf16x8 qd[2][2];
#pragma unroll
    for (int dir = 0; dir < 2; dir++)
#pragma unroll
        for (int ks = 0; ks < 2; ks++) qd[dir][ks] = *(const bf16x8*)((const bf16_t*)W_HQ + (((size_t)u * 2 + dir) * 64 + w * 16 + r16) * 64 + ks * 32 + q4 * 8);
    __syncthreads();
#pragma unroll
    for (int dir = 0; dir < 2; dir++)
#pragma unroll
        for (int ks = 0; ks < 2; ks++)
#pragma unroll
            for (int vt = 0; vt < 4; vt++) {
                const bf16x8 stf = *(const bf16x8*)(ST + dir * 9216 + (vt * 16 + r16) * 144 + ks * 64 + q4 * 16);
                oa[vt] = __builtin_amdgcn_mfma_f32_16x16x32_bf16(stf, qd[dir][ks], oa[vt], 0, 0, 0);
            }
    float ss = 0.f;
#pragma unroll
    for (int vt = 0; vt < 4; vt++) ss += oa[vt][0] * oa[vt][0] + oa[vt][1] * oa[vt][1] + oa[vt][2] * oa[vt][2] + oa[vt][3] * oa[vt][3];
    ss += __shfl_xor(ss, 16); ss += __shfl_xor(ss, 32);
    const float rs = rsqrtf(ss * (1.f / 64.f) + EPSF);
#pragma unroll
    for (int vt = 0; vt < 4; vt++) {
        const int v0 = vt * 16 + q4 * 4;
        const float4 g = *(const float4*)&W_hgrn_norm_g[l * 64 + v0];
        const float4 gt = ld4bf(&W_P[(size_t)row * DIN + C_HG + h * 64 + v0]);
        st4bf(&W_CAT[(size_t)row * 1024 + h * 64 + v0],
              make_float4(oa[vt][0] * rs * g.x * siluf_(gt.x), oa[vt][1] * rs * g.y * siluf_(gt.y), oa[vt][2] * rs * g.z * siluf_(gt.z), oa[vt][3] * rs * g.w * siluf_(gt.w)));
    }
}

template <int LL>
__device__ __forceinline__ void hyena_unit(const Params& p, int l, int b, int cp, float* sm) {
    constexpr int NT = LL / 256;
    float zprev[NT];
#pragma unroll 1
    for (int chh = 0; chh < 2; chh++) {
    const int c = cp * 2 + chh;
    constexpr bool isctx = (LL == 256);
    const int tid = TIDX;
    float* zs = sm;
    float* kc = sm + LL;
    const int rowbase = isctx ? NLAT + b * 256 : b * 2048;
    float z[NT], x1[NT], x2[NT];
#pragma unroll
    for (int i = 0; i < NT; i++) {
        const int t = tid + 256 * i;
        float val[3];
#pragma unroll
        for (int q = 0; q < 3; q++) {
            const int chn = q * 256 + c;
            const int col = C_HY + chn;
            const float um = t > 0 ? bf2f(W_P[(size_t)(rowbase + t - 1) * DIN + col]) : 0.f;
            const float u0 = bf2f(W_P[(size_t)(rowbase + t) * DIN + col]);
            const float up = t < LL - 1 ? bf2f(W_P[(size_t)(rowbase + t + 1) * DIN + col]) : 0.f;
            val[q] = W_hy_short_w[(l * 3 + 0) * 768 + chn] * um + W_hy_short_w[(l * 3 + 1) * 768 + chn] * u0 + W_hy_short_w[(l * 3 + 2) * 768 + chn] * up +
                     W_hy_short_b[l * 768 + chn];
        }
        z[i] = val[0]; x1[i] = val[1]; x2[i] = val[2];
    }
#pragma unroll
    for (int o = 0; o < 2; o++) {
        const float* kbase = W_HYKC + (size_t)((l * 2 + o) * 256 + c) * 2 * LL;
        __syncthreads();
        for (int i = tid; i < 2 * LL - 1; i += 256) { const int d = i - (LL - 1); kc[i] = d >= 0 ? kbase[d] : kbase[LL - d]; }
#pragma unroll
        for (int i = 0; i < NT; i++) zs[tid + 256 * i] = z[i];
        __syncthreads();
        float acc[NT];
#pragma unroll
        for (int i = 0; i < NT; i++) acc[i] = 0.f;
        for (int s = 0; s < LL; s++) {
            const float zv = zs[s];
#pragma unroll
            for (int i = 0; i < NT; i++) acc[i] += kc[(tid + 256 * i) - s + (LL - 1)] * zv;
        }
        const float dbv = W_hy_bias[(l * 2 + o) * 256 + c];
#pragma unroll
        for (int i = 0; i < NT; i++) z[i] = (o == 0 ? x1[i] : x2[i]) * (acc[i] + dbv * z[i]);
    }
    if (chh == 0) {
#pragma unroll
        for (int i = 0; i < NT; i++) zprev[i] = z[i];
    } else {
#pragma unroll
        for (int i = 0; i < NT; i++) *(unsigned*)&W_CAT[(size_t)(rowbase + tid + 256 * i) * 1024 + 256 + cp * 2] = pack2bf(zprev[i], z[i]);
    }
    }
}

__device__ __forceinline__ void hyena_fft_unit(const Params& p, int l, int bp, int cp, float* sm) {
    const int tid = TIDX;
    float2* fb = (float2*)sm;
    float* raw = sm + 8704;
    bf16_t* zp = (bf16_t*)(sm + 12808);
    float2* twl = (float2*)(sm + 14856);
    __syncthreads();
    { const float2* twg = W_TW;
#pragma unroll
      for (int i = 0; i < 4; i++) twl[tid + 256 * i] = twg[tid + 256 * i]; }
    if (tid < 2) { raw[tid * 2050] = 0.f; raw[tid * 2050 + 2049] = 0.f; }
#pragma unroll 1
    for (int chh = 0; chh < 2; chh++) {
        const int c = cp * 2 + chh;
        float z[2][8];
#pragma unroll 1
        for (int st = 0; st < 3; st++) {
            if (st > 0) {
                const int o = st - 1;
                float2 v[4][4];
#pragma unroll
                for (int r1 = 0; r1 < 4; r1++)
#pragma unroll
                    for (int r2 = 0; r2 < 4; r2++) v[r1][r2] = r1 < 2 ? make_float2(z[0][(r1 & 1) * 4 + r2], z[1][(r1 & 1) * 4 + r2]) : make_float2(0.f, 0.f);
                fft_fwd_pass<0>(v, tid, twl);
                fft_lds_write<0>(v, tid, fb);
                __syncthreads();
                const float2* ks = W_KSPEC + (size_t)((l * 2 + o) * 256 + c) * 4096 + tid * 16;
                float2 kv[16];
#pragma unroll
                for (int j = 0; j < 16; j++) kv[j] = ks[j];
                fft_lds_read<2>(v, tid, fb);
                fft_fwd_pass<2>(v, tid, twl);
                fft_lds_write<2>(v, tid, fb);
                __syncthreads();
                fft_lds_read<4>(v, tid, fb);
                fft_fwd_pass<4>(v, tid, twl);
#pragma unroll
                for (int r1 = 0; r1 < 4; r1++)
#pragma unroll
                    for (int r2 = 0; r2 < 4; r2++) v[r1][r2] = cmul(v[r1][r2], kv[r1 * 4 + r2]);
                fft_inv_pass<4>(v, tid, twl);
                fft_lds_write<4>(v, tid, fb);
                __syncthreads();
                fft_lds_read<2>(v, tid, fb);
                fft_inv_pass<2>(v, tid, twl);
                fft_lds_write<2>(v, tid, fb);
                __syncthreads();
                fft_lds_read<0>(v, tid, fb);
                fft_inv_pass<0>(v, tid, twl);
                const float dbv = W_hy_bias[(l * 2 + o) * 256 + c];
#pragma unroll
                for (int r1 = 0; r1 < 2; r1++)
#pragma unroll
                    for (int r2 = 0; r2 < 4; r2++) {
                        const int i = r1 * 4 + r2;
                        z[0][i] = v[r1][r2].x + dbv * z[0][i];
                        z[1][i] = v[r1][r2].y + dbv * z[1][i];
                    }
            }
            const int chn = st * 256 + c;
#pragma unroll 1
            for (int b2 = 0; b2 < 2; b2++)
#pragma unroll 4
                for (int i = 0; i < 8; i++) {
                    const int t = tid + 256 * i;
                    raw[b2 * 2050 + 1 + t] = bf2f(W_HYT[((size_t)(bp * 2 + b2) * 768 + chn) * 2048 + t]);
                }
            __syncthreads();
            const float w0 = W_hy_short_w[(l * 3 + 0) * 768 + chn], w1 = W_hy_short_w[(l * 3 + 1) * 768 + chn], w2 = W_hy_short_w[(l * 3 + 2) * 768 + chn];
            const float sb = W_hy_short_b[l * 768 + chn];
#pragma unroll
            for (int b2 = 0; b2 < 2; b2++)
#pragma unroll
                for (int i = 0; i < 8; i++) {
                    const int t = tid + 256 * i;
                    const float val = w0 * raw[b2 * 2050 + t] + w1 * raw[b2 * 2050 + t + 1] + w2 * raw[b2 * 2050 + t + 2] + sb;
                    z[b2][i] = st == 0 ? val : val * z[b2][i];
                }
            __syncthreads();
        }
        if (chh == 0) {
#pragma unroll
            for (int b2 = 0; b2 < 2; b2++)
#pragma unroll
                for (int i = 0; i < 8; i++) zp[(b2 * 8 + i) * 256 + tid] = f2bf(z[b2][i]);
        } else {
#pragma unroll
            for (int b2 = 0; b2 < 2; b2++)
#pragma unroll
                for (int i = 0; i < 8; i++)
                    *(unsigned*)&W_CAT[(size_t)((bp * 2 + b2) * 2048 + tid + 256 * i) * 1024 + 256 + cp * 2] = ((unsigned)zp[(b2 * 8 + i) * 256 + tid] | ((unsigned)f2bf(z[b2][i]) << 16));
        }
    }
}

__device__ __forceinline__ void moe_conv_unit(const Params& p, int l, int u, float* sm) {
    const int tid = TIDX;
    bf16_t* const wmoe = W_WMOE;
    const float* src; size_t doff; int N, K, kt, ng;
    if (u < 2048) {
        const int m = u >> 10, r = u & 1023, e = r >> 5; kt = (r >> 1) & 15; ng = r & 1; N = 512; K = 1024;
        src = (m ? p.moe_w_up : p.moe_w_gate) + (size_t)(l * 32 + e) * 1024 * 512;
        doff = (size_t)m * 32 * 512 * 1024 + (size_t)e * 512 * 1024;
    } else {
        const int v = u - 2048, e = v >> 5, r = v & 31; kt = r >> 2; ng = r & 3; N = 1024; K = 512;
        src = p.moe_w_down + (size_t)(l * 32 + e) * 512 * 1024;
        doff = (size_t)2 * 32 * 512 * 1024 + (size_t)e * 1024 * 512;
    }
    bf16_t* dst = wmoe + doff;
    __syncthreads();
#pragma unroll 4
    for (int i = 0; i < 16; i++) {
        const int idx = tid + 256 * i, kr = idx >> 6, c4 = idx & 63;
        const float4 v = *(const float4*)&src[(size_t)(kt * 64 + kr) * N + ng * 256 + c4 * 4];
        *(float4*)&sm[kr * 260 + c4 * 4] = v;
    }
    __syncthreads();
#pragma unroll 2
    for (int i = 0; i < 8; i++) {
        const int idx = tid + 256 * i, nr = idx >> 3, c8 = idx & 7;
        const float* col = sm + (c8 * 8) * 260 + nr;
        u32x4 o;
        o[0] = pack2bf(col[0], col[260]); o[1] = pack2bf(col[2 * 260], col[3 * 260]);
        o[2] = pack2bf(col[4 * 260], col[5 * 260]); o[3] = pack2bf(col[6 * 260], col[7 * 260]);
        *(u32x4*)&dst[(size_t)(ng * 256 + nr) * K + kt * 64 + c8 * 8] = o;
    }
}

__device__ void phase_mix(const Params& p, int l, float* sm) {
    const bool need_ctx = l < DEPTH - 1;
    const int G = gridDim.x, bid = BIDX;
    for (int u = wq_next(WQ(p, l, 3), sm); u < 512; u = wq_next(WQ(p, l, 3), sm)) hyena_fft_unit(p, l, u >> 7, u & 127, sm);
    for (int u = wq_next(WQ(p, l, 13), sm); u < 1024; u = wq_next(WQ(p, l, 13), sm)) hgrn_scan_unit(p, l, u);
    for (int u = wq_next(WQ(p, l, 4), sm); u < 1024; u = wq_next(WQ(p, l, 4), sm)) na_unit(p, l, u, false, sm);
    if (need_ctx) {
        for (int u = wq_next(WQ(p, l, 5), sm); u < 128; u = wq_next(WQ(p, l, 5), sm)) na_unit(p, l, u, true, sm);
        for (int u = wq_next(WQ(p, l, 6), sm); u < 1024; u = wq_next(WQ(p, l, 6), sm)) hyena_unit<256>(p, l, u >> 7, u & 127, sm);
    }
}
__device__ void phase_mix2(const Params& p, int l, float* sm) {
    const bool need_ctx = l < DEPTH - 1;
    const int bid = BIDX;
    const bool conv_first = (bid >> 8) & 1;
#pragma unroll 1
    for (int st = 0; st < 2; st++) {
        if ((st == 0) == conv_first) {
            for (int u = wq_next(WQ(p, l, 15), sm); u < 3072; u = wq_next(WQ(p, l, 15), sm)) moe_conv_unit(p, l, u, sm);
        } else {
            for (int u = wq_next(WQ(p, l, 7), sm); u < 512; u = wq_next(WQ(p, l, 7), sm)) mla_unit(p, l, u, false, sm);
            for (int u = wq_next(WQ(p, l, 8), sm); u < 1152; u = wq_next(WQ(p, l, 8), sm)) { if (need_ctx || (u % 36) >= 4) hgrn_final_unit(p, l, u, sm); }
            if (need_ctx) for (int u = wq_next(WQ(p, l, 9), sm); u < 64; u = wq_next(WQ(p, l, 9), sm)) mla_unit(p, l, u, true, sm);
        }
    }
}

__device__ void phase_gemm2(const Params& p, int l, float* sm) {
    const int nrows = (l < DEPTH - 1) ? TT : NLAT;
    const float* W = p.w_out + (size_t)l * 1024 * 1024;
    const int tid = TIDX, lane = tid & 63, w = tid >> 6, wm = w >> 1, wn = w & 1, r16 = lane & 15, q = lane >> 4;
    for (int u = wq_next(WQ(p, l, 10), sm); u < (nrows / 128) * 8; u = wq_next(WQ(p, l, 10), sm)) {
        const int rb = u >> 3, cb = u & 7;
        const int r0 = rb * 128, n0 = cb * 128;
        const float* g1 = W_MOD + (size_t)(l * 9 + bidx_of(r0)) * 6144 + 2048;
        f32x4 acc[4][4];
        const bf16_t* cb_ = W_CAT + (size_t)r0 * 1024;
        const bf16_t* wb = W_WOUTT + (size_t)l * 1024 * 1024 + (size_t)n0 * 1024;
        gemm128_bt<true>(1024, (char*)sm, [&](int r) { return cb_ + (size_t)r * 1024; }, [&](int r) { return wb + (size_t)r * 1024; }, acc);
#pragma unroll
        for (int i = 0; i < 4; i++)
#pragma unroll
            for (int j = 0; j < 4; j++) {
                const int m = r0 + wm * 64 + i * 16 + r16, n = n0 + wn * 64 + j * 16 + q * 4;
                const float* xsrc = l > 0 ? &W_X[(size_t)m * 1024 + n] : (m < NLAT ? &p.x[(size_t)m * 1024 + n] : &p.ctx[(size_t)(m - NLAT) * 1024 + n]);
                float4 xv = *(const float4*)xsrc;
                const float4 g = *(const float4*)&g1[n];
                xv.x += g.x * acc[i][j][0]; xv.y += g.y * acc[i][j][1]; xv.z += g.z * acc[i][j][2]; xv.w += g.w * acc[i][j][3];
                *(float4*)&W_X[(size_t)m * 1024 + n] = xv;
            }
    }
}

__device__ void phase_norm2(const Params& p, int l, float* sm) {
    const int tid = TIDX, wave = tid >> 6, lane = tid & 63, r16 = lane & 15, kq = lane >> 4;
    const int nrows = (l < DEPTH - 1) ? TT : NLAT;
    float* red = sm;
    float* lg = sm + 64;
    for (int t16 = wq_next(WQ(p, l, 14), sm); t16 < nrows / 16; t16 = wq_next(WQ(p, l, 14), sm)) {
        const int row = t16 * 16 + r16;
        const int bi = bidx_of(t16 * 16);
        const int kb = wave * 256 + kq * 64;
        const float* xr = W_X + (size_t)row * 1024 + kb;
        float ss = 0.f;
#pragma unroll
        for (int i = 0; i < 16; i++) { const float4 v = *(const float4*)&xr[i * 4]; ss += v.x * v.x + v.y * v.y + v.z * v.z + v.w * v.w; }
        ss += __shfl_xor(ss, 16); ss += __shfl_xor(ss, 32);
        if (kq == 0) red[wave * 16 + r16] = ss;
        __syncthreads();
        const float rstd = rsqrtf((red[r16] + red[16 + r16] + red[32 + r16] + red[48 + r16]) * (1.f / 1024.f) + EPSF);
        const float* md = W_MOD + (size_t)(l * 9 + bi) * 6144 + kb;
        const float* gn = W_norm2_g + l * 1024 + kb;
        const float* we = W_moe_we + (size_t)(l * 1024 + kb) * 32 + r16;
        const float* wg = W_moe_wg + (size_t)(l * 1024 + kb) * 4 + (r16 & 3);
        bf16_t* hr = W_H + (size_t)row * 1024 + kb;
        f32x4 a0 = (f32x4){0.f, 0.f, 0.f, 0.f}, a1 = a0, a2 = a0;
#pragma unroll 2
        for (int i = 0; i < 16; i++) {
            const float4 xq = *(const float4*)&xr[i * 4];
            const float4 g = *(const float4*)&gn[i * 4];
            const float4 sh = *(const float4*)&md[3072 + i * 4];
            const float4 sc = *(const float4*)&md[4096 + i * 4];
            float h[4];
            h[0] = xq.x * rstd * g.x * (1.f + sc.x) + sh.x; h[1] = xq.y * rstd * g.y * (1.f + sc.y) + sh.y;
            h[2] = xq.z * rstd * g.z * (1.f + sc.z) + sh.z; h[3] = xq.w * rstd * g.w * (1.f + sc.w) + sh.w;
            st4bf(hr + i * 4, make_float4(h[0], h[1], h[2], h[3]));
#pragma unroll
            for (int e = 0; e < 4; e++) {
                const int k = i * 4 + e;
                const float b0 = we[k * 32], b1 = we[k * 32 + 16];
                const float b2 = r16 < 4 ? wg[k * 4] : 0.f;
                a0 = __builtin_amdgcn_mfma_f32_16x16x4f32(h[e], b0, a0, 0, 0, 0);
                a1 = __builtin_amdgcn_mfma_f32_16x16x4f32(h[e], b1, a1, 0, 0, 0);
                a2 = __builtin_amdgcn_mfma_f32_16x16x4f32(h[e], b2, a2, 0, 0, 0);
            }
        }
        float* lw = lg + wave * 768;
#pragma unroll
        for (int e = 0; e < 4; e++) {
            lw[(kq * 4 + e) * 48 + r16] = a0[e];
            lw[(kq * 4 + e) * 48 + 16 + r16] = a1[e];
            lw[(kq * 4 + e) * 48 + 32 + r16] = a2[e];
        }
        __syncthreads();
        if (tid < 16) {
            const float* L0 = lg + tid * 48;
            const int rrow = t16 * 16 + tid;
            float gl[4];
#pragma unroll
            for (int c = 0; c < 4; c++) gl[c] = L0[32 + c] + L0[768 + 32 + c] + L0[1536 + 32 + c] + L0[2304 + 32 + c] + W_moe_bg[l * 4 + c];
            int gs = 0; float best = gl[0];
#pragma unroll
            for (int c = 1; c < 4; c++) if (gl[c] > best) { best = gl[c]; gs = c; }
            float den = 0.f;
#pragma unroll
            for (int c = 0; c < 4; c++) den += expf(gl[c] - best);
            const float psel = 1.f / den;
            float le[8];
#pragma unroll
            for (int i = 0; i < 8; i++) { const int c = gs * 8 + i; le[i] = L0[c] + L0[768 + c] + L0[1536 + c] + L0[2304 + c] + W_moe_be[l * 32 + c]; }
            int i1 = 0; float v1 = le[0];
#pragma unroll
            for (int i = 1; i < 8; i++) if (le[i] > v1) { v1 = le[i]; i1 = i; }
            int i2 = -1; float v2 = -3.0e38f;
#pragma unroll
            for (int i = 0; i < 8; i++) if (i != i1 && le[i] > v2) { v2 = le[i]; i2 = i; }
            const float e2 = expf(v2 - v1);
            const float w1 = psel / (1.f + e2), w2 = psel * e2 / (1.f + e2);
            const int ea = gs * 8 + i1, eb = gs * 8 + i2;
            const int n0 = rrow * 2, n1 = rrow * 2 + 1;
            W_EW[n0] = w1; W_EW[n1] = w2;
            const int pa = atomicAdd(&W_cnt[l * 32 + ea], 1);
            W_LIST[(size_t)ea * TT + pa] = n0;
            const int pb = atomicAdd(&W_cnt[l * 32 + eb], 1);
            W_LIST[(size_t)eb * TT + pb] = n1;
        }
    }
}

__device__ void phase_moe1(const Params& p, int l, float* sm) {
    int* offs = (int*)(sm + 16384);
    int* ns = (int*)(sm + 16384 + 64);
    const int tid = TIDX, lane = tid & 63, w = tid >> 6, wm = w >> 1, wn = w & 1, r16 = lane & 15, q = lane >> 4;
    __syncthreads();
    if (tid == 0) { int a = 0; for (int e = 0; e < 32; e++) { offs[e] = a; a += (W_cnt[l * 32 + e] + 127) >> 7; } offs[32] = a; }
    __syncthreads();
    const int total = offs[32] * 8;
    for (int u = wq_next(WQ(p, l, 11), sm); u < total; u = wq_next(WQ(p, l, 11), sm)) {
        const int rbg = u >> 3, cb = u & 7;
        int e = 0;
        while (offs[e + 1] <= rbg) e++;
        const int rbi = rbg - offs[e];
        const int ce = W_cnt[l * 32 + e];
        __syncthreads();
        if (tid < 128) { const int idx = rbi * 128 + tid; ns[tid] = idx < ce ? W_LIST[(size_t)e * TT + idx] : -1; }
        __syncthreads();
        const int j0 = cb * 64;
        const bf16_t* hb = W_H;
        const bf16_t* gT = W_WMOE + (size_t)e * 512 * 1024;
        const bf16_t* uT = W_WMOE + (size_t)32 * 512 * 1024 + (size_t)e * 512 * 1024;
        f32x4 acc[4][4];
        gemm128_bt<true>(1024, (char*)sm, [&](int r) { return hb + (size_t)(max(ns[r], 0) >> 1) * 1024; },
                         [&](int c) { const int hid = j0 + (c >> 6) * 32 + ((c >> 4) & 1) * 16 + (c & 15);
                                      return (((c >> 4) & 3) >= 2 ? uT : gT) + (size_t)hid * 1024; }, acc);
#pragma unroll
        for (int i = 0; i < 4; i++) {
            const int n = ns[wm * 64 + i * 16 + r16];
            if (n >= 0) {
#pragma unroll
                for (int j = 0; j < 2; j++) {
                    const int hh = j0 + wn * 32 + j * 16 + q * 4;
                    float4 a;
                    a.x = siluf_(acc[i][j][0]) * acc[i][j + 2][0]; a.y = siluf_(acc[i][j][1]) * acc[i][j + 2][1];
                    a.z = siluf_(acc[i][j][2]) * acc[i][j + 2][2]; a.w = siluf_(acc[i][j][3]) * acc[i][j + 2][3];
                    st4bf(&W_ACT[(size_t)n * 512 + hh], a);
                }
            }
        }
    }
}
__device__ void phase_moe2(const Params& p, int l, float* sm) {
    int* offs = (int*)(sm + 16384);
    int* ns = (int*)(sm + 16384 + 64);
    const int tid = TIDX, lane = tid & 63, w = tid >> 6, wm = w >> 1, wn = w & 1, r16 = lane & 15, q = lane >> 4;
    __syncthreads();
    if (tid == 0) { int a = 0; for (int e = 0; e < 32; e++) { offs[e] = a; a += (W_cnt[l * 32 + e] + 127) >> 7; } offs[32] = a; }
    __syncthreads();
    const int total = offs[32] * 8;
    for (int u = wq_next(WQ(p, l, 12), sm); u < total; u = wq_next(WQ(p, l, 12), sm)) {
        const int rbg = u >> 3, cb = u & 7;
        int e = 0;
        while (offs[e + 1] <= rbg) e++;
        const int rbi = rbg - offs[e];
        const int ce = W_cnt[l * 32 + e];
        __syncthreads();
        if (tid < 128) { const int idx = rbi * 128 + tid; ns[tid] = idx < ce ? W_LIST[(size_t)e * TT + idx] : -1; }
        __syncthreads();
        const int n0 = cb * 128;
        const bf16_t* ab_ = W_ACT;
        const bf16_t* dT = W_WMOE + (size_t)2 * 32 * 512 * 1024 + ((size_t)e * 1024 + n0) * 512;
        f32x4 acc[4][4];
        gemm128_bt<true>(512, (char*)sm, [&](int r) { return ab_ + (size_t)max(ns[r], 0) * 512; }, [&](int r) { return dT + (size_t)r * 512; }, acc);
#pragma unroll
        for (int i = 0; i < 4; i++) {
            const int n = ns[wm * 64 + i * 16 + r16];
            if (n >= 0) {
                const float wt = W_EW[n];
#pragma unroll
                for (int j = 0; j < 4; j++) {
                    const int col = n0 + wn * 64 + j * 16 + q * 4;
                    st4bf(&W_YEXP[(size_t)n * 1024 + col], make_float4(acc[i][j][0] * wt, acc[i][j][1] * wt, acc[i][j][2] * wt, acc[i][j][3] * wt));
                }
            }
        }
    }
}

enum { PH_PRO1 = 0, PH_PRO2, PH_NORM1, PH_GEMM1, PH_PREP, PH_MIX, PH_HGOUT, PH_GEMM2, PH_NORM2, PH_MOE1, PH_MOE2, PH_FINAL };

template <int PH>
__device__ __forceinline__ void run_phase(const Params& p, int l, float* sm) {
    if (PH == PH_PRO1) phase_pro1(p, sm);
    else if (PH == PH_PRO2) phase_pro2(p, sm);
    else if (PH == PH_NORM1) phase_norm1(p, l, sm);
    else if (PH == PH_GEMM1) phase_gemm1(p, l, sm);
    else if (PH == PH_PREP) phase_prep(p, l, sm);
    else if (PH == PH_MIX) phase_mix(p, l, sm);
    else if (PH == PH_HGOUT) phase_mix2(p, l, sm);
    else if (PH == PH_GEMM2) phase_gemm2(p, l, sm);
    else if (PH == PH_NORM2) phase_norm2(p, l, sm);
    else if (PH == PH_MOE1) phase_moe1(p, l, sm);
    else if (PH == PH_MOE2) phase_moe2(p, l, sm);
    else if (PH == PH_FINAL) phase_final(p, sm);
}

#if !MEGA
template <int PH>
__global__ void __launch_bounds__(256, 2) k_phase(Params p, int l) {
    __shared__ float sm[SMF];
    run_phase<PH>(p, l, sm);
}
#else
__global__ void __launch_bounds__(256, 2) k_mega(Params p) {
    __shared__ float sm[SMF];
    __shared__ uint4 xb_words;
    if (TIDX == 0) xb_words = make_uint4(0u, 0u, 0u, 0u);
    __syncthreads();
    if (threadIdx.x == 0) ((int*)sm)[SMF - 2] = 0;
    __syncthreads();
    XcdBarrier bar = xcd_barrier_post(W_bar, (volatile LAS unsigned*)&xb_words);
#if USE_CG
#define xcd_barrier(b) cooperative_groups::this_grid().sync()
#endif
    for (int r = 0; r < p.rep[PH_PRO1]; r++) { if (threadIdx.x == 0) ((int*)sm)[SMF - 2] = r; __syncthreads(); run_phase<PH_PRO1>(p, 0, sm); xcd_barrier(bar); }
    for (int r = 0; r < p.rep[PH_PRO2]; r++) { if (threadIdx.x == 0) ((int*)sm)[SMF - 2] = r; __syncthreads(); run_phase<PH_PRO2>(p, 0, sm); xcd_barrier(bar); }
    for (int l = 0; l < DEPTH; l++) {
        if (threadIdx.x == 0) ((int*)sm)[SMF - 2] = 0; __syncthreads(); run_phase<PH_NORM1>(p, l, sm); xcd_barrier(bar);
        for (int r = 0; r < p.rep[PH_GEMM1]; r++) { if (threadIdx.x == 0) ((int*)sm)[SMF - 2] = r; __syncthreads(); run_phase<PH_GEMM1>(p, l, sm); xcd_barrier(bar); }
        for (int r = 0; r < p.rep[PH_PREP]; r++) { if (threadIdx.x == 0) ((int*)sm)[SMF - 2] = r; __syncthreads(); run_phase<PH_PREP>(p, l, sm); xcd_barrier(bar); }
        for (int r = 0; r < p.rep[PH_MIX]; r++) { if (threadIdx.x == 0) ((int*)sm)[SMF - 2] = r; __syncthreads(); run_phase<PH_MIX>(p, l, sm); xcd_barrier(bar); }
        for (int r = 0; r < p.rep[PH_HGOUT]; r++) { if (threadIdx.x == 0) ((int*)sm)[SMF - 2] = r; __syncthreads(); run_phase<PH_HGOUT>(p, l, sm); xcd_barrier(bar); }
        if (threadIdx.x == 0) ((int*)sm)[SMF - 2] = 0; __syncthreads(); run_phase<PH_GEMM2>(p, l, sm); xcd_barrier(bar);
        run_phase<PH_NORM2>(p, l, sm); xcd_barrier(bar);
        for (int r = 0; r < p.rep[PH_MOE1]; r++) { if (threadIdx.x == 0) ((int*)sm)[SMF - 2] = r; __syncthreads(); run_phase<PH_MOE1>(p, l, sm); xcd_barrier(bar); }
        for (int r = 0; r < p.rep[PH_MOE2]; r++) { if (threadIdx.x == 0) ((int*)sm)[SMF - 2] = r; __syncthreads(); run_phase<PH_MOE2>(p, l, sm); xcd_barrier(bar); }
    }
    run_phase<PH_FINAL>(p, 0, sm);
}
#endif

static inline size_t align_up(size_t v, size_t a) { return (v + a - 1) / a * a; }

extern "C" void kernel_launch(void* const* d_in, const int* in_sizes, int n_in, void* d_out, int out_size, void* d_ws, size_t ws_size,
                              hipStream_t stream) {
    Params p{};
    const float* const* in = (const float* const*)d_in;
    p.x = in[0]; p.c = in[1]; p.ctx = in[2]; p.c_ctx = in[3]; p.w_ada = in[4]; p.b_ada = in[5]; p.norm1_g = in[6]; p.norm2_g = in[7];
    p.w_in = in[8]; p.w_out = in[9]; p.lb_logits = in[10]; p.hgrn_norm_g = in[11];
    p.hy_short_w = in[12]; p.hy_short_b = in[13]; p.hy_w1 = in[14]; p.hy_b1 = in[15]; p.hy_freq = in[16]; p.hy_w2 = in[17]; p.hy_b2 = in[18];
    p.hy_w3 = in[19]; p.hy_b3 = in[20]; p.hy_decay = in[21]; p.hy_bias = in[22];
    p.na_rpb = in[23]; p.na_q_g = in[24]; p.na_k_g = in[25];
    p.mla_q_a_g = in[26]; p.mla_kv_a_g = in[27]; p.mla_w_uq = in[28]; p.mla_w_ukv = in[29]; p.mla_q_g = in[30]; p.mla_k_g = in[31];
    p.moe_wg = in[32]; p.moe_bg = in[33]; p.moe_we = in[34]; p.moe_be = in[35]; p.moe_w_gate = in[36]; p.moe_w_up = in[37]; p.moe_w_down = in[38];
    p.out = (float*)d_out;
    for (int i = 0; i < 16; i++) p.rep[i] = 1;
#ifdef PROBE_PH
    p.rep[PROBE_PH] = 2;
#endif
#ifdef PROBE_PH2
    p.rep[PROBE_PH2] = 2;
#endif

    p.ws = (char*)d_ws;
    const size_t off = WS_TOTAL;
    if (off > ws_size) { fprintf(stderr, "workspace too small: need %zu have %zu\n", off, ws_size); return; }

#if !MEGA
#ifndef BIGMASK
#define BIGMASK 0xFFF
#endif
#define GR(ph) (((BIGMASK >> (ph)) & 1) ? 1024 : 256)
    k_phase<PH_PRO1><<<GR(PH_PRO1), 256, 0, stream>>>(p, 0);
    k_phase<PH_PRO2><<<GR(PH_PRO2), 256, 0, stream>>>(p, 0);
    for (int l = 0; l < DEPTH; l++) {
        k_phase<PH_NORM1><<<GR(PH_NORM1), 256, 0, stream>>>(p, l);
        k_phase<PH_GEMM1><<<GR(PH_GEMM1), 256, 0, stream>>>(p, l);
        k_phase<PH_PREP><<<GR(PH_PREP), 256, 0, stream>>>(p, l);
        k_phase<PH_MIX><<<GR(PH_MIX), 256, 0, stream>>>(p, l);
        k_phase<PH_HGOUT><<<GR(PH_HGOUT), 256, 0, stream>>>(p, l);
        k_phase<PH_GEMM2><<<GR(PH_GEMM2), 256, 0, stream>>>(p, l);
        k_phase<PH_NORM2><<<GR(PH_NORM2), 256, 0, stream>>>(p, l);
        k_phase<PH_MOE1><<<GR(PH_MOE1), 256, 0, stream>>>(p, l);
        k_phase<PH_MOE2><<<GR(PH_MOE2), 256, 0, stream>>>(p, l);
    }
    k_phase<PH_FINAL><<<GR(PH_FINAL), 256, 0, stream>>>(p, 0);
#else
    static int grid = 0;
    if (!grid) {
        int dev = 0, cus = 0, per_cu = 0;
        hipGetDevice(&dev);
        hipDeviceGetAttribute(&cus, hipDeviceAttributeMultiprocessorCount, dev);
        hipOccupancyMaxActiveBlocksPerMultiprocessor(&per_cu, k_mega, 256, 0);
        if (per_cu > 2) per_cu = 2;
        if (per_cu < 1) per_cu = 1;
        grid = cus * per_cu;
    }
    hipMemsetAsync(p.ws + OFF_bar, 0, (XCD_BAR_WORDS + WQ_WORDS) * sizeof(unsigned), stream);
#if USE_CG
    { void* args[] = {&p}; hipLaunchCooperativeKernel((void*)k_mega, dim3(grid), dim3(256), args, 0, stream); }
#else
    k_mega<<<grid, 256, 0, stream>>>(p);
#endif
#endif
}
```
